# Optimizing an MI355X kernel written in HIP

```python
import jax, jax.numpy as jnp
from jax import lax
import numpy as np

D_MODEL = 1024
BATCH = 2
SEQ = 8192
DEPTH = 2

N_MIXERS = 2
HEAD_DIM = 64
N_HEADS = D_MODEL // HEAD_DIM
DECAY_LORA = 64
ICLR_LORA = 64
GATE_LORA = 128
GN_EPS = 64e-5
N_DIR = 2
CHUNK = 128
GMLP_WIDTH = 2 * D_MODEL
GMLP_GROUP = 128
GMLP_GROUPS = GMLP_WIDTH // GMLP_GROUP
FFN_HIDDEN = 4 * D_MODEL
NORM_EPS = 1e-5
N_RWKV = (DEPTH + 1) // 2
N_GMLP = DEPTH // 2

kernel_name = "bidir_rwkv7_chunked_gmlp_hybrid"


def rms_norm(x, g):
    xf = x.astype(jnp.float32)
    y = xf * lax.rsqrt(jnp.mean(xf * xf, axis=-1, keepdims=True) + NORM_EPS)
    return (y * g.astype(jnp.float32)).astype(x.dtype)


def layer_norm(x, g, b):
    xf = x.astype(jnp.float32)
    mu = jnp.mean(xf, axis=-1, keepdims=True)
    xc = xf - mu
    var = jnp.mean(xc * xc, axis=-1, keepdims=True)
    y = xc * lax.rsqrt(var + NORM_EPS) * g.astype(jnp.float32) + b.astype(jnp.float32)
    return y.astype(x.dtype)


def centred_shift(x):
    x_prev = jnp.pad(x[:, :-1], ((0, 0), (1, 0), (0, 0)))
    x_next = jnp.pad(x[:, 1:], ((0, 0), (0, 1), (0, 0)))
    return 0.5 * (x_prev + x_next) - x


def wkv7_scan(r, w, k, v, a_vec, b_vec, reverse):
    B, T, H, N = r.shape
    xs = tuple(jnp.moveaxis(t, 1, 0) for t in (r, w, k, v, a_vec, b_vec))

    def step(S, inp):
        r_t, w_t, k_t, v_t, a_t, b_t = inp
        sa = jnp.einsum('bhvk,bhk->bhv', S, a_t)
        S = S * w_t[:, :, None, :] + sa[..., None] * b_t[:, :, None, :] + v_t[..., None] * k_t[:, :, None, :]
        o = jnp.einsum('bhvk,bhk->bhv', S, r_t)
        return S, o

    S0 = jnp.zeros((B, H, N, N), jnp.float32)
    _, o = lax.scan(step, S0, xs, reverse=reverse)
    return jnp.moveaxis(o, 0, 1)


def rwkv7_bidir(xn, mu, wr, wk, wv, wo, w0, w1, w2, a0, a1, a2, g1, g2, k_k, k_a, r_k, ln_g, ln_b):
    B, T, D = xn.shape
    heads = lambda t: t.reshape(B, T, N_HEADS, HEAD_DIM)
    xx = centred_shift(xn)
    xr, xw, xk, xv, xa, xg = (xn + xx * mu[i] for i in range(6))
    r = heads(xr @ wr).astype(jnp.float32)
    k = heads(xk @ wk).astype(jnp.float32)
    v = heads(xv @ wv).astype(jnp.float32)
    g = jax.nn.sigmoid(xg @ g1) @ g2
    kk = k * k_k.reshape(N_HEADS, HEAD_DIM).astype(jnp.float32)
    kk = kk / jnp.maximum(jnp.sqrt(jnp.sum(kk * kk, axis=-1, keepdims=True)), 1e-12)
    k_a_h = k_a.reshape(N_HEADS, HEAD_DIM).astype(jnp.float32)
    r_k_f = r_k.astype(jnp.float32)
    scan_sum = jnp.zeros_like(r)
    bonus_sum = jnp.zeros_like(r)
    for d in range(N_DIR):
        w_log = -jax.nn.softplus(-(w0[d] + jnp.tanh(xw @ w1[d]) @ w2[d]).astype(jnp.float32)) - 0.5
        decay = heads(jnp.exp(-jnp.exp(w_log)))
        a = heads(jax.nn.sigmoid((a0[d] + (xa @ a1[d]) @ a2[d]).astype(jnp.float32)))
        k_d = k * (1.0 + (a - 1.0) * k_a_h)
        scan_sum = scan_sum + wkv7_scan(r, decay, k_d, v, -kk, kk * a, reverse=(d == 1))
        bonus_sum = bonus_sum + jnp.sum(r * k_d * r_k_f, axis=-1, keepdims=True) * v
    mu_h = jnp.mean(scan_sum, axis=-1, keepdims=True)
    oc = scan_sum - mu_h
    o = oc * lax.rsqrt(jnp.mean(oc * oc, axis=-1, keepdims=True) + GN_EPS)
    o = o.reshape(B, T, D) * ln_g.astype(jnp.float32) + ln_b.astype(jnp.float32)
    o = o + bonus_sum.reshape(B, T, D)
    return (o.astype(xn.dtype) * g) @ wo


def chunked_gmlp(xn, w_in, ln_g, ln_b, w_s, b_s, w_out):
    B, T, D = xn.shape
    h = jax.nn.gelu(xn @ w_in, approximate=False)
    u, v = jnp.split(h, 2, axis=-1)
    v = layer_norm(v, ln_g, ln_b)
    v = v.reshape(B, T // CHUNK, CHUNK, GMLP_GROUPS, GMLP_GROUP)
    v = jnp.einsum('gij,bcjgd->bcigd', w_s, v) + jnp.transpose(b_s)[None, None, :, :, None]
    v = v.reshape(B, T, GMLP_WIDTH)
    return (u * v) @ w_out


def sqrelu_ffn(xn, w1, w2):
    h = jax.nn.relu(xn @ w1)
    return (h * h) @ w2


def setup_inputs(seed: int = 0) -> dict:
    key = jax.random.key(seed)
    ks = iter(jax.random.split(key, 40))
    nrm = lambda shape, scale: jax.random.normal(next(ks), shape, jnp.float32) * scale
    D, NR, NG = D_MODEL, N_RWKV, N_GMLP
    return {
        "x": nrm((BATCH, SEQ, D), 1.0),
        "mix_norm": 1.0 + nrm((DEPTH, D), 0.02),
        "ffn_norm": 1.0 + nrm((DEPTH, D), 0.02),
        "final_norm": 1.0 + nrm((D,), 0.02),
        "rwkv_mu": jax.random.uniform(next(ks), (NR, 6, D), jnp.float32),
        "rwkv_wr": nrm((NR, D, D), D ** -0.5),
        "rwkv_wk": nrm((NR, D, D), D ** -0.5),
        "rwkv_wv": nrm((NR, D, D), D ** -0.5),
        "rwkv_wo": nrm((NR, D, D), D ** -0.5),
        "rwkv_w0": jax.random.uniform(next(ks), (NR, N_DIR, D), jnp.float32, -6.0, 1.0),
        "rwkv_w1": nrm((NR, N_DIR, D, DECAY_LORA), D ** -0.5),
        "rwkv_w2": nrm((NR, N_DIR, DECAY_LORA, D), 0.1 * DECAY_LORA ** -0.5),
        "rwkv_a0": nrm((NR, N_DIR, D), 0.1),
        "rwkv_a1": nrm((NR, N_DIR, D, ICLR_LORA), D ** -0.5),
        "rwkv_a2": nrm((NR, N_DIR, ICLR_LORA, D), 0.1 * ICLR_LORA ** -0.5),
        "rwkv_g1": nrm((NR, D, GATE_LORA), D ** -0.5),
        "rwkv_g2": nrm((NR, GATE_LORA, D), GATE_LORA ** -0.5),
        "rwkv_k_k": 0.85 + nrm((NR, D), 0.02),
        "rwkv_k_a": 1.0 + nrm((NR, D), 0.02),
        "rwkv_r_k": nrm((NR, N_HEADS, HEAD_DIM), 0.1),
        "rwkv_ln_g": 1.0 + nrm((NR, D), 0.02),
        "rwkv_ln_b": nrm((NR, D), 0.02),
        "gmlp_w_in": nrm((NG, D, 2 * GMLP_WIDTH), D ** -0.5),
        "gmlp_ln_g": 1.0 + nrm((NG, GMLP_WIDTH), 0.02),
        "gmlp_ln_b": nrm((NG, GMLP_WIDTH), 0.02),
        "gmlp_w_s": nrm((NG, GMLP_GROUPS, CHUNK, CHUNK), CHUNK ** -0.5),
        "gmlp_b_s": 1.0 + nrm((NG, GMLP_GROUPS, CHUNK), 0.1),
        "gmlp_w_out": nrm((NG, GMLP_WIDTH, D), GMLP_WIDTH ** -0.5),
        "ffn_w1": nrm((DEPTH, D, FFN_HIDDEN), D ** -0.5),
        "ffn_w2": nrm((DEPTH, FFN_HIDDEN, D), FFN_HIDDEN ** -0.5),
    }


def reference(x, mix_norm, ffn_norm, final_norm, rwkv_mu, rwkv_wr, rwkv_wk, rwkv_wv, rwkv_wo,
              rwkv_w0, rwkv_w1, rwkv_w2, rwkv_a0, rwkv_a1, rwkv_a2, rwkv_g1, rwkv_g2,
              rwkv_k_k, rwkv_k_a, rwkv_r_k, rwkv_ln_g, rwkv_ln_b,
              gmlp_w_in, gmlp_ln_g, gmlp_ln_b, gmlp_w_s, gmlp_b_s, gmlp_w_out,
              ffn_w1, ffn_w2):
    for i in range(DEPTH):
        xn = rms_norm(x, mix_norm[i])
        j = i // N_MIXERS
        if i % N_MIXERS == 0:
            h = rwkv7_bidir(xn, rwkv_mu[j], rwkv_wr[j], rwkv_wk[j], rwkv_wv[j], rwkv_wo[j],
                            rwkv_w0[j], rwkv_w1[j], rwkv_w2[j], rwkv_a0[j], rwkv_a1[j], rwkv_a2[j],
                            rwkv_g1[j], rwkv_g2[j], rwkv_k_k[j], rwkv_k_a[j], rwkv_r_k[j],
                            rwkv_ln_g[j], rwkv_ln_b[j])
        else:
            h = chunked_gmlp(xn, gmlp_w_in[j], gmlp_ln_g[j], gmlp_ln_b[j], gmlp_w_s[j],
                             gmlp_b_s[j], gmlp_w_out[j])
        x = x + h
        x = x + sqrelu_ffn(rms_norm(x, ffn_norm[i]), ffn_w1[i], ffn_w2[i])
    return rms_norm(x, final_norm)
```

```cpp
#include <hip/hip_runtime.h>
#include <hip/hip_cooperative_groups.h>
#include <cstdio>
#include <cstdint>
namespace cg = cooperative_groups;

#ifndef MK_SINGLE
#define MK_SINGLE 1
#endif

#define LAS __attribute__((address_space(3)))
typedef unsigned short bf16_t;
typedef short bf16x8 __attribute__((ext_vector_type(8)));
typedef float f32x4 __attribute__((ext_vector_type(4)));
typedef float f32x2 __attribute__((ext_vector_type(2)));
typedef unsigned u32x4 __attribute__((ext_vector_type(4)));
typedef unsigned u32x2 __attribute__((ext_vector_type(2)));

constexpr int BATCH = 2, T = 8192, D = 1024, FF = 4096, M = BATCH * T;
constexpr int NWAVES = 8, NTHR = 512;
constexpr float NORM_EPS = 1e-5f, GN_EPS = 64e-5f;

constexpr size_t MiB = 1u << 20;
constexpr size_t WS_SS = 0;
constexpr size_t WS_BAR = 1 * MiB + 65536;
constexpr size_t WS_WRKV = 2 * MiB;
constexpr size_t WS_WO = 8 * MiB;
constexpr size_t WS_L1 = 10 * MiB;
constexpr size_t WS_L2 = 12 * MiB;
constexpr size_t WS_G2 = 14 * MiB;
constexpr size_t WS_R = 15 * MiB, WS_K = 47 * MiB, WS_V = 79 * MiB;
constexpr size_t WS_XR = 111 * MiB;
constexpr size_t WS_AA = 111 * MiB;
constexpr size_t WS_OD = 175 * MiB;
constexpr size_t WS_A2 = 239 * MiB;
constexpr size_t WS_SG = 247 * MiB;
constexpr size_t WS_W1_0 = 15 * MiB, WS_W2_0 = 23 * MiB, WS_WIN = 31 * MiB, WS_WOUT = 39 * MiB, WS_WSB = 43 * MiB, WS_W1_1 = 44 * MiB, WS_W2_1 = 52 * MiB;
constexpr size_t WS_XB = 60 * MiB;
constexpr size_t WS_H = 92 * MiB;
constexpr size_t WS_LNP = 220 * MiB;
constexpr size_t WS_END = 256 * MiB;

constexpr int RING_BYTES = 131072, RS_OFF = RING_BYTES + 1024, LDS_BYTES = 147456;

__device__ __forceinline__ unsigned cvt_pk_bf16(float lo, float hi) { unsigned r; asm volatile("v_cvt_pk_bf16_f32 %0, %1, %2" : "=v"(r) : "v"(lo), "v"(hi)); return r; }
__device__ __forceinline__ float bf_lo(unsigned w) { return __builtin_bit_cast(float, w << 16); }
__device__ __forceinline__ float bf_hi(unsigned w) { return __builtin_bit_cast(float, w & 0xffff0000u); }
__device__ __forceinline__ float wave_sum(float v) {
#pragma unroll
    for (int o = 1; o < 64; o <<= 1) v += __shfl_xor(v, o);
    return v;
}
template <int CTRL> __device__ __forceinline__ float dpp_f(float x) { return __builtin_bit_cast(float, __builtin_amdgcn_update_dpp(0, __builtin_bit_cast(int, x), CTRL, 0xF, 0xF, true)); }
__device__ __forceinline__ float row16_allsum(float x) { x += dpp_f<0x128>(x); x += dpp_f<0x124>(x); x += dpp_f<0x122>(x); x += dpp_f<0x121>(x); return x; }
__device__ __forceinline__ float sigmoidf_(float x) { return __builtin_amdgcn_rcpf(1.0f + __expf(-x)); }
__device__ __forceinline__ float tanhf_(float x) { return 1.0f - 2.0f * __builtin_amdgcn_rcpf(__expf(2.0f * x) + 1.0f); }
__device__ __forceinline__ f32x2 gelu_pk(f32x2 v) {
    const f32x2 av = __builtin_elementwise_abs(v), d = av * 0.2316418882f + 1.0f;
    f32x2 t; t.x = __builtin_amdgcn_rcpf(d.x); t.y = __builtin_amdgcn_rcpf(d.y);
    f32x2 q = t * 0.5307027145f + (-0.7265760135f); q = q * t + 0.7107068705f; q = q * t + (-0.142248368f); q = q * t + 0.127414796f; q = q * t;
    const f32x2 s = (v * v) * (-0.72134752044f);
    f32x2 e; e.x = __builtin_amdgcn_exp2f(s.x); e.y = __builtin_amdgcn_exp2f(s.y);
    const f32x2 m = v * (q * e), r = v - m;
    f32x2 o; o.x = v.x < 0.f ? m.x : r.x; o.y = v.y < 0.f ? m.y : r.y; return o;
}
__device__ __forceinline__ u32x4 pack8(const f32x4 a, const f32x4 b) { u32x4 w; w.x = cvt_pk_bf16(a[0], a[1]); w.y = cvt_pk_bf16(a[2], a[3]); w.z = cvt_pk_bf16(b[0], b[1]); w.w = cvt_pk_bf16(b[2], b[3]); return w; }
__device__ __forceinline__ void unpack8(const u32x4 w, float (&f)[8]) { f[0] = bf_lo(w.x); f[1] = bf_hi(w.x); f[2] = bf_lo(w.y); f[3] = bf_hi(w.y); f[4] = bf_lo(w.z); f[5] = bf_hi(w.z); f[6] = bf_lo(w.w); f[7] = bf_hi(w.w); }

namespace pg8 {
constexpr int BM = 256, BK = 64, HALF = 128, HTB = HALF * BK * 2, NXCD = 8, WGM = 4;
__host__ __device__ __forceinline__ int lds_byte(int r, int c) { const int st = (r >> 4) * 2 + (c >> 5), rr = r & 15, cc = c & 31, ob = rr * 64 + cc * 2; return st * 1024 + (ob ^ (((ob >> 9) & 1) << 5)); }
__host__ __device__ __forceinline__ void stage_rc(int b, int& R, int& C) { const int st = b / 1024, sb = b % 1024, swz = sb ^ (((sb >> 9) & 1) << 5); R = (st >> 1) * 16 + swz / 64; C = (st & 1) * 32 + (swz % 64) / 2; }
__host__ __device__ __forceinline__ int perm32(int rho) { const int n = rho >> 4, i = rho & 15; return 8 * (i >> 2) + 4 * n + (i & 3); }

struct Unit { int pm, pn; };
struct Gemm { const bf16_t* A; const bf16_t* Bt; int M, N, K, lda; int agrp; size_t astride; };

struct StaticOrder {
    int nM, nN, nwg, G, c, L0, cnt;
    __host__ __device__ void init(int M_, int N_, int G_, int c_) { nM = M_ / BM; nN = N_ / BM; nwg = nM * nN; G = G_; c = c_; L0 = 0; cnt = 1 << 20; }
    __host__ __device__ void init_sub(int M_, int N_, int G_, int c_, int L0_, int cnt_) { init(M_, N_, G_, c_); L0 = L0_; cnt = cnt_; }
    __host__ __device__ bool next(int i, Unit& u) const {
        if (i >= cnt || c < 0) return false;
        const long L = (long)L0 + (long)i * G + c; if (L >= nwg) return false;
        int wgid = (int)L; { const int q = nwg / NXCD, r = nwg % NXCD, xcd = wgid % NXCD, off = wgid / NXCD; wgid = (xcd < r ? xcd * (q + 1) : r * (q + 1) + (xcd - r) * q) + off; }
        const int nig = WGM * nN, gid = wgid / nig, fm = gid * WGM, gsz = (nM - fm) < WGM ? (nM - fm) : WGM;
        u.pm = fm + ((wgid % nig) % gsz); u.pn = (wgid % nig) / gsz; return true;
    }
};

template <class Epi>
__device__ __forceinline__ void gemm_phase(LAS unsigned char* lds, const Gemm g, const StaticOrder& S, const Epi& E) {
    const int tid = threadIdx.x, wid = __builtin_amdgcn_readfirstlane(tid >> 6), lane = tid & 63, wr = wid >> 2, wc = wid & 3, fr = lane & 15, fq = lane >> 4;
    const int K = g.K, nt = K / BK;
    unsigned voffA[2], voffB[2];
#pragma unroll
    for (int i = 0; i < 2; ++i) { int R, C; stage_rc(tid * 16 + i * 8192, R, C); const int Rb = (R & ~31) + perm32(R & 31);
        voffA[i] = (unsigned)(R * g.lda + C) * 2u; voffB[i] = (unsigned)(Rb * K + C) * 2u; }
    const size_t kstep = (size_t)(BK * 2);
    const size_t hA = (size_t)HALF * g.lda * 2, tA = 2 * hA, hB = (size_t)HALF * K * 2, tB = 2 * hB;
    const unsigned ldsw = (unsigned)wid * 1024u;
    const int aoff = lds_byte(wr * 64 + fr, fq * 8), boff = lds_byte(wc * 32 + fr, fq * 8);
#define PG8_SA(b, h) (((b) * 2 + (h)) * HTB)
#define PG8_SB(b, h) ((4 + (b) * 2 + (h)) * HTB)
#define PG8_STAGE(bufoff, gbase, voff) do { _Pragma("unroll") for (int _i = 0; _i < 2; ++_i) \
        __builtin_amdgcn_global_load_lds((const unsigned*)((const char*)(gbase) + (voff)[_i]), (LAS unsigned*)(lds + (bufoff) + ldsw + _i * 8192), 16, 0, 0); } while (0)
#define PG8_LDA(dst, b, h) do { _Pragma("unroll") for (int m = 0; m < 4; ++m) _Pragma("unroll") for (int k = 0; k < 2; ++k) dst[m][k] = *(const LAS bf16x8*)(lds + PG8_SA(b, h) + aoff + m * 2048 + k * 1024); } while (0)
#define PG8_LDB(dst, b, h) do { _Pragma("unroll") for (int n = 0; n < 2; ++n) _Pragma("unroll") for (int k = 0; k < 2; ++k) dst[n][k] = *(const LAS bf16x8*)(lds + PG8_SB(b, h) + boff + n * 2048 + k * 1024); } while (0)
#define PG8_MMA(ai, bj, At, Bt) do { __builtin_amdgcn_s_setprio(1); _Pragma("unroll") for (int m = 0; m < 4; ++m) _Pragma("unroll") for (int n = 0; n < 2; ++n) _Pragma("unroll") for (int k = 0; k < 2; ++k) \
        acc[ai][bj][m][n] = __builtin_amdgcn_mfma_f32_16x16x32_bf16(Bt[n][k], At[m][k], acc[ai][bj][m][n], 0, 0, 0); __builtin_amdgcn_s_setprio(0); } while (0)
#define PG8_WAIT_V(n) asm volatile("s_waitcnt vmcnt(" #n ")" ::: "memory")
#define PG8_WAIT_L(n) asm volatile("s_waitcnt lgkmcnt(" #n ")" ::: "memory")
#define PG8_BAR __builtin_amdgcn_s_barrier()
#define PG8_SCHED __builtin_amdgcn_sched_barrier(0)
    Unit cur, nxt; int ui = 0;
    if (!S.next(0, cur)) return;
    f32x4 acc[2][2][4][2];
#pragma unroll
    for (int a = 0; a < 2; ++a)
#pragma unroll
        for (int b = 0; b < 2; ++b)
#pragma unroll
            for (int m = 0; m < 4; ++m)
#pragma unroll
                for (int n = 0; n < 2; ++n) acc[a][b][m][n] = (f32x4){0.f, 0.f, 0.f, 0.f};
    bf16x8 At[4][2], B0[2][2], B1[2][2];
    const char* cA = (const char*)g.A + (size_t)cur.pm * tA + (size_t)(cur.pn / g.agrp) * g.astride; const char* cB = (const char*)g.Bt + (size_t)cur.pn * tB;
    PG8_STAGE(PG8_SB(0, 0), cB, voffB); PG8_STAGE(PG8_SB(0, 1), cB + hB, voffB); PG8_STAGE(PG8_SA(0, 0), cA, voffA); PG8_STAGE(PG8_SA(0, 1), cA + hA, voffA);
    if (wr == 1) PG8_BAR;
    PG8_WAIT_V(2); PG8_BAR;
    PG8_STAGE(PG8_SB(1, 0), cB + kstep, voffB); PG8_STAGE(PG8_SA(1, 0), cA + kstep, voffA); PG8_STAGE(PG8_SB(1, 1), cB + hB + kstep, voffB);
    PG8_WAIT_V(6); PG8_BAR;
    for (;;) {
        const bool has_next = S.next(ui + 1, nxt);
        const char* nA = has_next ? (const char*)g.A + (size_t)nxt.pm * tA + (size_t)(nxt.pn / g.agrp) * g.astride : cA; const char* nB = has_next ? (const char*)g.Bt + (size_t)nxt.pn * tB : cB;
#pragma nounroll
        for (int t = 0; t < nt; t += 2) {
            const bool last = (t == nt - 2);
            const char* a1 = cA + (size_t)(t + 1) * kstep;
            const char* a2 = last ? nA : cA + (size_t)(t + 2) * kstep; const char* b2 = last ? nB : cB + (size_t)(t + 2) * kstep;
            const char* a3 = a2 + kstep; const char* b3 = b2 + kstep;
            PG8_LDB(B0, 0, 0); PG8_LDB(B1, 0, 1); PG8_SCHED; PG8_LDA(At, 0, 0); PG8_STAGE(PG8_SA(1, 1), a1 + hA, voffA);
            PG8_WAIT_V(8); PG8_WAIT_L(0); PG8_BAR; PG8_MMA(0, 0, At, B0); PG8_MMA(0, 1, At, B1); PG8_BAR; PG8_SCHED;
            PG8_LDA(At, 0, 1); PG8_STAGE(PG8_SB(0, 0), b2, voffB); PG8_STAGE(PG8_SB(0, 1), b2 + hB, voffB); PG8_STAGE(PG8_SA(0, 0), a2, voffA);
            PG8_WAIT_V(8); PG8_WAIT_L(0); PG8_BAR; PG8_MMA(1, 0, At, B0); PG8_MMA(1, 1, At, B1); PG8_BAR; PG8_SCHED;
            PG8_LDB(B0, 1, 0); PG8_LDB(B1, 1, 1); PG8_SCHED; PG8_LDA(At, 1, 0); PG8_STAGE(PG8_SA(0, 1), a2 + hA, voffA);
            PG8_WAIT_V(8); PG8_WAIT_L(0); PG8_BAR; PG8_MMA(0, 0, At, B0); PG8_MMA(0, 1, At, B1); PG8_BAR; PG8_SCHED;
            PG8_LDA(At, 1, 1); PG8_STAGE(PG8_SB(1, 0), b3, voffB); PG8_STAGE(PG8_SB(1, 1), b3 + hB, voffB); PG8_STAGE(PG8_SA(1, 0), a3, voffA);
            PG8_WAIT_V(8); PG8_WAIT_L(0); PG8_BAR; PG8_MMA(1, 0, At, B0); PG8_MMA(1, 1, At, B1); PG8_BAR; PG8_SCHED;
        }
        if (wr == 0) PG8_BAR;
        E(acc, cur, ui, wr, wc, fr, fq);
        if (!has_next) break;
#pragma unroll
        for (int a = 0; a < 2; ++a)
#pragma unroll
            for (int b = 0; b < 2; ++b)
#pragma unroll
                for (int m = 0; m < 4; ++m)
#pragma unroll
                    for (int n = 0; n < 2; ++n) acc[a][b][m][n] = (f32x4){0.f, 0.f, 0.f, 0.f};
        cur = nxt; cA = nA; cB = nB; ++ui;
        if (wr == 1) PG8_BAR;
    }
    PG8_WAIT_V(0);
    PG8_BAR;
#undef PG8_SA
#undef PG8_SB
#undef PG8_STAGE
#undef PG8_LDA
#undef PG8_LDB
#undef PG8_MMA
#undef PG8_WAIT_V
#undef PG8_WAIT_L
#undef PG8_BAR
#undef PG8_SCHED
}

#define EPI_ARGS const f32x4 (&acc)[2][2][4][2], const Unit& u, int ui, int wr, int wc, int fr, int fq
#define EPI_ROWS for (int ai = 0; ai < 2; ++ai) _Pragma("unroll") for (int m = 0; m < 4; ++m)
struct EpiSplit {
    bf16_t* O; int ldc; int split_cols; size_t split_stride;
    __device__ __forceinline__ void operator()(EPI_ARGS) const {
        int colt = u.pn * BM; const int t = colt / split_cols; bf16_t* base = O + (size_t)t * split_stride; colt -= t * split_cols;
        const int col0 = colt + wc * 32 + 8 * fq;
#pragma unroll
        EPI_ROWS { bf16_t* rowp = base + (size_t)(u.pm * BM + ai * HALF + wr * 64 + m * 16 + fr) * ldc + col0;
#pragma unroll
            for (int bj = 0; bj < 2; ++bj) *(u32x4*)(rowp + bj * HALF) = pack8(acc[ai][bj][m][0], acc[ai][bj][m][1]); }
    }
};
struct EpiLora1 {
    bf16_t* A2; bf16_t* SG;
    __device__ __forceinline__ void operator()(EPI_ARGS) const {
        bf16_t* base = u.pn == 0 ? A2 : SG; const int col0 = wc * 32 + 8 * fq;
#pragma unroll
        EPI_ROWS { bf16_t* rowp = base + (size_t)(u.pm * BM + ai * HALF + wr * 64 + m * 16 + fr) * 256 + col0;
            f32x4 v0 = acc[ai][0][m][0], v1 = acc[ai][0][m][1];
            if (u.pn == 0) { for (int e = 0; e < 4; ++e) { v0[e] = tanhf_(v0[e]); v1[e] = tanhf_(v1[e]); } }
            else { for (int e = 0; e < 4; ++e) { v0[e] = sigmoidf_(v0[e]); v1[e] = sigmoidf_(v1[e]); } }
            *(u32x4*)(rowp) = pack8(v0, v1);
            f32x4 w0 = acc[ai][1][m][0], w1 = acc[ai][1][m][1];
            if (u.pn != 0) { w0 = (f32x4){0.f, 0.f, 0.f, 0.f}; w1 = w0; }
            *(u32x4*)(rowp + HALF) = pack8(w0, w1); }
    }
};
struct EpiLora2 {
    bf16_t* EW; bf16_t* AA; const float* w0; const float* a0;
    __device__ __forceinline__ void operator()(EPI_ARGS) const {
        const int grp = u.pn >> 2, c0 = (u.pn & 3) * BM + wc * 32 + 8 * fq;
        const float* bias = (grp < 2 ? w0 + grp * D : a0 + (grp - 2) * D) + c0;
        bf16_t* base = (grp < 2 ? EW + (size_t)grp * M * D : AA + (size_t)(grp - 2) * M * D) + c0;
        const float sc = grp < 2 ? 0.60653065971f : 1.0f;
#pragma unroll
        EPI_ROWS { bf16_t* rowp = base + (size_t)(u.pm * BM + ai * HALF + wr * 64 + m * 16 + fr) * D;
#pragma unroll
            for (int bj = 0; bj < 2; ++bj) { f32x4 v0 = acc[ai][bj][m][0] + *(const f32x4*)(bias + bj * HALF), v1 = acc[ai][bj][m][1] + *(const f32x4*)(bias + bj * HALF + 4);
                for (int e = 0; e < 4; ++e) { v0[e] = sigmoidf_(v0[e]) * sc; v1[e] = sigmoidf_(v1[e]) * sc; }
                *(u32x4*)(rowp + bj * HALF) = pack8(v0, v1); } asm volatile("" ::: "memory"); }
    }
};
struct EpiG {
    bf16_t* Z;
    __device__ __forceinline__ void operator()(EPI_ARGS) const {
        const int col0 = u.pn * BM + wc * 32 + 8 * fq;
#pragma unroll
        EPI_ROWS { bf16_t* rowp = Z + (size_t)(u.pm * BM + ai * HALF + wr * 64 + m * 16 + fr) * D + col0;
#pragma unroll
            for (int bj = 0; bj < 2; ++bj) { const u32x4 zw = *(const u32x4*)(rowp + bj * HALF); float z[8]; unpack8(zw, z);
                f32x4 v0 = acc[ai][bj][m][0], v1 = acc[ai][bj][m][1];
                for (int e = 0; e < 4; ++e) { v0[e] *= z[e]; v1[e] *= z[4 + e]; }
                *(u32x4*)(rowp + bj * HALF) = pack8(v0, v1); } if (m & 1) asm volatile("" ::: "memory"); }
    }
};
template <bool BASE_F32> struct EpiRes {
    const float* basef; bf16_t* xb; float* ss;
    __device__ __forceinline__ void operator()(EPI_ARGS) const {
        const int col0 = u.pn * BM + wc * 32 + 8 * fq;
#pragma unroll
        EPI_ROWS { const int row = u.pm * BM + ai * HALF + wr * 64 + m * 16 + fr; const size_t off = (size_t)row * D + col0; float sq = 0.f;
#pragma unroll
            for (int bj = 0; bj < 2; ++bj) { f32x4 b0, b1;
                if (BASE_F32) { const float* bp = basef + off + bj * HALF; b0 = *(const f32x4*)bp; b1 = *(const f32x4*)(bp + 4); }
                else { const u32x4 w = *(const u32x4*)(xb + off + bj * HALF); float t[8]; unpack8(w, t); b0 = (f32x4){t[0], t[1], t[2], t[3]}; b1 = (f32x4){t[4], t[5], t[6], t[7]}; }
                const f32x4 v0 = acc[ai][bj][m][0] + b0, v1 = acc[ai][bj][m][1] + b1;
                *(u32x4*)(xb + off + bj * HALF) = pack8(v0, v1);
                sq += (v0[0] * v0[0] + v0[1] * v0[1]) + (v0[2] * v0[2] + v0[3] * v0[3]) + (v1[0] * v1[0] + v1[1] * v1[1]) + (v1[2] * v1[2] + v1[3] * v1[3]); }
            sq += __shfl_xor(sq, 16); sq += __shfl_xor(sq, 32);
            if (fq == 0) ss[(size_t)row * 16 + u.pn * 4 + wc] = sq; if (m & 1) asm volatile("" ::: "memory"); }
    }
};
struct EpiSq {
    bf16_t* H; const LAS float* RS;
    __device__ __forceinline__ void operator()(EPI_ARGS) const {
        const int col0 = u.pn * BM + wc * 32 + 8 * fq;
#pragma unroll
        EPI_ROWS { const int rl = ai * HALF + wr * 64 + m * 16 + fr; const float rs = RS[ui * 256 + rl]; bf16_t* rowp = H + (size_t)(u.pm * BM + rl) * FF + col0;
#pragma unroll
            for (int bj = 0; bj < 2; ++bj) { f32x4 v0 = acc[ai][bj][m][0] * rs, v1 = acc[ai][bj][m][1] * rs;
                for (int e = 0; e < 4; ++e) { const float a = fmaxf(v0[e], 0.f), b = fmaxf(v1[e], 0.f); v0[e] = a * a; v1[e] = b * b; }
                *(u32x4*)(rowp + bj * HALF) = pack8(v0, v1); } }
    }
};
struct EpiGelu {
    bf16_t* H; const LAS float* RS; f32x2* LNP;
    __device__ __forceinline__ void operator()(EPI_ARGS) const {
        const int col0 = u.pn * BM + wc * 32 + 8 * fq;
#pragma unroll
        EPI_ROWS { const int rl = ai * HALF + wr * 64 + m * 16 + fr; const float rs = RS[ui * 256 + rl]; const int row = u.pm * BM + rl; bf16_t* rowp = H + (size_t)row * FF + col0; float s = 0.f, q = 0.f;
#pragma unroll
            for (int bj = 0; bj < 2; ++bj) { f32x4 v0 = acc[ai][bj][m][0] * rs, v1 = acc[ai][bj][m][1] * rs;
                const f32x2 g0 = gelu_pk((f32x2){v0[0], v0[1]}), g1 = gelu_pk((f32x2){v0[2], v0[3]}), g2 = gelu_pk((f32x2){v1[0], v1[1]}), g3 = gelu_pk((f32x2){v1[2], v1[3]});
                v0 = (f32x4){g0.x, g0.y, g1.x, g1.y}; v1 = (f32x4){g2.x, g2.y, g3.x, g3.y};
                s += (v0[0] + v0[1]) + (v0[2] + v0[3]) + (v1[0] + v1[1]) + (v1[2] + v1[3]);
                q += (v0[0] * v0[0] + v0[1] * v0[1]) + (v0[2] * v0[2] + v0[3] * v0[3]) + (v1[0] * v1[0] + v1[1] * v1[1]) + (v1[2] * v1[2] + v1[3] * v1[3]);
                *(u32x4*)(rowp + bj * HALF) = pack8(v0, v1); }
            if (u.pn >= 8) { s += __shfl_xor(s, 16); s += __shfl_xor(s, 32); q += __shfl_xor(q, 16); q += __shfl_xor(q, 32);
                if (fq == 0) LNP[(size_t)row * 32 + (u.pn - 8) * 4 + wc] = (f32x2){s, q}; } }
    }
};
}

struct Args { const float* in[30]; float* out; unsigned char* ws; int ph_lo, ph_hi; };
struct Frame {
    LAS unsigned char* lds;
    int tid, lane, wave, G;
    float* out; unsigned char* ws;
};
#define LDS_WAIT() asm volatile("s_waitcnt lgkmcnt(0)" ::: "memory")

__device__ __forceinline__ void tr_item(const float* W, int ldw, bf16_t* WT, int ldt, int drow0, int dcol0, const float* ks, LAS float* scr, int k0, int n0, int lane) {
#pragma unroll 8
    for (int i = 0; i < 32; ++i) { const int kk = 2 * i + (lane >> 5); float v = W[(size_t)(k0 + kk) * ldw + n0 + (lane & 31)]; if (ks) v *= ks[k0 + kk]; scr[kk * 33 + (lane & 31)] = v; }
    LDS_WAIT(); asm volatile("" ::: "memory");
    const int c = lane & 7;
#pragma unroll
    for (int j = 0; j < 4; ++j) { const int n = (lane >> 3) + 8 * j; const LAS float* s = scr + (8 * c) * 33 + n;
        u32x4 o; o.x = cvt_pk_bf16(s[0 * 33], s[1 * 33]); o.y = cvt_pk_bf16(s[2 * 33], s[3 * 33]); o.z = cvt_pk_bf16(s[4 * 33], s[5 * 33]); o.w = cvt_pk_bf16(s[6 * 33], s[7 * 33]);
        *(u32x4*)(WT + (size_t)(drow0 + n0 + n) * ldt + dcol0 + k0 + 8 * c) = o; }
    LDS_WAIT(); asm volatile("" ::: "memory");
}
__device__ __forceinline__ void zero_item(bf16_t* WT, int ldt, int row0, int col0, int lane) {
#pragma unroll
    for (int j = 0; j < 4; ++j) { const int q = lane + 64 * j, r = q >> 3, c = q & 7; *(u32x4*)(WT + (size_t)(row0 + r) * ldt + col0 + 8 * c) = (u32x4){0u, 0u, 0u, 0u}; }
}
#define TR_MAT(W, KK, NN, WT, LDT, DR, DC, KS) { const int _n = ((KK) / 64) * ((NN) / 32); if (r < _n) { const int _nb = (NN) / 32; tr_item(W, NN, WT, LDT, DR, DC, KS, scr, 64 * (r / _nb), 32 * (r % _nb), F.lane); continue; } r -= _n; }

__device__ __forceinline__ void p0_phase(Frame& F, const Args& A) {
    LAS float* scr = (LAS float*)(F.lds + F.wave * 16384);
    const int gw = blockIdx.x * NWAVES + F.wave, NGW = F.G * NWAVES;
    bf16_t* WRKV = (bf16_t*)(F.ws + WS_WRKV); bf16_t* WO = (bf16_t*)(F.ws + WS_WO); bf16_t* L1 = (bf16_t*)(F.ws + WS_L1); bf16_t* L2 = (bf16_t*)(F.ws + WS_L2); bf16_t* G2 = (bf16_t*)(F.ws + WS_G2);
    const float* mu = A.in[4];
    constexpr int NZ1 = 128, NZ2 = 128;
    constexpr int NTOT = 4 * 512 + 2 * (4 * 32 + 64) + 4 * 32 + 64 + NZ1 + NZ2;
    for (int it = gw; it < NTOT; it += NGW) {
        int r = it;
        TR_MAT(A.in[5], 1024, 1024, WRKV, 1024, 0, 0, nullptr)
        TR_MAT(A.in[6], 1024, 1024, WRKV, 1024, 1024, 0, nullptr)
        TR_MAT(A.in[7], 1024, 1024, WRKV, 1024, 2048, 0, nullptr)
        TR_MAT(A.in[8], 1024, 1024, WO, 1024, 0, 0, nullptr)
        TR_MAT(A.in[10], 1024, 64, L1, 2048, 0, 0, nullptr)
        TR_MAT(A.in[10] + 1024 * 64, 1024, 64, L1, 2048, 64, 0, nullptr)
        TR_MAT(A.in[13], 1024, 64, L1, 2048, 128, 0, nullptr)
        TR_MAT(A.in[13] + 1024 * 64, 1024, 64, L1, 2048, 192, 0, nullptr)
        TR_MAT(A.in[15], 1024, 128, L1, 2048, 256, 0, nullptr)
        TR_MAT(A.in[10], 1024, 64, L1, 2048, 0, 1024, mu + 1 * D)
        TR_MAT(A.in[10] + 1024 * 64, 1024, 64, L1, 2048, 64, 1024, mu + 1 * D)
        TR_MAT(A.in[13], 1024, 64, L1, 2048, 128, 1024, mu + 4 * D)
        TR_MAT(A.in[13] + 1024 * 64, 1024, 64, L1, 2048, 192, 1024, mu + 4 * D)
        TR_MAT(A.in[15], 1024, 128, L1, 2048, 256, 1024, mu + 5 * D)
        TR_MAT(A.in[11], 64, 1024, L2, 128, 0, 0, nullptr)
        TR_MAT(A.in[11] + 64 * 1024, 64, 1024, L2, 128, 1024, 64, nullptr)
        TR_MAT(A.in[14], 64, 1024, L2, 128, 2048, 0, nullptr)
        TR_MAT(A.in[14] + 64 * 1024, 64, 1024, L2, 128, 3072, 64, nullptr)
        TR_MAT(A.in[16], 128, 1024, G2, 128, 0, 0, nullptr)
        if (r < NZ1) { zero_item(L1, 2048, 384 + 32 * (r / 32), 64 * (r % 32), F.lane); continue; } r -= NZ1;
        { const int grp = r / 32; zero_item(L2, 128, 32 * r, 64 * (1 - (grp & 1)), F.lane); }
    }
    const float* x = A.in[0]; const float* gn = A.in[1];
    bf16_t* XNXX = (bf16_t*)F.out; bf16_t* XR = (bf16_t*)(F.ws + WS_XR);
    f32x4 gv[4], m0[4], m2[4], m3[4];
#pragma unroll
    for (int j = 0; j < 4; ++j) { gv[j] = ((const f32x4*)gn)[64 * j + F.lane]; m0[j] = ((const f32x4*)mu)[64 * j + F.lane]; m2[j] = ((const f32x4*)(mu + 2 * D))[64 * j + F.lane]; m3[j] = ((const f32x4*)(mu + 3 * D))[64 * j + F.lane]; }
    for (int m = gw; m < M; m += NGW) {
        const int t = m & (T - 1); const bool hp = t > 0, hn = t < T - 1;
        const f32x4* xc = (const f32x4*)(x + (size_t)m * D) + F.lane; const f32x4* xp = xc - D / 4; const f32x4* xq = xc + D / 4;
        f32x4 vc[4], vp[4], vn[4]; float sc = 0.f, sp = 0.f, sn = 0.f; const f32x4 z4 = {0.f, 0.f, 0.f, 0.f};
#pragma unroll
        for (int j = 0; j < 4; ++j) { vc[j] = xc[64 * j]; vp[j] = hp ? xp[64 * j] : z4; vn[j] = hn ? xq[64 * j] : z4;
            sc += (vc[j].x * vc[j].x + vc[j].y * vc[j].y) + (vc[j].z * vc[j].z + vc[j].w * vc[j].w);
            sp += (vp[j].x * vp[j].x + vp[j].y * vp[j].y) + (vp[j].z * vp[j].z + vp[j].w * vp[j].w);
            sn += (vn[j].x * vn[j].x + vn[j].y * vn[j].y) + (vn[j].z * vn[j].z + vn[j].w * vn[j].w); }
        const float rc = 1.0f / sqrtf(wave_sum(sc) * (1.f / D) + NORM_EPS), rp = 1.0f / sqrtf(wave_sum(sp) * (1.f / D) + NORM_EPS), rn = 1.0f / sqrtf(wave_sum(sn) * (1.f / D) + NORM_EPS);
#pragma unroll
        for (int j = 0; j < 4; ++j) { const int col = 4 * (64 * j + F.lane);
            const f32x4 a = vc[j] * rc * gv[j], xx = (vp[j] * rp + vn[j] * rn) * gv[j] * 0.5f - a;
            const f32x4 vr = a + xx * m0[j], vk = a + xx * m2[j], vv = a + xx * m3[j];
            *(u32x2*)(XNXX + (size_t)m * 2048 + col) = (u32x2){cvt_pk_bf16(a[0], a[1]), cvt_pk_bf16(a[2], a[3])};
            *(u32x2*)(XNXX + (size_t)m * 2048 + 1024 + col) = (u32x2){cvt_pk_bf16(xx[0], xx[1]), cvt_pk_bf16(xx[2], xx[3])};
            *(u32x2*)(XR + (size_t)m * D + col) = (u32x2){cvt_pk_bf16(vr[0], vr[1]), cvt_pk_bf16(vr[2], vr[3])};
            *(u32x2*)(XR + (size_t)M * D + (size_t)m * D + col) = (u32x2){cvt_pk_bf16(vk[0], vk[1]), cvt_pk_bf16(vk[2], vk[3])};
            *(u32x2*)(XR + 2 * (size_t)M * D + (size_t)m * D + col) = (u32x2){cvt_pk_bf16(vv[0], vv[1]), cvt_pk_bf16(vv[2], vv[3])}; }
    }
}

__device__ __forceinline__ void convB_phase(Frame& F, const Args& A) {
    LAS float* scr = (LAS float*)(F.lds + F.wave * 16384);
    const int gw = blockIdx.x * NWAVES + F.wave, NGW = F.G * NWAVES;
    bf16_t* W1_0 = (bf16_t*)(F.ws + WS_W1_0); bf16_t* W2_0 = (bf16_t*)(F.ws + WS_W2_0); bf16_t* WIN = (bf16_t*)(F.ws + WS_WIN); bf16_t* WOUT = (bf16_t*)(F.ws + WS_WOUT);
    bf16_t* WSB = (bf16_t*)(F.ws + WS_WSB); bf16_t* W1_1 = (bf16_t*)(F.ws + WS_W1_1); bf16_t* W2_1 = (bf16_t*)(F.ws + WS_W2_1);
    constexpr int NTOT = 5 * 2048 + 1024 + 512;
    for (int it = gw; it < NTOT; it += NGW) {
        int r = it;
        TR_MAT(A.in[28], 1024, 4096, W1_0, 1024, 0, 0, A.in[2])
        TR_MAT(A.in[29], 4096, 1024, W2_0, 4096, 0, 0, nullptr)
        TR_MAT(A.in[22], 1024, 4096, WIN, 1024, 0, 0, A.in[1] + D)
        TR_MAT(A.in[28] + (size_t)D * FF, 1024, 4096, W1_1, 1024, 0, 0, A.in[2] + D)
        TR_MAT(A.in[29] + (size_t)D * FF, 4096, 1024, W2_1, 4096, 0, 0, nullptr)
        TR_MAT(A.in[27], 2048, 1024, WOUT, 2048, 0, 0, nullptr)
        { const float* s = A.in[25] + (size_t)r * 512 + F.lane * 8; const f32x4 a = *(const f32x4*)s, b = *(const f32x4*)(s + 4); *(u32x4*)(WSB + (size_t)r * 512 + F.lane * 8) = pack8(a, b); }
    }
}

constexpr int TC = 16, NCH = T / TC, SREC = 336;
template <int VAR>
__device__ __forceinline__ void scan_phase(Frame& F, const Args& A) {
    LAS float* BUF = (LAS float*)(F.lds);
    LAS float* OP = (LAS float*)(F.lds + 2 * TC * SREC * 4);
    const int tid = F.tid, lane = F.lane, wave = F.wave;
    const bool prod = wave >= 4; const int ptid = tid - 256;
    const bf16_t* Rg = (const bf16_t*)(F.ws + WS_R); const bf16_t* Kg = (const bf16_t*)(F.ws + WS_K); const bf16_t* Vg = (const bf16_t*)(F.ws + WS_V);
    const bf16_t* EWg = (const bf16_t*)F.out; const bf16_t* AAg = (const bf16_t*)(F.ws + WS_AA); bf16_t* ODg = (bf16_t*)(F.ws + WS_OD);
    for (int it0 = blockIdx.x; it0 < 256; it0 += F.G) {
        const int item = (F.G == 256) ? ((it0 & 7) * 32 + (it0 >> 3)) : it0;
        const int chain = item >> 2, quarter = item & 3, dir = chain & 1, bh = chain >> 1, b = bh >> 4, h = bh & 15, row0 = quarter * 16;
        const size_t boff = (size_t)b * T * D + h * 64;
        const bf16_t* Rp = Rg + boff; const bf16_t* Kp = Kg + boff; const bf16_t* Vp = Vg + boff;
        const bf16_t* Ep = EWg + (size_t)dir * M * D + boff; const bf16_t* Ap = AAg + (size_t)dir * M * D + boff; bf16_t* Op = ODg + (size_t)dir * M * D + boff + row0;
        const int pw = wave - 4, tq = lane >> 4, c4 = (lane & 15) * 4;
        u32x2 raw[4][5];
#pragma unroll
        for (int j = 0; j < 4; ++j) for (int q = 0; q < 5; ++q) raw[j][q] = (u32x2){0u, 0u};
        f32x4 kk4 = {0, 0, 0, 0}, ka4 = {0, 0, 0, 0};
        if (prod) { kk4 = *(const f32x4*)(A.in[17] + h * 64 + c4); ka4 = *(const f32x4*)(A.in[18] + h * 64 + c4); }
        asm volatile("s_waitcnt vmcnt(0)" : "+v"(kk4), "+v"(ka4) :: "memory");
#define SC_LOAD(c) do { _Pragma("unroll") for (int j = 0; j < 4; ++j) { const int step = (c) * TC + tq + 4 * j; const int tt = dir ? (T - 1 - step) : step; const size_t o = (size_t)tt * D + c4; \
        raw[j][0] = *(const u32x2*)(Rp + o); raw[j][1] = *(const u32x2*)(Kp + o); raw[j][2] = *(const u32x2*)(Vp + o); raw[j][3] = *(const u32x2*)(Ep + o); raw[j][4] = *(const u32x2*)(Ap + o); } } while (0)
#define SC_PROC(c) do { _Pragma("unroll") for (int j = 0; j < 4; ++j) { const int tl = tq + 4 * j; const u32x2 rr = raw[j][0], rk = raw[j][1], rv = raw[j][2], re = raw[j][3], ra = raw[j][4]; \
        const f32x4 r4 = {bf_lo(rr.x), bf_hi(rr.x), bf_lo(rr.y), bf_hi(rr.y)}, k4 = {bf_lo(rk.x), bf_hi(rk.x), bf_lo(rk.y), bf_hi(rk.y)}, v4 = {bf_lo(rv.x), bf_hi(rv.x), bf_lo(rv.y), bf_hi(rv.y)}; \
        const f32x4 e4 = {bf_lo(re.x), bf_hi(re.x), bf_lo(re.y), bf_hi(re.y)}, a4 = {bf_lo(ra.x), bf_hi(ra.x), bf_lo(ra.y), bf_hi(ra.y)}; \
        f32x4 kk = k4 * kk4; float ss = (kk[0] * kk[0] + kk[1] * kk[1]) + (kk[2] * kk[2] + kk[3] * kk[3]); ss = row16_allsum(ss); \
        const float inv = __builtin_amdgcn_rsqf(fmaxf(ss, 1e-24f)); kk = kk * inv; \
        f32x4 dec; dec[0] = __expf(-e4[0]); dec[1] = __expf(-e4[1]); dec[2] = __expf(-e4[2]); dec[3] = __expf(-e4[3]); \
        const f32x4 kd = k4 * (1.0f + (a4 - 1.0f) * ka4); \
        LAS float* dst = BUF + ((c) & 1) * TC * SREC + tl * SREC + c4; \
        *(LAS f32x4*)(dst) = dec; *(LAS f32x4*)(dst + 64) = -kk; *(LAS f32x4*)(dst + 128) = kk * a4; *(LAS f32x4*)(dst + 192) = kd; *(LAS f32x4*)(dst + 256) = r4; \
        if ((c4 >> 4) == quarter) *(LAS f32x4*)(BUF + ((c) & 1) * TC * SREC + tl * SREC + 320 + c4 - row0) = v4; } } while (0)
#define SC_RED(c, ok) do { const int row = lane & 15; const LAS float* src = OP + ((c) & 1) * TC * 256 + tq * 1024 + ((row >> 2) * 64 + (row & 3) * 16) * 4; \
        f32x4 o4 = {0.f, 0.f, 0.f, 0.f}; \
        _Pragma("unroll") for (int j = 0; j < 16; ++j) o4 += *(const LAS f32x4*)(src + (((j + row) & 15) << 2));     \
        _Pragma("unroll") for (int e = 0; e < 4; ++e) { const int step = (c) * TC + 4 * tq + e; const int tt = dir ? (T - 1 - step) : step; \
            if (ok) Op[(size_t)tt * D + row] = (bf16_t)(cvt_pk_bf16(o4[e], 0.f) & 0xffffu); } } while (0)
        if (prod) { SC_LOAD(pw); if (pw == 0) { SC_PROC(0); SC_LOAD(4); } }
        __syncthreads();
        f32x2 S01 = {0.f, 0.f}, S23 = {0.f, 0.f};
        const int ks = lane & 15, rl = lane >> 4;
        for (int c0 = 0; c0 < NCH; c0 += 4) {
#pragma unroll
        for (int cj = 0; cj < 4; ++cj) { const int c = c0 + cj;
            if (!prod || VAR == 5) { if (VAR != 2) {
                const LAS float* bp = BUF + (c & 1) * TC * SREC + ks * 4; const LAS float* vp = BUF + (c & 1) * TC * SREC + 320 + wave * 4 + rl;
                LAS float* op = OP + (c & 1) * TC * 256 + tid * 4;
                f32x4 oq = {0.f, 0.f, 0.f, 0.f};
                constexpr int PD = 2;
                f32x4 pw[PD], pa[PD], pb[PD], pk[PD], pr[PD]; float pv[PD];
#pragma unroll
                for (int j = 0; j < PD; ++j) { const LAS float* q = bp + j * SREC; pw[j] = *(const LAS f32x4*)(q); pa[j] = *(const LAS f32x4*)(q + 64); pb[j] = *(const LAS f32x4*)(q + 128); pk[j] = *(const LAS f32x4*)(q + 192); pr[j] = *(const LAS f32x4*)(q + 256); pv[j] = vp[j * SREC]; }
#pragma unroll
                for (int i = 0; i < TC; ++i) {
                    const int sl = i % PD;
                    const f32x4 w = pw[sl], a = pa[sl], bb = pb[sl], k = pk[sl], r = pr[sl]; const float v = pv[sl];
                    if (VAR != 3 && VAR != 5 && i + PD < TC) { const LAS float* q = bp + (i + PD) * SREC; pw[sl] = *(const LAS f32x4*)(q); pa[sl] = *(const LAS f32x4*)(q + 64); pb[sl] = *(const LAS f32x4*)(q + 128); pk[sl] = *(const LAS f32x4*)(q + 192); pr[sl] = *(const LAS f32x4*)(q + 256); pv[sl] = vp[(i + PD) * SREC]; }
                    f32x2 p = S01 * (f32x2){a[0], a[1]}; p = S23 * (f32x2){a[2], a[3]} + p;
                    float sa = p.x + p.y; if (VAR != 4) sa = row16_allsum(sa);
                    const f32x2 vk01 = (f32x2){k[0], k[1]} * v, vk23 = (f32x2){k[2], k[3]} * v;
                    const f32x2 t01 = (f32x2){bb[0], bb[1]} * sa + vk01, t23 = (f32x2){bb[2], bb[3]} * sa + vk23;
                    S01 = S01 * (f32x2){w[0], w[1]} + t01; S23 = S23 * (f32x2){w[2], w[3]} + t23;
                    f32x2 q2 = S01 * (f32x2){r[0], r[1]}; q2 = S23 * (f32x2){r[2], r[3]} + q2;
                    oq[i & 3] = q2.x + q2.y; if ((i & 3) == 3) *(LAS f32x4*)(op + (i >> 2) * 1024) = oq;
                }
            } } else if (VAR == 0 || VAR == 2) {
                if (pw == ((cj + 1) & 3)) { SC_PROC(c + 1); const int cl = (c + 5 < NCH) ? (c + 5) : (NCH - 1); SC_LOAD(cl); }
                if (pw == ((cj + 3) & 3)) { const int cr = c >= 1 ? c - 1 : 0; const bool ok = c >= 1 && VAR == 0; SC_RED(cr, ok); }
            }
            asm volatile("s_waitcnt lgkmcnt(0)" ::: "memory"); __builtin_amdgcn_s_barrier(); asm volatile("" ::: "memory");
        } }
        if (pw == 0) SC_RED(NCH - 1, VAR == 0);
        __syncthreads();
#undef SC_LOAD
#undef SC_PROC
#undef SC_RED
    }
}

__device__ __forceinline__ void z_phase(Frame& F, const Args& A) {
    const int gw = blockIdx.x * NWAVES + F.wave, NGW = F.G * NWAVES, col = F.lane * 16;
    const bf16_t* Rg = (const bf16_t*)(F.ws + WS_R); const bf16_t* Kg = (const bf16_t*)(F.ws + WS_K); const bf16_t* Vg = (const bf16_t*)(F.ws + WS_V);
    const bf16_t* A0 = (const bf16_t*)(F.ws + WS_AA); const bf16_t* A1 = A0 + (size_t)M * D; bf16_t* OF = (bf16_t*)(F.ws + WS_OD); const bf16_t* OB = OF + (size_t)M * D;
    float ka[16], rkc[16], lg[16], lb[16];
#pragma unroll
    for (int i = 0; i < 16; ++i) { ka[i] = A.in[18][col + i]; rkc[i] = A.in[19][col + i]; lg[i] = A.in[20][col + i]; lb[i] = A.in[21][col + i]; }
    for (int m = gw; m < M; m += NGW) {
        const size_t o = (size_t)m * D + col;
        float of[16], ob[16], r[16], k[16], v[16], a0[16], a1[16];
#define LD16(dst, P) { const u32x4 _a = *(const u32x4*)((P) + o), _b = *(const u32x4*)((P) + o + 8); float _t[8]; unpack8(_a, _t); for (int i = 0; i < 8; ++i) dst[i] = _t[i]; unpack8(_b, _t); for (int i = 0; i < 8; ++i) dst[8 + i] = _t[i]; }
        LD16(of, OF) LD16(ob, OB) LD16(r, Rg) LD16(k, Kg) LD16(v, Vg) LD16(a0, A0) LD16(a1, A1)
#undef LD16
        float s = 0.f, dot = 0.f;
#pragma unroll
        for (int i = 0; i < 16; ++i) { of[i] += ob[i]; s += of[i]; dot += r[i] * rkc[i] * k[i] * (2.0f + (a0[i] + a1[i] - 2.0f) * ka[i]); }
        s += __shfl_xor(s, 1); s += __shfl_xor(s, 2); dot += __shfl_xor(dot, 1); dot += __shfl_xor(dot, 2);
        const float mean = s * (1.f / 64.f); float q = 0.f;
#pragma unroll
        for (int i = 0; i < 16; ++i) { of[i] -= mean; q += of[i] * of[i]; }
        q += __shfl_xor(q, 1); q += __shfl_xor(q, 2);
        const float rstd = 1.0f / sqrtf(q * (1.f / 64.f) + GN_EPS);
        float z[16];
#pragma unroll
        for (int i = 0; i < 16; ++i) z[i] = of[i] * rstd * lg[i] + lb[i] + dot * v[i];
        u32x4 w0, w1; w0.x = cvt_pk_bf16(z[0], z[1]); w0.y = cvt_pk_bf16(z[2], z[3]); w0.z = cvt_pk_bf16(z[4], z[5]); w0.w = cvt_pk_bf16(z[6], z[7]);
        w1.x = cvt_pk_bf16(z[8], z[9]); w1.y = cvt_pk_bf16(z[10], z[11]); w1.z = cvt_pk_bf16(z[12], z[13]); w1.w = cvt_pk_bf16(z[14], z[15]);
        *(u32x4*)(OF + o) = w0; *(u32x4*)(OF + o + 8) = w1;
    }
}

__device__ __forceinline__ void rs_table(Frame& F, const pg8::StaticOrder& S) {
    LAS float* RS = (LAS float*)(F.lds + RS_OFF); const float* SS = (const float*)(F.ws + WS_SS);
    pg8::Unit u;
    for (int i = 0; i < 8 && S.next(i, u); ++i) {
        if (F.tid < 256) { const f32x4* p = (const f32x4*)(SS + (size_t)(u.pm * 256 + F.tid) * 16); const f32x4 a = p[0], b = p[1], c = p[2], d = p[3]; const f32x4 t = (a + b) + (c + d);
            RS[i * 256 + F.tid] = 1.0f / sqrtf(((t[0] + t[1]) + (t[2] + t[3])) * (1.f / D) + NORM_EPS); }
    }
    __syncthreads();
}

__device__ __forceinline__ void spatial_phase(Frame& F, const Args& A) {
    constexpr int LDW = 136;
    LAS bf16_t* WL = (LAS bf16_t*)(F.lds); LAS bf16_t* VL = (LAS bf16_t*)(F.lds + 128 * LDW * 2); LAS f32x2* ST = (LAS f32x2*)(F.lds + 2 * 128 * LDW * 2);
    bf16_t* H = (bf16_t*)(F.ws + WS_H); const bf16_t* WSB = (const bf16_t*)(F.ws + WS_WSB); const f32x2* LNP = (const f32x2*)(F.ws + WS_LNP);
    const float* lng = A.in[23]; const float* lnb = A.in[24]; const float* bs = A.in[26];
    const int tid = F.tid, lane = F.lane, wave = F.wave, fr = lane & 15, fq = lane >> 4;
    const int i0 = (wave >> 1) * 32, d0 = (wave & 1) * 64, cc = tid & 15;
    int gcur = -1; float gam[8], bet[8], bsv[2];
#pragma unroll
    for (int e = 0; e < 8; ++e) { gam[e] = 0.f; bet[e] = 0.f; }
    bsv[0] = bsv[1] = 0.f;
    u32x4 vraw[4]; f32x4 lnp[4];
#define SP_PREF(un_) do { const int c_ = (un_) >> 4, g_ = (un_) & 15; \
        _Pragma("unroll") for (int i = 0; i < 4; ++i) { const int j = (tid + 512 * i) >> 4; vraw[i] = *(const u32x4*)(H + (size_t)(c_ * 128 + j) * FF + 2048 + g_ * 128 + cc * 8); } \
        const f32x4* p_ = (const f32x4*)(LNP + (size_t)(c_ * 128 + (tid >> 2)) * 32) + (tid & 3) * 4; \
        _Pragma("unroll") for (int i = 0; i < 4; ++i) lnp[i] = p_[i]; } while (0)
    int un = blockIdx.x;
    if (un < 2048) SP_PREF(un);
    for (; un < 2048; un += F.G) {
        const int c = un >> 4, g = un & 15;
        if (g != gcur) {
            __syncthreads();
#pragma unroll
            for (int i = 0; i < 4; ++i) { const int q = tid + 512 * i, row = q >> 4, c8 = q & 15; *(LAS u32x4*)(WL + row * LDW + c8 * 8) = *(const u32x4*)(WSB + (size_t)g * 16384 + row * 128 + c8 * 8); }
#pragma unroll
            for (int e = 0; e < 8; ++e) { gam[e] = lng[g * 128 + cc * 8 + e]; bet[e] = lnb[g * 128 + cc * 8 + e]; }
            bsv[0] = bs[g * 128 + i0 + fr]; bsv[1] = bs[g * 128 + i0 + 16 + fr];
            gcur = g;
        }
        { float s_ = 0.f, q_ = 0.f;
#pragma unroll
          for (int i = 0; i < 4; ++i) { s_ += lnp[i][0] + lnp[i][2]; q_ += lnp[i][1] + lnp[i][3]; }
          s_ += __shfl_xor(s_, 1); s_ += __shfl_xor(s_, 2); q_ += __shfl_xor(q_, 1); q_ += __shfl_xor(q_, 2);
          const float mean = s_ * (1.f / 2048.f), var = q_ * (1.f / 2048.f) - mean * mean;
          if ((tid & 3) == 0) ST[tid >> 2] = (f32x2){mean, 1.0f / sqrtf(fmaxf(var, 0.f) + NORM_EPS)}; }
        __syncthreads();
#pragma unroll
        for (int i = 0; i < 4; ++i) { const int j = (tid + 512 * i) >> 4; float v[8]; unpack8(vraw[i], v);
            const f32x2 st = ST[j];
            for (int e = 0; e < 8; ++e) v[e] = (v[e] - st.x) * st.y * gam[e] + bet[e];
            u32x4 w; w.x = cvt_pk_bf16(v[0], v[1]); w.y = cvt_pk_bf16(v[2], v[3]); w.z = cvt_pk_bf16(v[4], v[5]); w.w = cvt_pk_bf16(v[6], v[7]);
            *(LAS u32x4*)(VL + j * LDW + cc * 8) = w; }
        __syncthreads();
        u32x2 uw[2][4];
#pragma unroll
        for (int mb = 0; mb < 2; ++mb) { const bf16_t* up = H + (size_t)(c * 128 + i0 + mb * 16 + fr) * FF + g * 128 + d0 + 4 * fq;
#pragma unroll
            for (int nb = 0; nb < 4; ++nb) uw[mb][nb] = *(const u32x2*)(up + nb * 16); }
        if (un + F.G < 2048) SP_PREF(un + F.G);
        f32x4 acc[2][4];
#pragma unroll
        for (int mb = 0; mb < 2; ++mb)
#pragma unroll
            for (int nb = 0; nb < 4; ++nb) acc[mb][nb] = (f32x4){0.f, 0.f, 0.f, 0.f};
#pragma unroll
        for (int kk = 0; kk < 4; ++kk) {
            bf16x8 wf[2], vf[4];
#pragma unroll
            for (int mb = 0; mb < 2; ++mb) wf[mb] = *(const LAS bf16x8*)(WL + (i0 + mb * 16 + fr) * LDW + kk * 32 + fq * 8);
#pragma unroll
            for (int nb = 0; nb < 4; ++nb) { const LAS bf16_t* p = VL + (kk * 32 + fq * 8) * LDW + d0 + nb * 16 + fr;
#pragma unroll
                for (int e = 0; e < 8; ++e) vf[nb][e] = (short)p[e * LDW]; }
#pragma unroll
            for (int mb = 0; mb < 2; ++mb)
#pragma unroll
                for (int nb = 0; nb < 4; ++nb) acc[mb][nb] = __builtin_amdgcn_mfma_f32_16x16x32_bf16(vf[nb], wf[mb], acc[mb][nb], 0, 0, 0);
        }
#pragma unroll
        for (int mb = 0; mb < 2; ++mb) { bf16_t* up = H + (size_t)(c * 128 + i0 + mb * 16 + fr) * FF + g * 128 + d0 + 4 * fq;
#pragma unroll
            for (int nb = 0; nb < 4; ++nb) { const f32x4 a = acc[mb][nb]; const u32x2 w = uw[mb][nb];
                const float o0 = (a[0] + bsv[mb]) * bf_lo(w.x), o1 = (a[1] + bsv[mb]) * bf_hi(w.x), o2 = (a[2] + bsv[mb]) * bf_lo(w.y), o3 = (a[3] + bsv[mb]) * bf_hi(w.y);
                *(u32x2*)(up + nb * 16) = (u32x2){cvt_pk_bf16(o0, o1), cvt_pk_bf16(o2, o3)}; } }
    }
#undef SP_PREF
    __syncthreads();
}

__device__ __forceinline__ void final_phase(Frame& F, const Args& A) {
    const int gw = blockIdx.x * NWAVES + F.wave, NGW = F.G * NWAVES, col = F.lane * 16;
    const bf16_t* XBp = (const bf16_t*)(F.ws + WS_XB);
    float gv[16];
#pragma unroll
    for (int i = 0; i < 16; ++i) gv[i] = A.in[3][col + i];
    for (int m = gw; m < M; m += NGW) {
        const u32x4 a = *(const u32x4*)(XBp + (size_t)m * D + col), b = *(const u32x4*)(XBp + (size_t)m * D + col + 8);
        float v[16]; { float t[8]; unpack8(a, t); for (int i = 0; i < 8; ++i) v[i] = t[i]; unpack8(b, t); for (int i = 0; i < 8; ++i) v[8 + i] = t[i]; }
        float s = 0.f;
#pragma unroll
        for (int i = 0; i < 16; ++i) s += v[i] * v[i];
        const float rs = 1.0f / sqrtf(wave_sum(s) * (1.f / D) + NORM_EPS);
        float* op = F.out + (size_t)m * D + col;
#pragma unroll
        for (int i = 0; i < 16; i += 4) *(f32x4*)(op + i) = (f32x4){v[i] * rs * gv[i], v[i + 1] * rs * gv[i + 1], v[i + 2] * rs * gv[i + 2], v[i + 3] * rs * gv[i + 3]};
    }
}

#define XB_TMO      128
#define XB_XCNT(j)  (256  + 64 * (j))
#define XB_XSUB(j)  (1280 + 64 * (j))
#define XB_XGEN(j)  (2304 + 64 * (j))
#define XB_TOP      3328
#define XB_TOPGEN   3392
#define XCD_BAR_WORDS 3456
#define XB_SPIN_CAP (1u << 18)
__device__ __forceinline__ unsigned xb_ld(unsigned* p)              { return __hip_atomic_load(p, __ATOMIC_RELAXED, __HIP_MEMORY_SCOPE_AGENT); }
__device__ __forceinline__ unsigned xb_add(unsigned* p, unsigned v) { return __hip_atomic_fetch_add(p, v, __ATOMIC_RELAXED, __HIP_MEMORY_SCOPE_AGENT); }
__device__ __forceinline__ unsigned xb_xcc_id() { return (unsigned)__builtin_amdgcn_s_getreg((3 << 11) | 20) & 0xFu; }
#define XB_SPIN(cond, bar) do { unsigned _sp = 0; while (cond) { __builtin_amdgcn_s_sleep(1); \
    if ((++_sp & 255u) == 0u) { if (xb_ld(&(bar)[XB_TMO])) break; if (_sp > XB_SPIN_CAP) { atomicAdd(&(bar)[XB_TMO], 1u); break; } } } } while (0)
struct XcdBarrier { unsigned* bar; unsigned x; volatile LAS unsigned* st; };
__device__ __forceinline__ XcdBarrier xcd_barrier_post(unsigned* bar, volatile LAS unsigned* st) {
    XcdBarrier b; b.bar = bar; b.x = xb_xcc_id(); b.st = st;
    if (threadIdx.x == 0) (void)xb_add(&bar[XB_XCNT(b.x)], 1u);
    return b;
}
__device__ __forceinline__ void xcd_barrier_complete(unsigned* bar, unsigned x, unsigned& nloc, unsigned& nx) {
    const unsigned G = gridDim.x * gridDim.y * gridDim.z;
    unsigned sum, cnt, mine, sp = 0u;
    for (;;) {
        sum = 0u; cnt = 0u; mine = 0u;
#pragma unroll
        for (unsigned j = 0; j < 16; ++j) { const unsigned c = xb_ld(&bar[XB_XCNT(j)]); sum += c; cnt += (c > 0u) ? 1u : 0u; mine = (j == x) ? c : mine; }
        if (sum == G) break;
        __builtin_amdgcn_s_sleep(1);
        if ((++sp & 255u) == 0u) { if (xb_ld(&bar[XB_TMO])) break; if (sp > XB_SPIN_CAP) { atomicAdd(&bar[XB_TMO], 1u); break; } }
    }
    nloc = mine > 0u ? mine : 1u; nx = cnt > 0u ? cnt : 1u;
}
__device__ __forceinline__ void xcd_barrier(const XcdBarrier& b) {
    asm volatile("s_waitcnt vmcnt(0)" ::: "memory");
    __syncthreads();
    if (threadIdx.x == 0) {
        unsigned* bar = b.bar;
        __builtin_amdgcn_s_waitcnt(0);
        unsigned nloc = b.st[0], nx = b.st[1];
        if (nloc == 0u) { xcd_barrier_complete(bar, b.x, nloc, nx); b.st[0] = nloc; b.st[1] = nx; }
        const unsigned old = xb_add(&bar[XB_XSUB(b.x)], 1u);
        const unsigned gen = old / nloc;
        if (old + 1u == (gen + 1u) * nloc) {
            __builtin_amdgcn_fence(__ATOMIC_RELEASE, "agent");
            asm volatile("s_waitcnt vmcnt(0)" ::: "memory");
            const unsigned og = xb_add(&bar[XB_TOP], 1u);
            const unsigned tg = og / nx;
            if (og + 1u == (tg + 1u) * nx) xb_add(&bar[XB_TOPGEN], 1u);
            else XB_SPIN(xb_ld(&bar[XB_TOPGEN]) == tg, bar);
            __builtin_amdgcn_fence(__ATOMIC_ACQUIRE, "agent");
            xb_add(&bar[XB_XGEN(b.x)], 1u);
            asm volatile("s_waitcnt vmcnt(0)" ::: "memory");
        } else {
            XB_SPIN(xb_ld(&bar[XB_XGEN(b.x)]) == gen, bar);
            __builtin_amdgcn_fence(__ATOMIC_ACQUIRE, "agent");
            asm volatile("s_waitcnt vmcnt(0)" ::: "memory");
        }
    }
    __syncthreads();
}

struct EpiFinal {
    const bf16_t* base; float* out; const float* g; float* ss; XcdBarrier xb;
    __device__ __forceinline__ void operator()(f32x4 (&acc)[2][2][4][2], const pg8::Unit& u, int ui, int wr, int wc, int fr, int fq) const {
        using namespace pg8;
        const int col0 = u.pn * BM + wc * 32 + 8 * fq;
#pragma unroll
        for (int ai = 0; ai < 2; ++ai)
#pragma unroll
            for (int m = 0; m < 4; ++m) { const int row = u.pm * BM + ai * HALF + wr * 64 + m * 16 + fr; const size_t off = (size_t)row * D + col0; float sq = 0.f;
#pragma unroll
                for (int bj = 0; bj < 2; ++bj) { const u32x4 w = *(const u32x4*)(base + off + bj * HALF); float t[8]; unpack8(w, t); const f32x4 b0 = {t[0], t[1], t[2], t[3]}, b1 = {t[4], t[5], t[6], t[7]};
                    const f32x4 v0 = acc[ai][bj][m][0] + b0, v1 = acc[ai][bj][m][1] + b1; acc[ai][bj][m][0] = v0; acc[ai][bj][m][1] = v1;
                    sq += (v0[0] * v0[0] + v0[1] * v0[1]) + (v0[2] * v0[2] + v0[3] * v0[3]) + (v1[0] * v1[0] + v1[1] * v1[1]) + (v1[2] * v1[2] + v1[3] * v1[3]); }
                sq += __shfl_xor(sq, 16); sq += __shfl_xor(sq, 32);
                if (fq == 0) ss[(size_t)row * 16 + u.pn * 4 + wc] = sq; if (m & 1) asm volatile("" ::: "memory"); }
        xcd_barrier(xb);
        f32x4 gv[2][2];
#pragma unroll
        for (int bj = 0; bj < 2; ++bj) { gv[bj][0] = *(const f32x4*)(g + col0 + bj * HALF); gv[bj][1] = *(const f32x4*)(g + col0 + bj * HALF + 4); }
#pragma unroll
        for (int ai = 0; ai < 2; ++ai)
#pragma unroll
            for (int m = 0; m < 4; ++m) { const int row = u.pm * BM + ai * HALF + wr * 64 + m * 16 + fr; const size_t off = (size_t)row * D + col0;
                const f32x4* p = (const f32x4*)(ss + (size_t)row * 16); const f32x4 t = (p[0] + p[1]) + (p[2] + p[3]);
                const float rs = 1.0f / sqrtf(((t[0] + t[1]) + (t[2] + t[3])) * (1.f / D) + NORM_EPS);
#pragma unroll
                for (int bj = 0; bj < 2; ++bj) { float* op = out + off + bj * HALF; *(f32x4*)op = acc[ai][bj][m][0] * rs * gv[bj][0]; *(f32x4*)(op + 4) = acc[ai][bj][m][1] * rs * gv[bj][1]; }
                if (m & 1) asm volatile("" ::: "memory"); }
    }
};

constexpr int NPHASE = 15;
__global__ void __launch_bounds__(NTHR, 2) fwd_kernel(Args args) {
    extern __shared__ __attribute__((aligned(16))) unsigned char lds_raw[];
    Frame F;
    F.lds = (LAS unsigned char*)lds_raw; F.tid = threadIdx.x; F.lane = F.tid & 63; F.wave = __builtin_amdgcn_readfirstlane(F.tid >> 6); F.G = gridDim.x;
    F.out = args.out; F.ws = args.ws;
    const int lo = args.ph_lo, hi = args.ph_hi;
    cg::grid_group grid = cg::this_grid();
    volatile LAS unsigned* MISC = (volatile LAS unsigned*)(F.lds + RING_BYTES + 512);
    if (F.tid < 2) MISC[F.tid] = 0u;
    __syncthreads();
    XcdBarrier xbar = xcd_barrier_post((unsigned*)(args.ws + WS_BAR), MISC);
#ifndef PHMASK
#define PHMASK 0x7fff
#endif
#define IN(k) (((PHMASK >> (k)) & 1) && lo <= (k) && (k) < hi)
#define SEAM(k) do { if (IN(k) && IN((k) + 1)) { if (hi > 1000) grid.sync(); else xcd_barrier(xbar); } } while (0)
    unsigned char* ws = args.ws;
    bf16_t* XB = (bf16_t*)(ws + WS_XB); bf16_t* HB = (bf16_t*)(ws + WS_H); float* SS = (float*)(ws + WS_SS);
    const LAS float* RS = (const LAS float*)(F.lds + RS_OFF);
    const int bx = blockIdx.x;

    if (IN(0)) { p0_phase(F, args); }
    SEAM(0);
    if (IN(1)) {
        __syncthreads();
        const bool bal = (F.G == 256);
        { pg8::Gemm g{(const bf16_t*)F.out, (const bf16_t*)(ws + WS_L1), M, 512, 2048, 2048, 1 << 20, 0}; pg8::StaticOrder S;
          if (bal) S.init_sub(M, 512, 128, bx >= 128 ? bx - 128 : -1, 0, 1); else S.init(M, 512, F.G, bx);
          pg8::EpiLora1 E{(bf16_t*)(ws + WS_A2), (bf16_t*)(ws + WS_SG)}; pg8::gemm_phase(F.lds, g, S, E); }
        { pg8::Gemm g{(const bf16_t*)(ws + WS_XR), (const bf16_t*)(ws + WS_WRKV), M, 3072, 1024, 1024, 4, (size_t)M * D * 2}; pg8::StaticOrder S;
          if (bal) { if (bx < 128) S.init_sub(M, 3072, 128, bx, 0, 4); else S.init_sub(M, 3072, 128, bx - 128, 512, 2); } else S.init(M, 3072, F.G, bx);
          pg8::EpiSplit E{(bf16_t*)(ws + WS_R), D, D, (size_t)M * D}; pg8::gemm_phase(F.lds, g, S, E); }
    }
    SEAM(1);
    if (IN(2)) {
        pg8::Gemm g{(const bf16_t*)(ws + WS_A2), (const bf16_t*)(ws + WS_L2), M, 4096, 128, 256, 8, 256}; pg8::StaticOrder S; S.init(M, 4096, F.G, bx);
        pg8::EpiLora2 E{(bf16_t*)F.out, (bf16_t*)(ws + WS_AA), args.in[9], args.in[12]}; pg8::gemm_phase(F.lds, g, S, E);
    }
    SEAM(2);
    if (IN(3)) { scan_phase<0>(F, args); }
    SEAM(3);
    if (IN(4)) { z_phase(F, args); }
    SEAM(4);
    if (IN(5)) {
        convB_phase(F, args); __syncthreads();
        pg8::Gemm g{(const bf16_t*)(ws + WS_SG), (const bf16_t*)(ws + WS_G2), M, 1024, 128, 256, 1 << 20, 0}; pg8::StaticOrder S; S.init(M, 1024, F.G, bx);
        pg8::EpiG E{(bf16_t*)(ws + WS_OD)}; pg8::gemm_phase(F.lds, g, S, E);
    }
    SEAM(5);
    if (IN(6)) {
        pg8::Gemm g{(const bf16_t*)(ws + WS_OD), (const bf16_t*)(ws + WS_WO), M, 1024, 1024, 1024, 1 << 20, 0}; pg8::StaticOrder S; S.init(M, 1024, F.G, bx);
        pg8::EpiRes<true> E{args.in[0], XB, SS}; pg8::gemm_phase(F.lds, g, S, E);
    }
    SEAM(6);
    if (IN(7)) {
        pg8::Gemm g{XB, (const bf16_t*)(ws + WS_W1_0), M, FF, 1024, 1024, 1 << 20, 0}; pg8::StaticOrder S; S.init(M, FF, F.G, bx);
        rs_table(F, S);
        pg8::EpiSq E{HB, RS}; pg8::gemm_phase(F.lds, g, S, E);
    }
    SEAM(7);
    if (IN(8)) {
        pg8::Gemm g{HB, (const bf16_t*)(ws + WS_W2_0), M, 1024, FF, FF, 1 << 20, 0}; pg8::StaticOrder S; S.init(M, 1024, F.G, bx);
        pg8::EpiRes<false> E{nullptr, XB, SS}; pg8::gemm_phase(F.lds, g, S, E);
    }
    SEAM(8);
    if (IN(9)) {
        pg8::Gemm g{XB, (const bf16_t*)(ws + WS_WIN), M, FF, 1024, 1024, 1 << 20, 0}; pg8::StaticOrder S; S.init(M, FF, F.G, bx);
        rs_table(F, S);
        pg8::EpiGelu E{HB, RS, (f32x2*)(ws + WS_LNP)}; pg8::gemm_phase(F.lds, g, S, E);
    }
    SEAM(9);
    if (IN(10)) { __syncthreads(); spatial_phase(F, args); }
    SEAM(10);
    if (IN(11)) {
        __syncthreads();
        pg8::Gemm g{HB, (const bf16_t*)(ws + WS_WOUT), M, 1024, 2048, FF, 1 << 20, 0}; pg8::StaticOrder S; S.init(M, 1024, F.G, bx);
        pg8::EpiRes<false> E{nullptr, XB, SS}; pg8::gemm_phase(F.lds, g, S, E);
    }
    SEAM(11);
    if (IN(12)) {
        pg8::Gemm g{XB, (const bf16_t*)(ws + WS_W1_1), M, FF, 1024, 1024, 1 << 20, 0}; pg8::StaticOrder S; S.init(M, FF, F.G, bx);
        rs_table(F, S);
        pg8::EpiSq E{HB, RS}; pg8::gemm_phase(F.lds, g, S, E);
    }
    SEAM(12);
    const bool fuse_final = IN(13) && IN(14) && F.G == 256;
    if (IN(13)) {
        pg8::Gemm g{HB, (const bf16_t*)(ws + WS_W2_1), M, 1024, FF, FF, 1 << 20, 0}; pg8::StaticOrder S; S.init(M, 1024, F.G, bx);
        if (fuse_final) { EpiFinal E{XB, F.out, args.in[3], SS, xbar}; pg8::gemm_phase(F.lds, g, S, E); }
        else { pg8::EpiRes<false> E{nullptr, XB, SS}; pg8::gemm_phase(F.lds, g, S, E); }
    }
    if (!fuse_final) { SEAM(13); }
    if (IN(14) && !fuse_final) { final_phase(F, args); }
}

extern "C" void kernel_launch(void* const* d_in, const int* in_sizes, int n_in, void* d_out, int out_size, void* d_ws, size_t ws_size, hipStream_t stream) {
    static int grid = 0;
    if (grid == 0) {
        if (n_in != 30 || out_size != M * D || ws_size < WS_END) { fprintf(stderr, "kernel_launch: unexpected shapes (n_in %d out %d ws %zu)\n", n_in, out_size, ws_size); grid = -1; return; }
        int dev = 0, cus = 0, per_cu = 0;
        (void)hipGetDevice(&dev); (void)hipDeviceGetAttribute(&cus, hipDeviceAttributeMultiprocessorCount, dev);
        (void)hipFuncSetAttribute((const void*)fwd_kernel, hipFuncAttributeMaxDynamicSharedMemorySize, LDS_BYTES);
        (void)hipOccupancyMaxActiveBlocksPerMultiprocessor(&per_cu, (const void*)fwd_kernel, NTHR, LDS_BYTES);
        if (per_cu < 1) { fprintf(stderr, "kernel_launch: occupancy query says %d blocks per CU\n", per_cu); per_cu = 1; }
        (void)hipGetLastError();
        grid = cus;
        if (grid > 256) grid = 256;
    }
    if (grid < 0) return;
    if (hipMemsetAsync((char*)d_ws + WS_BAR, 0, 16384, stream) != hipSuccess) { fprintf(stderr, "memset failed\n"); return; }
    Args a{};
    for (int i = 0; i < 30; ++i) a.in[i] = (const float*)d_in[i];
    a.out = (float*)d_out; a.ws = (unsigned char*)d_ws;
#if MK_SINGLE
    a.ph_lo = 0; a.ph_hi = NPHASE;
    void* kargs[] = {&a};
    hipError_t e = hipLaunchCooperativeKernel((const void*)fwd_kernel, dim3(grid), dim3(NTHR), kargs, LDS_BYTES, stream);
    if (e != hipSuccess) fprintf(stderr, "cooperative launch failed: %s (grid %d)\n", hipGetErrorString(e), grid);
#else
    for (int p = 0; p < NPHASE; ++p) { a.ph_lo = p; a.ph_hi = p + 1; hipLaunchKernelGGL(fwd_kernel, dim3(grid), dim3(NTHR), LDS_BYTES, stream, a); }
#endif
}
```

```cpp
#include <hip/hip_runtime.h>
#include <hip/hip_cooperative_groups.h>
#include <cstdio>
#include <cstdint>
namespace cg = cooperative_groups;

#ifndef MK_SINGLE
#define MK_SINGLE 1
#endif

#define LAS __attribute__((address_space(3)))
typedef unsigned short bf16_t;
typedef short bf16x8 __attribute__((ext_vector_type(8)));
typedef float f32x4 __attribute__((ext_vector_type(4)));
typedef float f32x2 __attribute__((ext_vector_type(2)));
typedef unsigned u32x4 __attribute__((ext_vector_type(4)));
typedef unsigned u32x2 __attribute__((ext_vector_type(2)));

constexpr int BATCH = 2, T = 8192, D = 1024, FF = 4096, M = BATCH * T;
constexpr int NWAVES = 8, NTHR = 512;
constexpr float NORM_EPS = 1e-5f, GN_EPS = 64e-5f;

constexpr size_t MiB = 1u << 20;
constexpr size_t WS_SS = 0;
constexpr size_t WS_BAR = 1 * MiB + 65536;
constexpr size_t WS_WRKV = 2 * MiB;
constexpr size_t WS_WO = 8 * MiB;
constexpr size_t WS_L1 = 10 * MiB;
constexpr size_t WS_L2 = 12 * MiB;
constexpr size_t WS_G2 = 14 * MiB;
constexpr size_t WS_R = 15 * MiB, WS_K = 47 * MiB, WS_V = 79 * MiB;
constexpr size_t WS_XR = 111 * MiB;
constexpr size_t WS_AA = 111 * MiB;
constexpr size_t WS_OD = 175 * MiB;
constexpr size_t WS_A2 = 239 * MiB;
constexpr size_t WS_SG = 247 * MiB;
constexpr size_t WS_W1_0 = 15 * MiB, WS_W2_0 = 23 * MiB, WS_WIN = 31 * MiB, WS_WOUT = 39 * MiB, WS_WSB = 43 * MiB, WS_W1_1 = 44 * MiB, WS_W2_1 = 52 * MiB;
constexpr size_t WS_XB = 60 * MiB;
constexpr size_t WS_H = 92 * MiB;
constexpr size_t WS_LNP = 220 * MiB;
constexpr size_t WS_END = 256 * MiB;

constexpr int RING_BYTES = 131072, RS_OFF = RING_BYTES + 1024, LDS_BYTES = 147456;

__device__ __forceinline__ unsigned cvt_pk_bf16(float lo, float hi) { unsigned r; asm volatile("v_cvt_pk_bf16_f32 %0, %1, %2" : "=v"(r) : "v"(lo), "v"(hi)); return r; }
__device__ __forceinline__ float bf_lo(unsigned w) { return __builtin_bit_cast(float, w << 16); }
__device__ __forceinline__ float bf_hi(unsigned w) { return __builtin_bit_cast(float, w & 0xffff0000u); }
__device__ __forceinline__ float wave_sum(float v) {
#pragma unroll
    for (int o = 1; o < 64; o <<= 1) v += __shfl_xor(v, o);
    return v;
}
template <int CTRL> __device__ __forceinline__ float dpp_f(float x) { return __builtin_bit_cast(float, __builtin_amdgcn_update_dpp(0, __builtin_bit_cast(int, x), CTRL, 0xF, 0xF, true)); }
__device__ __forceinline__ float row16_allsum(float x) { x += dpp_f<0x128>(x); x += dpp_f<0x124>(x); x += dpp_f<0x122>(x); x += dpp_f<0x121>(x); return x; }
__device__ __forceinline__ float sigmoidf_(float x) { return __builtin_amdgcn_rcpf(1.0f + __expf(-x)); }
__device__ __forceinline__ float tanhf_(float x) { return 1.0f - 2.0f * __builtin_amdgcn_rcpf(__expf(2.0f * x) + 1.0f); }
__device__ __forceinline__ f32x2 gelu_pk(f32x2 v) {
    const f32x2 av = __builtin_elementwise_abs(v), d = av * 0.2316418882f + 1.0f;
    f32x2 t; t.x = __builtin_amdgcn_rcpf(d.x); t.y = __builtin_amdgcn_rcpf(d.y);
    f32x2 q = t * 0.5307027145f + (-0.7265760135f); q = q * t + 0.7107068705f; q = q * t + (-0.142248368f); q = q * t + 0.127414796f; q = q * t;
    const f32x2 s = (v * v) * (-0.72134752044f);
    f32x2 e; e.x = __builtin_amdgcn_exp2f(s.x); e.y = __builtin_amdgcn_exp2f(s.y);
    const f32x2 m = v * (q * e), r = v - m;
    f32x2 o; o.x = v.x < 0.f ? m.x : r.x; o.y = v.y < 0.f ? m.y : r.y; return o;
}
__device__ __forceinline__ u32x4 pack8(const f32x4 a, const f32x4 b) { u32x4 w; w.x = cvt_pk_bf16(a[0], a[1]); w.y = cvt_pk_bf16(a[2], a[3]); w.z = cvt_pk_bf16(b[0], b[1]); w.w = cvt_pk_bf16(b[2], b[3]); return w; }
__device__ __forceinline__ void unpack8(const u32x4 w, float (&f)[8]) { f[0] = bf_lo(w.x); f[1] = bf_hi(w.x); f[2] = bf_lo(w.y); f[3] = bf_hi(w.y); f[4] = bf_lo(w.z); f[5] = bf_hi(w.z); f[6] = bf_lo(w.w); f[7] = bf_hi(w.w); }

namespace pg8 {
constexpr int BM = 256, BK = 64, HALF = 128, HTB = HALF * BK * 2, NXCD = 8, WGM = 4;
__host__ __device__ __forceinline__ int lds_byte(int r, int c) { const int st = (r >> 4) * 2 + (c >> 5), rr = r & 15, cc = c & 31, ob = rr * 64 + cc * 2; return st * 1024 + (ob ^ (((ob >> 9) & 1) << 5)); }
__host__ __device__ __forceinline__ void stage_rc(int b, int& R, int& C) { const int st = b / 1024, sb = b % 1024, swz = sb ^ (((sb >> 9) & 1) << 5); R = (st >> 1) * 16 + swz / 64; C = (st & 1) * 32 + (swz % 64) / 2; }
__host__ __device__ __forceinline__ int perm32(int rho) { const int n = rho >> 4, i = rho & 15; return 8 * (i >> 2) + 4 * n + (i & 3); }

struct Unit { int pm, pn; };
struct Gemm { const bf16_t* A; const bf16_t* Bt; int M, N, K, lda; int agrp; size_t astride; };

struct StaticOrder {
    int nM, nN, nwg, G, c, L0, cnt;
    __host__ __device__ void init(int M_, int N_, int G_, int c_) { nM = M_ / BM; nN = N_ / BM; nwg = nM * nN; G = G_; c = c_; L0 = 0; cnt = 1 << 20; }
    __host__ __device__ void init_sub(int M_, int N_, int G_, int c_, int L0_, int cnt_) { init(M_, N_, G_, c_); L0 = L0_; cnt = cnt_; }
    __host__ __device__ bool next(int i, Unit& u) const {
        if (i >= cnt || c < 0) return false;
        const long L = (long)L0 + (long)i * G + c; if (L >= nwg) return false;
        int wgid = (int)L; { const int q = nwg / NXCD, r = nwg % NXCD, xcd = wgid % NXCD, off = wgid / NXCD; wgid = (xcd < r ? xcd * (q + 1) : r * (q + 1) + (xcd - r) * q) + off; }
        const int nig = WGM * nN, gid = wgid / nig, fm = gid * WGM, gsz = (nM - fm) < WGM ? (nM - fm) : WGM;
        u.pm = fm + ((wgid % nig) % gsz); u.pn = (wgid % nig) / gsz; return true;
    }
};

template <class Epi>
__device__ __forceinline__ void gemm_phase(LAS unsigned char* lds, const Gemm g, const StaticOrder& S, const Epi& E) {
    const int tid = threadIdx.x, wid = __builtin_amdgcn_readfirstlane(tid >> 6), lane = tid & 63, wr = wid >> 2, wc = wid & 3, fr = lane & 15, fq = lane >> 4;
    const int K = g.K, nt = K / BK;
    unsigned voffA[2], voffB[2];
#pragma unroll
    for (int i = 0; i < 2; ++i) { int R, C; stage_rc(tid * 16 + i * 8192, R, C); const int Rb = (R & ~31) + perm32(R & 31);
        voffA[i] = (unsigned)(R * g.lda + C) * 2u; voffB[i] = (unsigned)(Rb * K + C) * 2u; }
    const size_t kstep = (size_t)(BK * 2);
    const size_t hA = (size_t)HALF * g.lda * 2, tA = 2 * hA, hB = (size_t)HALF * K * 2, tB = 2 * hB;
    const unsigned ldsw = (unsigned)wid * 1024u;
    const int aoff = lds_byte(wr * 64 + fr, fq * 8), boff = lds_byte(wc * 32 + fr, fq * 8);
#define PG8_SA(b, h) (((b) * 2 + (h)) * HTB)
#define PG8_SB(b, h) ((4 + (b) * 2 + (h)) * HTB)
#define PG8_STAGE(bufoff, gbase, voff) do { _Pragma("unroll") for (int _i = 0; _i < 2; ++_i) \
        __builtin_amdgcn_global_load_lds((const unsigned*)((const char*)(gbase) + (voff)[_i]), (LAS unsigned*)(lds + (bufoff) + ldsw + _i * 8192), 16, 0, 0); } while (0)
#define PG8_LDA(dst, b, h) do { _Pragma("unroll") for (int m = 0; m < 4; ++m) _Pragma("unroll") for (int k = 0; k < 2; ++k) dst[m][k] = *(const LAS bf16x8*)(lds + PG8_SA(b, h) + aoff + m * 2048 + k * 1024); } while (0)
#define PG8_LDB(dst, b, h) do { _Pragma("unroll") for (int n = 0; n < 2; ++n) _Pragma("unroll") for (int k = 0; k < 2; ++k) dst[n][k] = *(const LAS bf16x8*)(lds + PG8_SB(b, h) + boff + n * 2048 + k * 1024); } while (0)
#define PG8_MMA(ai, bj, At, Bt) do { __builtin_amdgcn_s_setprio(1); _Pragma("unroll") for (int m = 0; m < 4; ++m) _Pragma("unroll") for (int n = 0; n < 2; ++n) _Pragma("unroll") for (int k = 0; k < 2; ++k) \
        acc[ai][bj][m][n] = __builtin_amdgcn_mfma_f32_16x16x32_bf16(Bt[n][k], At[m][k], acc[ai][bj][m][n], 0, 0, 0); __builtin_amdgcn_s_setprio(0); } while (0)
#define PG8_WAIT_V(n) asm volatile("s_waitcnt vmcnt(" #n ")" ::: "memory")
#define PG8_WAIT_L(n) asm volatile("s_waitcnt lgkmcnt(" #n ")" ::: "memory")
#define PG8_BAR __builtin_amdgcn_s_barrier()
#define PG8_SCHED __builtin_amdgcn_sched_barrier(0)
    Unit cur, nxt; int ui = 0;
    if (!S.next(0, cur)) return;
    f32x4 acc[2][2][4][2];
#pragma unroll
    for (int a = 0; a < 2; ++a)
#pragma unroll
        for (int b = 0; b < 2; ++b)
#pragma unroll
            for (int m = 0; m < 4; ++m)
#pragma unroll
                for (int n = 0; n < 2; ++n) acc[a][b][m][n] = (f32x4){0.f, 0.f, 0.f, 0.f};
    bf16x8 At[4][2], B0[2][2], B1[2][2];
    const char* cA = (const char*)g.A + (size_t)cur.pm * tA + (size_t)(cur.pn / g.agrp) * g.astride; const char* cB = (const char*)g.Bt + (size_t)cur.pn * tB;
    PG8_STAGE(PG8_SB(0, 0), cB, voffB); PG8_STAGE(PG8_SB(0, 1), cB + hB, voffB); PG8_STAGE(PG8_SA(0, 0), cA, voffA); PG8_STAGE(PG8_SA(0, 1), cA + hA, voffA);
    if (wr == 1) PG8_BAR;
    PG8_WAIT_V(2); PG8_BAR;
    PG8_STAGE(PG8_SB(1, 0), cB + kstep, voffB); PG8_STAGE(PG8_SA(1, 0), cA + kstep, voffA); PG8_STAGE(PG8_SB(1, 1), cB + hB + kstep, voffB);
    PG8_WAIT_V(6); PG8_BAR;
    for (;;) {
        const bool has_next = S.next(ui + 1, nxt);
        const char* nA = has_next ? (const char*)g.A + (size_t)nxt.pm * tA + (size_t)(nxt.pn / g.agrp) * g.astride : cA; const char* nB = has_next ? (const char*)g.Bt + (size_t)nxt.pn * tB : cB;
#pragma nounroll
        for (int t = 0; t < nt; t += 2) {
            const bool last = (t == nt - 2);
            const char* a1 = cA + (size_t)(t + 1) * kstep;
            const char* a2 = last ? nA : cA + (size_t)(t + 2) * kstep; const char* b2 = last ? nB : cB + (size_t)(t + 2) * kstep;
            const char* a3 = a2 + kstep; const char* b3 = b2 + kstep;
            PG8_LDB(B0, 0, 0); PG8_LDB(B1, 0, 1); PG8_SCHED; PG8_LDA(At, 0, 0); PG8_STAGE(PG8_SA(1, 1), a1 + hA, voffA);
            PG8_WAIT_V(8); PG8_WAIT_L(0); PG8_BAR; PG8_MMA(0, 0, At, B0); PG8_MMA(0, 1, At, B1); PG8_BAR; PG8_SCHED;
            PG8_LDA(At, 0, 1); PG8_STAGE(PG8_SB(0, 0), b2, voffB); PG8_STAGE(PG8_SB(0, 1), b2 + hB, voffB); PG8_STAGE(PG8_SA(0, 0), a2, voffA);
            PG8_WAIT_V(8); PG8_WAIT_L(0); PG8_BAR; PG8_MMA(1, 0, At, B0); PG8_MMA(1, 1, At, B1); PG8_BAR; PG8_SCHED;
            PG8_LDB(B0, 1, 0); PG8_LDB(B1, 1, 1); PG8_SCHED; PG8_LDA(At, 1, 0); PG8_STAGE(PG8_SA(0, 1), a2 + hA, voffA);
            PG8_WAIT_V(8); PG8_WAIT_L(0); PG8_BAR; PG8_MMA(0, 0, At, B0); PG8_MMA(0, 1, At, B1); PG8_BAR; PG8_SCHED;
            PG8_LDA(At, 1, 1); PG8_STAGE(PG8_SB(1, 0), b3, voffB); PG8_STAGE(PG8_SB(1, 1), b3 + hB, voffB); PG8_STAGE(PG8_SA(1, 0), a3, voffA);
            PG8_WAIT_V(8); PG8_WAIT_L(0); PG8_BAR; PG8_MMA(1, 0, At, B0); PG8_MMA(1, 1, At, B1); PG8_BAR; PG8_SCHED;
        }
        if (wr == 0) PG8_BAR;
        E(acc, cur, ui, wr, wc, fr, fq);
        if (!has_next) break;
#pragma unroll
        for (int a = 0; a < 2; ++a)
#pragma unroll
            for (int b = 0; b < 2; ++b)
#pragma unroll
                for (int m = 0; m < 4; ++m)
#pragma unroll
                    for (int n = 0; n < 2; ++n) acc[a][b][m][n] = (f32x4){0.f, 0.f, 0.f, 0.f};
        cur = nxt; cA = nA; cB = nB; ++ui;
        if (wr == 1) PG8_BAR;
    }
    PG8_WAIT_V(0);
    PG8_BAR;
#undef PG8_SA
#undef PG8_SB
#undef PG8_STAGE
#undef PG8_LDA
#undef PG8_LDB
#undef PG8_MMA
#undef PG8_WAIT_V
#undef PG8_WAIT_L
#undef PG8_BAR
#undef PG8_SCHED
}

#define EPI_ARGS const f32x4 (&acc)[2][2][4][2], const Unit& u, int ui, int wr, int wc, int fr, int fq
#define EPI_ROWS for (int ai = 0; ai < 2; ++ai) _Pragma("unroll") for (int m = 0; m < 4; ++m)
struct EpiSplit {
    bf16_t* O; int ldc; int split_cols; size_t split_stride;
    __device__ __forceinline__ void operator()(EPI_ARGS) const {
        int colt = u.pn * BM; const int t = colt / split_cols; bf16_t* base = O + (size_t)t * split_stride; colt -= t * split_cols;
        const int col0 = colt + wc * 32 + 8 * fq;
#pragma unroll
        EPI_ROWS { bf16_t* rowp = base + (size_t)(u.pm * BM + ai * HALF + wr * 64 + m * 16 + fr) * ldc + col0;
#pragma unroll
            for (int bj = 0; bj < 2; ++bj) *(u32x4*)(rowp + bj * HALF) = pack8(acc[ai][bj][m][0], acc[ai][bj][m][1]); }
    }
};
struct EpiLora1 {
    bf16_t* A2; bf16_t* SG;
    __device__ __forceinline__ void operator()(EPI_ARGS) const {
        bf16_t* base = u.pn == 0 ? A2 : SG; const int col0 = wc * 32 + 8 * fq;
#pragma unroll
        EPI_ROWS { bf16_t* rowp = base + (size_t)(u.pm * BM + ai * HALF + wr * 64 + m * 16 + fr) * 256 + col0;
            f32x4 v0 = acc[ai][0][m][0], v1 = acc[ai][0][m][1];
            if (u.pn == 0) { for (int e = 0; e < 4; ++e) { v0[e] = tanhf_(v0[e]); v1[e] = tanhf_(v1[e]); } }
            else { for (int e = 0; e < 4; ++e) { v0[e] = sigmoidf_(v0[e]); v1[e] = sigmoidf_(v1[e]); } }
            *(u32x4*)(rowp) = pack8(v0, v1);
            f32x4 w0 = acc[ai][1][m][0], w1 = acc[ai][1][m][1];
            if (u.pn != 0) { w0 = (f32x4){0.f, 0.f, 0.f, 0.f}; w1 = w0; }
            *(u32x4*)(rowp + HALF) = pack8(w0, w1); }
    }
};
struct EpiLora2 {
    bf16_t* EW; bf16_t* AA; const float* w0; const float* a0;
    __device__ __forceinline__ void operator()(EPI_ARGS) const {
        const int grp = u.pn >> 2, c0 = (u.pn & 3) * BM + wc * 32 + 8 * fq;
        const float* bias = (grp < 2 ? w0 + grp * D : a0 + (grp - 2) * D) + c0;
        bf16_t* base = (grp < 2 ? EW + (size_t)grp * M * D : AA + (size_t)(grp - 2) * M * D) + c0;
        const float sc = grp < 2 ? 0.60653065971f : 1.0f;
#pragma unroll
        EPI_ROWS { bf16_t* rowp = base + (size_t)(u.pm * BM + ai * HALF + wr * 64 + m * 16 + fr) * D;
#pragma unroll
            for (int bj = 0; bj < 2; ++bj) { f32x4 v0 = acc[ai][bj][m][0] + *(const f32x4*)(bias + bj * HALF), v1 = acc[ai][bj][m][1] + *(const f32x4*)(bias + bj * HALF + 4);
                for (int e = 0; e < 4; ++e) { v0[e] = sigmoidf_(v0[e]) * sc; v1[e] = sigmoidf_(v1[e]) * sc; }
                *(u32x4*)(rowp + bj * HALF) = pack8(v0, v1); } if (m & 1) asm volatile("" ::: "memory"); }
    }
};
struct EpiG {
    bf16_t* Z;
    __device__ __forceinline__ void operator()(EPI_ARGS) const {
        const int col0 = u.pn * BM + wc * 32 + 8 * fq;
#pragma unroll
        EPI_ROWS { bf16_t* rowp = Z + (size_t)(u.pm * BM + ai * HALF + wr * 64 + m * 16 + fr) * D + col0;
#pragma unroll
            for (int bj = 0; bj < 2; ++bj) { const u32x4 zw = *(const u32x4*)(rowp + bj * HALF); float z[8]; unpack8(zw, z);
                f32x4 v0 = acc[ai][bj][m][0], v1 = acc[ai][bj][m][1];
                for (int e = 0; e < 4; ++e) { v0[e] *= z[e]; v1[e] *= z[4 + e]; }
                *(u32x4*)(rowp + bj * HALF) = pack8(v0, v1); } if (m & 1) asm volatile("" ::: "memory"); }
    }
};
template <bool BASE_F32> struct EpiRes {
    const float* basef; bf16_t* xb; float* ss;
    __device__ __forceinline__ void operator()(EPI_ARGS) const {
        const int col0 = u.pn * BM + wc * 32 + 8 * fq;
#pragma unroll
        EPI_ROWS { const int row = u.pm * BM + ai * HALF + wr * 64 + m * 16 + fr; const size_t off = (size_t)row * D + col0; float sq = 0.f;
#pragma unroll
            for (int bj = 0; bj < 2; ++bj) { f32x4 b0, b1;
                if (BASE_F32) { const float* bp = basef + off + bj * HALF; b0 = *(const f32x4*)bp; b1 = *(const f32x4*)(bp + 4); }
                else { const u32x4 w = *(const u32x4*)(xb + off + bj * HALF); float t[8]; unpack8(w, t); b0 = (f32x4){t[0], t[1], t[2], t[3]}; b1 = (f32x4){t[4], t[5], t[6], t[7]}; }
                const f32x4 v0 = acc[ai][bj][m][0] + b0, v1 = acc[ai][bj][m][1] + b1;
                *(u32x4*)(xb + off + bj * HALF) = pack8(v0, v1);
                sq += (v0[0] * v0[0] + v0[1] * v0[1]) + (v0[2] * v0[2] + v0[3] * v0[3]) + (v1[0] * v1[0] + v1[1] * v1[1]) + (v1[2] * v1[2] + v1[3] * v1[3]); }
            sq += __shfl_xor(sq, 16); sq += __shfl_xor(sq, 32);
            if (fq == 0) ss[(size_t)row * 16 + u.pn * 4 + wc] = sq; if (m & 1) asm volatile("" ::: "memory"); }
    }
};
struct EpiSq {
    bf16_t* H; const LAS float* RS;
    __device__ __forceinline__ void operator()(EPI_ARGS) const {
        const int col0 = u.pn * BM + wc * 32 + 8 * fq;
#pragma unroll
        EPI_ROWS { const int rl = ai * HALF + wr * 64 + m * 16 + fr; const float rs = RS[ui * 256 + rl]; bf16_t* rowp = H + (size_t)(u.pm * BM + rl) * FF + col0;
#pragma unroll
            for (int bj = 0; bj < 2; ++bj) { f32x4 v0 = acc[ai][bj][m][0] * rs, v1 = acc[ai][bj][m][1] * rs;
                for (int e = 0; e < 4; ++e) { const float a = fmaxf(v0[e], 0.f), b = fmaxf(v1[e], 0.f); v0[e] = a * a; v1[e] = b * b; }
                *(u32x4*)(rowp + bj * HALF) = pack8(v0, v1); } }
    }
};
struct EpiGelu {
    bf16_t* H; const LAS float* RS; f32x2* LNP;
    __device__ __forceinline__ void operator()(EPI_ARGS) const {
        const int col0 = u.pn * BM + wc * 32 + 8 * fq;
#pragma unroll
        EPI_ROWS { const int rl = ai * HALF + wr * 64 + m * 16 + fr; const float rs = RS[ui * 256 + rl]; const int row = u.pm * BM + rl; bf16_t* rowp = H + (size_t)row * FF + col0; float s = 0.f, q = 0.f;
#pragma unroll
            for (int bj = 0; bj < 2; ++bj) { f32x4 v0 = acc[ai][bj][m][0] * rs, v1 = acc[ai][bj][m][1] * rs;
                const f32x2 g0 = gelu_pk((f32x2){v0[0], v0[1]}), g1 = gelu_pk((f32x2){v0[2], v0[3]}), g2 = gelu_pk((f32x2){v1[0], v1[1]}), g3 = gelu_pk((f32x2){v1[2], v1[3]});
                v0 = (f32x4){g0.x, g0.y, g1.x, g1.y}; v1 = (f32x4){g2.x, g2.y, g3.x, g3.y};
                s += (v0[0] + v0[1]) + (v0[2] + v0[3]) + (v1[0] + v1[1]) + (v1[2] + v1[3]);
                q += (v0[0] * v0[0] + v0[1] * v0[1]) + (v0[2] * v0[2] + v0[3] * v0[3]) + (v1[0] * v1[0] + v1[1] * v1[1]) + (v1[2] * v1[2] + v1[3] * v1[3]);
                *(u32x4*)(rowp + bj * HALF) = pack8(v0, v1); }
            if (u.pn >= 8) { s += __shfl_xor(s, 16); s += __shfl_xor(s, 32); q += __shfl_xor(q, 16); q += __shfl_xor(q, 32);
                if (fq == 0) LNP[(size_t)row * 32 + (u.pn - 8) * 4 + wc] = (f32x2){s, q}; } }
    }
};
}

struct Args { const float* in[30]; float* out; unsigned char* ws; int ph_lo, ph_hi; };
struct Frame {
    LAS unsigned char* lds;
    int tid, lane, wave, G;
    float* out; unsigned char* ws;
};
#define LDS_WAIT() asm volatile("s_waitcnt lgkmcnt(0)" ::: "memory")

__device__ __forceinline__ void tr_item(const float* W, int ldw, bf16_t* WT, int ldt, int drow0, int dcol0, const float* ks, LAS float* scr, int k0, int n0, int lane) {
#pragma unroll 8
    for (int i = 0; i < 32; ++i) { const int kk = 2 * i + (lane >> 5); float v = W[(size_t)(k0 + kk) * ldw + n0 + (lane & 31)]; if (ks) v *= ks[k0 + kk]; scr[kk * 33 + (lane & 31)] = v; }
    LDS_WAIT(); asm volatile("" ::: "memory");
    const int c = lane & 7;
#pragma unroll
    for (int j = 0; j < 4; ++j) { const int n = (lane >> 3) + 8 * j; const LAS float* s = scr + (8 * c) * 33 + n;
        u32x4 o; o.x = cvt_pk_bf16(s[0 * 33], s[1 * 33]); o.y = cvt_pk_bf16(s[2 * 33], s[3 * 33]); o.z = cvt_pk_bf16(s[4 * 33], s[5 * 33]); o.w = cvt_pk_bf16(s[6 * 33], s[7 * 33]);
        *(u32x4*)(WT + (size_t)(drow0 + n0 + n) * ldt + dcol0 + k0 + 8 * c) = o; }
    LDS_WAIT(); asm volatile("" ::: "memory");
}
__device__ __forceinline__ void zero_item(bf16_t* WT, int ldt, int row0, int col0, int lane) {
#pragma unroll
    for (int j = 0; j < 4; ++j) { const int q = lane + 64 * j, r = q >> 3, c = q & 7; *(u32x4*)(WT + (size_t)(row0 + r) * ldt + col0 + 8 * c) = (u32x4){0u, 0u, 0u, 0u}; }
}
#define TR_MAT(W, KK, NN, WT, LDT, DR, DC, KS) { const int _n = ((KK) / 64) * ((NN) / 32); if (r < _n) { const int _nb = (NN) / 32; tr_item(W, NN, WT, LDT, DR, DC, KS, scr, 64 * (r / _nb), 32 * (r % _nb), F.lane); continue; } r -= _n; }

__device__ __forceinline__ void p0_phase(Frame& F, const Args& A) {
    LAS float* scr = (LAS float*)(F.lds + F.wave * 16384);
    const int gw = blockIdx.x * NWAVES + F.wave, NGW = F.G * NWAVES;
    bf16_t* WRKV = (bf16_t*)(F.ws + WS_WRKV); bf16_t* WO = (bf16_t*)(F.ws + WS_WO); bf16_t* L1 = (bf16_t*)(F.ws + WS_L1); bf16_t* L2 = (bf16_t*)(F.ws + WS_L2); bf16_t* G2 = (bf16_t*)(F.ws + WS_G2);
    const float* mu = A.in[4];
    constexpr int NZ1 = 128, NZ2 = 128;
    constexpr int NTOT = 4 * 512 + 2 * (4 * 32 + 64) + 4 * 32 + 64 + NZ1 + NZ2;
    for (int it = gw; it < NTOT; it += NGW) {
        int r = it;
        TR_MAT(A.in[5], 1024, 1024, WRKV, 1024, 0, 0, nullptr)
        TR_MAT(A.in[6], 1024, 1024, WRKV, 1024, 1024, 0, nullptr)
        TR_MAT(A.in[7], 1024, 1024, WRKV, 1024, 2048, 0, nullptr)
        TR_MAT(A.in[8], 1024, 1024, WO, 1024, 0, 0, nullptr)
        TR_MAT(A.in[10], 1024, 64, L1, 2048, 0, 0, nullptr)
        TR_MAT(A.in[10] + 1024 * 64, 1024, 64, L1, 2048, 64, 0, nullptr)
        TR_MAT(A.in[13], 1024, 64, L1, 2048, 128, 0, nullptr)
        TR_MAT(A.in[13] + 1024 * 64, 1024, 64, L1, 2048, 192, 0, nullptr)
        TR_MAT(A.in[15], 1024, 128, L1, 2048, 256, 0, nullptr)
        TR_MAT(A.in[10], 1024, 64, L1, 2048, 0, 1024, mu + 1 * D)
        TR_MAT(A.in[10] + 1024 * 64, 1024, 64, L1, 2048, 64, 1024, mu + 1 * D)
        TR_MAT(A.in[13], 1024, 64, L1, 2048, 128, 1024, mu + 4 * D)
        TR_MAT(A.in[13] + 1024 * 64, 1024, 64, L1, 2048, 192, 1024, mu + 4 * D)
        TR_MAT(A.in[15], 1024, 128, L1, 2048, 256, 1024, mu + 5 * D)
        TR_MAT(A.in[11], 64, 1024, L2, 128, 0, 0, nullptr)
        TR_MAT(A.in[11] + 64 * 1024, 64, 1024, L2, 128, 1024, 64, nullptr)
        TR_MAT(A.in[14], 64, 1024, L2, 128, 2048, 0, nullptr)
        TR_MAT(A.in[14] + 64 * 1024, 64, 1024, L2, 128, 3072, 64, nullptr)
        TR_MAT(A.in[16], 128, 1024, G2, 128, 0, 0, nullptr)
        if (r < NZ1) { zero_item(L1, 2048, 384 + 32 * (r / 32), 64 * (r % 32), F.lane); continue; } r -= NZ1;
        { const int grp = r / 32; zero_item(L2, 128, 32 * r, 64 * (1 - (grp & 1)), F.lane); }
    }
    const float* x = A.in[0]; const float* gn = A.in[1];
    bf16_t* XNXX = (bf16_t*)F.out; bf16_t* XR = (bf16_t*)(F.ws + WS_XR);
    f32x4 gv[4], m0[4], m2[4], m3[4];
#pragma unroll
    for (int j = 0; j < 4; ++j) { gv[j] = ((const f32x4*)gn)[64 * j + F.lane]; m0[j] = ((const f32x4*)mu)[64 * j + F.lane]; m2[j] = ((const f32x4*)(mu + 2 * D))[64 * j + F.lane]; m3[j] = ((const f32x4*)(mu + 3 * D))[64 * j + F.lane]; }
    for (int m = gw; m < M; m += NGW) {
        const int t = m & (T - 1); const bool hp = t > 0, hn = t < T - 1;
        const f32x4* xc = (const f32x4*)(x + (size_t)m * D) + F.lane; const f32x4* xp = xc - D / 4; const f32x4* xq = xc + D / 4;
        f32x4 vc[4], vp[4], vn[4]; float sc = 0.f, sp = 0.f, sn = 0.f; const f32x4 z4 = {0.f, 0.f, 0.f, 0.f};
#pragma unroll
        for (int j = 0; j < 4; ++j) { vc[j] = xc[64 * j]; vp[j] = hp ? xp[64 * j] : z4; vn[j] = hn ? xq[64 * j] : z4;
            sc += (vc[j].x * vc[j].x + vc[j].y * vc[j].y) + (vc[j].z * vc[j].z + vc[j].w * vc[j].w);
            sp += (vp[j].x * vp[j].x + vp[j].y * vp[j].y) + (vp[j].z * vp[j].z + vp[j].w * vp[j].w);
            sn += (vn[j].x * vn[j].x + vn[j].y * vn[j].y) + (vn[j].z * vn[j].z + vn[j].w * vn[j].w); }
        const float rc = 1.0f / sqrtf(wave_sum(sc) * (1.f / D) + NORM_EPS), rp = 1.0f / sqrtf(wave_sum(sp) * (1.f / D) + NORM_EPS), rn = 1.0f / sqrtf(wave_sum(sn) * (1.f / D) + NORM_EPS);
#pragma unroll
        for (int j = 0; j < 4; ++j) { const int col = 4 * (64 * j + F.lane);
            const f32x4 a = vc[j] * rc * gv[j], xx = (vp[j] * rp + vn[j] * rn) * gv[j] * 0.5f - a;
            const f32x4 vr = a + xx * m0[j], vk = a + xx * m2[j], vv = a + xx * m3[j];
            *(u32x2*)(XNXX + (size_t)m * 2048 + col) = (u32x2){cvt_pk_bf16(a[0], a[1]), cvt_pk_bf16(a[2], a[3])};
            *(u32x2*)(XNXX + (size_t)m * 2048 + 1024 + col) = (u32x2){cvt_pk_bf16(xx[0], xx[1]), cvt_pk_bf16(xx[2], xx[3])};
            *(u32x2*)(XR + (size_t)m * D + col) = (u32x2){cvt_pk_bf16(vr[0], vr[1]), cvt_pk_bf16(vr[2], vr[3])};
            *(u32x2*)(XR + (size_t)M * D + (size_t)m * D + col) = (u32x2){cvt_pk_bf16(vk[0], vk[1]), cvt_pk_bf16(vk[2], vk[3])};
            *(u32x2*)(XR + 2 * (size_t)M * D + (size_t)m * D + col) = (u32x2){cvt_pk_bf16(vv[0], vv[1]), cvt_pk_bf16(vv[2], vv[3])}; }
    }
}

__device__ __forceinline__ void convB_phase(Frame& F, const Args& A) {
    LAS float* scr = (LAS float*)(F.lds + F.wave * 16384);
    const int gw = blockIdx.x * NWAVES + F.wave, NGW = F.G * NWAVES;
    bf16_t* W1_0 = (bf16_t*)(F.ws + WS_W1_0); bf16_t* W2_0 = (bf16_t*)(F.ws + WS_W2_0); bf16_t* WIN = (bf16_t*)(F.ws + WS_WIN); bf16_t* WOUT = (bf16_t*)(F.ws + WS_WOUT);
    bf16_t* WSB = (bf16_t*)(F.ws + WS_WSB); bf16_t* W1_1 = (bf16_t*)(F.ws + WS_W1_1); bf16_t* W2_1 = (bf16_t*)(F.ws + WS_W2_1);
    constexpr int NTOT = 5 * 2048 + 1024 + 512;
    for (int it = gw; it < NTOT; it += NGW) {
        int r = it;
        TR_MAT(A.in[28], 1024, 4096, W1_0, 1024, 0, 0, A.in[2])
        TR_MAT(A.in[29], 4096, 1024, W2_0, 4096, 0, 0, nullptr)
        TR_MAT(A.in[22], 1024, 4096, WIN, 1024, 0, 0, A.in[1] + D)
        TR_MAT(A.in[28] + (size_t)D * FF, 1024, 4096, W1_1, 1024, 0, 0, A.in[2] + D)
        TR_MAT(A.in[29] + (size_t)D * FF, 4096, 1024, W2_1, 4096, 0, 0, nullptr)
        TR_MAT(A.in[27], 2048, 1024, WOUT, 2048, 0, 0, nullptr)
        { const float* s = A.in[25] + (size_t)r * 512 + F.lane * 8; const f32x4 a = *(const f32x4*)s, b = *(const f32x4*)(s + 4); *(u32x4*)(WSB + (size_t)r * 512 + F.lane * 8) = pack8(a, b); }
    }
}

constexpr int TC = 16, NCH = T / TC, SREC = 336;
template <int VAR>
__device__ __forceinline__ void scan_phase(Frame& F, const Args& A) {
    LAS float* BUF = (LAS float*)(F.lds);
    LAS float* OP = (LAS float*)(F.lds + 2 * TC * SREC * 4);
    const int tid = F.tid, lane = F.lane, wave = F.wave;
    const bool prod = wave >= 4; const int ptid = tid - 256;
    const bf16_t* Rg = (const bf16_t*)(F.ws + WS_R); const bf16_t* Kg = (const bf16_t*)(F.ws + WS_K); const bf16_t* Vg = (const bf16_t*)(F.ws + WS_V);
    const bf16_t* EWg = (const bf16_t*)F.out; const bf16_t* AAg = (const bf16_t*)(F.ws + WS_AA); bf16_t* ODg = (bf16_t*)(F.ws + WS_OD);
    for (int it0 = blockIdx.x; it0 < 256; it0 += F.G) {
        const int item = (F.G == 256) ? ((it0 & 7) * 32 + (it0 >> 3)) : it0;
        const int chain = item >> 2, quarter = item & 3, dir = chain & 1, bh = chain >> 1, b = bh >> 4, h = bh & 15, row0 = quarter * 16;
        const size_t boff = (size_t)b * T * D + h * 64;
        const bf16_t* Rp = Rg + boff; const bf16_t* Kp = Kg + boff; const bf16_t* Vp = Vg + boff;
        const bf16_t* Ep = EWg + (size_t)dir * M * D + boff; const bf16_t* Ap = AAg + (size_t)dir * M * D + boff; bf16_t* Op = ODg + (size_t)dir * M * D + boff + row0;
        const int pw = wave - 4, tq = lane >> 4, c4 = (lane & 15) * 4;
        u32x2 raw[4][5];
#pragma unroll
        for (int j = 0; j < 4; ++j) for (int q = 0; q < 5; ++q) raw[j][q] = (u32x2){0u, 0u};
        f32x4 kk4 = {0, 0, 0, 0}, ka4 = {0, 0, 0, 0};
        if (prod) { kk4 = *(const f32x4*)(A.in[17] + h * 64 + c4); ka4 = *(const f32x4*)(A.in[18] + h * 64 + c4); }
        asm volatile("s_waitcnt vmcnt(0)" : "+v"(kk4), "+v"(ka4) :: "memory");
#define SC_LOAD(c) do { _Pragma("unroll") for (int j = 0; j < 4; ++j) { const int step = (c) * TC + tq + 4 * j; const int tt = dir ? (T - 1 - step) : step; const size_t o = (size_t)tt * D + c4; \
        raw[j][0] = *(const u32x2*)(Rp + o); raw[j][1] = *(const u32x2*)(Kp + o); raw[j][2] = *(const u32x2*)(Vp + o); raw[j][3] = *(const u32x2*)(Ep + o); raw[j][4] = *(const u32x2*)(Ap + o); } } while (0)
#define SC_PROC(c) do { _Pragma("unroll") for (int j = 0; j < 4; ++j) { const int tl = tq + 4 * j; const u32x2 rr = raw[j][0], rk = raw[j][1], rv = raw[j][2], re = raw[j][3], ra = raw[j][4]; \
        const f32x4 r4 = {bf_lo(rr.x), bf_hi(rr.x), bf_lo(rr.y), bf_hi(rr.y)}, k4 = {bf_lo(rk.x), bf_hi(rk.x), bf_lo(rk.y), bf_hi(rk.y)}, v4 = {bf_lo(rv.x), bf_hi(rv.x), bf_lo(rv.y), bf_hi(rv.y)}; \
        const f32x4 e4 = {bf_lo(re.x), bf_hi(re.x), bf_lo(re.y), bf_hi(re.y)}, a4 = {bf_lo(ra.x), bf_hi(ra.x), bf_lo(ra.y), bf_hi(ra.y)}; \
        f32x4 kk = k4 * kk4; float ss = (kk[0] * kk[0] + kk[1] * kk[1]) + (kk[2] * kk[2] + kk[3] * kk[3]); ss = row16_allsum(ss); \
        const float inv = __builtin_amdgcn_rsqf(fmaxf(ss, 1e-24f)); kk = kk * inv; \
        f32x4 dec; dec[0] = __expf(-e4[0]); dec[1] = __expf(-e4[1]); dec[2] = __expf(-e4[2]); dec[3] = __expf(-e4[3]); \
        const f32x4 kd = k4 * (1.0f + (a4 - 1.0f) * ka4); \
        LAS float* dst = BUF + ((c) & 1) * TC * SREC + tl * SREC + c4; \
        *(LAS f32x4*)(dst) = dec; *(LAS f32x4*)(dst + 64) = -kk; *(LAS f32x4*)(dst + 128) = kk * a4; *(LAS f32x4*)(dst + 192) = kd; *(LAS f32x4*)(dst + 256) = r4; \
        if ((c4 >> 4) == quarter) *(LAS f32x4*)(BUF + ((c) & 1) * TC * SREC + tl * SREC + 320 + c4 - row0) = v4; } } while (0)
#define SC_RED(c, ok) do { const int row = lane & 15; const LAS float* src = OP + ((c) & 1) * TC * 256 + tq * 1024 + ((row >> 2) * 64 + (row & 3) * 16) * 4; \
        f32x4 o4 = {0.f, 0.f, 0.f, 0.f}; \
        _Pragma("unroll") for (int j = 0; j < 16; ++j) o4 += *(const LAS f32x4*)(src + (((j + row) & 15) << 2));     \
        _Pragma("unroll") for (int e = 0; e < 4; ++e) { const int step = (c) * TC + 4 * tq + e; const int tt = dir ? (T - 1 - step) : step; \
            if (ok) Op[(size_t)tt * D + row] = (bf16_t)(cvt_pk_bf16(o4[e], 0.f) & 0xffffu); } } while (0)
        if (prod) { SC_LOAD(pw); if (pw == 0) { SC_PROC(0); SC_LOAD(4); } }
        __syncthreads();
        f32x2 S01 = {0.f, 0.f}, S23 = {0.f, 0.f};
        const int ks = lane & 15, rl = lane >> 4;
        for (int c0 = 0; c0 < NCH; c0 += 4) {
#pragma unroll
        for (int cj = 0; cj < 4; ++cj) { const int c = c0 + cj;
            if (!prod || VAR == 5) { if (VAR != 2) {
                const LAS float* bp = BUF + (c & 1) * TC * SREC + ks * 4; const LAS float* vp = BUF + (c & 1) * TC * SREC + 320 + wave * 4 + rl;
                LAS float* op = OP + (c & 1) * TC * 256 + tid * 4;
                f32x4 oq = {0.f, 0.f, 0.f, 0.f};
                constexpr int PD = 2;
                f32x4 pw[PD], pa[PD], pb[PD], pk[PD], pr[PD]; float pv[PD];
#pragma unroll
                for (int j = 0; j < PD; ++j) { const LAS float* q = bp + j * SREC; pw[j] = *(const LAS f32x4*)(q); pa[j] = *(const LAS f32x4*)(q + 64); pb[j] = *(const LAS f32x4*)(q + 128); pk[j] = *(const LAS f32x4*)(q + 192); pr[j] = *(const LAS f32x4*)(q + 256); pv[j] = vp[j * SREC]; }
#pragma unroll
                for (int i = 0; i < TC; ++i) {
                    const int sl = i % PD;
                    const f32x4 w = pw[sl], a = pa[sl], bb = pb[sl], k = pk[sl], r = pr[sl]; const float v = pv[sl];
                    if (VAR != 3 && VAR != 5 && i + PD < TC) { const LAS float* q = bp + (i + PD) * SREC; pw[sl] = *(const LAS f32x4*)(q); pa[sl] = *(const LAS f32x4*)(q + 64); pb[sl] = *(const LAS f32x4*)(q + 128); pk[sl] = *(const LAS f32x4*)(q + 192); pr[sl] = *(const LAS f32x4*)(q + 256); pv[sl] = vp[(i + PD) * SREC]; }
                    f32x2 p = S01 * (f32x2){a[0], a[1]}; p = S23 * (f32x2){a[2], a[3]} + p;
                    float sa = p.x + p.y; if (VAR != 4) sa = row16_allsum(sa);
                    const f32x2 vk01 = (f32x2){k[0], k[1]} * v, vk23 = (f32x2){k[2], k[3]} * v;
                    const f32x2 t01 = (f32x2){bb[0], bb[1]} * sa + vk01, t23 = (f32x2){bb[2], bb[3]} * sa + vk23;
                    S01 = S01 * (f32x2){w[0], w[1]} + t01; S23 = S23 * (f32x2){w[2], w[3]} + t23;
                    f32x2 q2 = S01 * (f32x2){r[0], r[1]}; q2 = S23 * (f32x2){r[2], r[3]} + q2;
                    oq[i & 3] = q2.x + q2.y; if ((i & 3) == 3) *(LAS f32x4*)(op + (i >> 2) * 1024) = oq;
                }
            } } else if (VAR == 0 || VAR == 2) {
                if (pw == ((cj + 1) & 3)) { SC_PROC(c + 1); const int cl = (c + 5 < NCH) ? (c + 5) : (NCH - 1); SC_LOAD(cl); }
                if (pw == ((cj + 3) & 3)) { const int cr = c >= 1 ? c - 1 : 0; const bool ok = c >= 1 && VAR == 0; SC_RED(cr, ok); }
            }
            asm volatile("s_waitcnt lgkmcnt(0)" ::: "memory"); __builtin_amdgcn_s_barrier(); asm volatile("" ::: "memory");
        } }
        if (pw == 0) SC_RED(NCH - 1, VAR == 0);
        __syncthreads();
#undef SC_LOAD
#undef SC_PROC
#undef SC_RED
    }
}

__device__ __forceinline__ void z_phase(Frame& F, const Args& A) {
    const int gw = blockIdx.x * NWAVES + F.wave, NGW = F.G * NWAVES, col = F.lane * 16;
    const bf16_t* Rg = (const bf16_t*)(F.ws + WS_R); const bf16_t* Kg = (const bf16_t*)(F.ws + WS_K); const bf16_t* Vg = (const bf16_t*)(F.ws + WS_V);
    const bf16_t* A0 = (const bf16_t*)(F.ws + WS_AA); const bf16_t* A1 = A0 + (size_t)M * D; bf16_t* OF = (bf16_t*)(F.ws + WS_OD); const bf16_t* OB = OF + (size_t)M * D;
    float ka[16], rkc[16], lg[16], lb[16];
#pragma unroll
    for (int i = 0; i < 16; ++i) { ka[i] = A.in[18][col + i]; rkc[i] = A.in[19][col + i]; lg[i] = A.in[20][col + i]; lb[i] = A.in[21][col + i]; }
    for (int m = gw; m < M; m += NGW) {
        const size_t o = (size_t)m * D + col;
        float of[16], ob[16], r[16], k[16], v[16], a0[16], a1[16];
#define LD16(dst, P) { const u32x4 _a = *(const u32x4*)((P) + o), _b = *(const u32x4*)((P) + o + 8); float _t[8]; unpack8(_a, _t); for (int i = 0; i < 8; ++i) dst[i] = _t[i]; unpack8(_b, _t); for (int i = 0; i < 8; ++i) dst[8 + i] = _t[i]; }
        LD16(of, OF) LD16(ob, OB) LD16(r, Rg) LD16(k, Kg) LD16(v, Vg) LD16(a0, A0) LD16(a1, A1)
#undef LD16
        float s = 0.f, dot = 0.f;
#pragma unroll
        for (int i = 0; i < 16; ++i) { of[i] += ob[i]; s += of[i]; dot += r[i] * rkc[i] * k[i] * (2.0f + (a0[i] + a1[i] - 2.0f) * ka[i]); }
        s += __shfl_xor(s, 1); s += __shfl_xor(s, 2); dot += __shfl_xor(dot, 1); dot += __shfl_xor(dot, 2);
        const float mean = s * (1.f / 64.f); float q = 0.f;
#pragma unroll
        for (int i = 0; i < 16; ++i) { of[i] -= mean; q += of[i] * of[i]; }
        q += __shfl_xor(q, 1); q += __shfl_xor(q, 2);
        const float rstd = 1.0f / sqrtf(q * (1.f / 64.f) + GN_EPS);
        float z[16];
#pragma unroll
        for (int i = 0; i < 16; ++i) z[i] = of[i] * rstd * lg[i] + lb[i] + dot * v[i];
        u32x4 w0, w1; w0.x = cvt_pk_bf16(z[0], z[1]); w0.y = cvt_pk_bf16(z[2], z[3]); w0.z = cvt_pk_bf16(z[4], z[5]); w0.w = cvt_pk_bf16(z[6], z[7]);
        w1.x = cvt_pk_bf16(z[8], z[9]); w1.y = cvt_pk_bf16(z[10], z[11]); w1.z = cvt_pk_bf16(z[12], z[13]); w1.w = cvt_pk_bf16(z[14], z[15]);
        *(u32x4*)(OF + o) = w0; *(u32x4*)(OF + o + 8) = w1;
    }
}

__device__ __forceinline__ void rs_table(Frame& F, const pg8::StaticOrder& S) {
    LAS float* RS = (LAS float*)(F.lds + RS_OFF); const float* SS = (const float*)(F.ws + WS_SS);
    pg8::Unit u;
    for (int i = 0; i < 8 && S.next(i, u); ++i) {
        if (F.tid < 256) { const f32x4* p = (const f32x4*)(SS + (size_t)(u.pm * 256 + F.tid) * 16); const f32x4 a = p[0], b = p[1], c = p[2], d = p[3]; const f32x4 t = (a + b) + (c + d);
            RS[i * 256 + F.tid] = 1.0f / sqrtf(((t[0] + t[1]) + (t[2] + t[3])) * (1.f / D) + NORM_EPS); }
    }
    __syncthreads();
}

__device__ __forceinline__ void spatial_phase(Frame& F, const Args& A) {
    constexpr int LDW = 136;
    LAS bf16_t* WL = (LAS bf16_t*)(F.lds); LAS bf16_t* VL = (LAS bf16_t*)(F.lds + 128 * LDW * 2); LAS f32x2* ST = (LAS f32x2*)(F.lds + 2 * 128 * LDW * 2);
    bf16_t* H = (bf16_t*)(F.ws + WS_H); const bf16_t* WSB = (const bf16_t*)(F.ws + WS_WSB); const f32x2* LNP = (const f32x2*)(F.ws + WS_LNP);
    const float* lng = A.in[23]; const float* lnb = A.in[24]; const float* bs = A.in[26];
    const int tid = F.tid, lane = F.lane, wave = F.wave, fr = lane & 15, fq = lane >> 4;
    const int i0 = (wave >> 1) * 32, d0 = (wave & 1) * 64, cc = tid & 15;
    int gcur = -1; float gam[8], bet[8], bsv[2];
#pragma unroll
    for (int e = 0; e < 8; ++e) { gam[e] = 0.f; bet[e] = 0.f; }
    bsv[0] = bsv[1] = 0.f;
    u32x4 vraw[4]; f32x4 lnp[4];
#define SP_PREF(un_) do { const int c_ = (un_) >> 4, g_ = (un_) & 15; \
        _Pragma("unroll") for (int i = 0; i < 4; ++i) { const int j = (tid + 512 * i) >> 4; vraw[i] = *(const u32x4*)(H + (size_t)(c_ * 128 + j) * FF + 2048 + g_ * 128 + cc * 8); } \
        const f32x4* p_ = (const f32x4*)(LNP + (size_t)(c_ * 128 + (tid >> 2)) * 32) + (tid & 3) * 4; \
        _Pragma("unroll") for (int i = 0; i < 4; ++i) lnp[i] = p_[i]; } while (0)
    int un = blockIdx.x;
    if (un < 2048) SP_PREF(un);
    for (; un < 2048; un += F.G) {
        const int c = un >> 4, g = un & 15;
        if (g != gcur) {
            __syncthreads();
#pragma unroll
            for (int i = 0; i < 4; ++i) { const int q = tid + 512 * i, row = q >> 4, c8 = q & 15; *(LAS u32x4*)(WL + row * LDW + c8 * 8) = *(const u32x4*)(WSB + (size_t)g * 16384 + row * 128 + c8 * 8); }
#pragma unroll
            for (int e = 0; e < 8; ++e) { gam[e] = lng[g * 128 + cc * 8 + e]; bet[e] = lnb[g * 128 + cc * 8 + e]; }
            bsv[0] = bs[g * 128 + i0 + fr]; bsv[1] = bs[g * 128 + i0 + 16 + fr];
            gcur = g;
        }
        { float s_ = 0.f, q_ = 0.f;
#pragma unroll
          for (int i = 0; i < 4; ++i) { s_ += lnp[i][0] + lnp[i][2]; q_ += lnp[i][1] + lnp[i][3]; }
          s_ += __shfl_xor(s_, 1); s_ += __shfl_xor(s_, 2); q_ += __shfl_xor(q_, 1); q_ += __shfl_xor(q_, 2);
          const float mean = s_ * (1.f / 2048.f), var = q_ * (1.f / 2048.f) - mean * mean;
          if ((tid & 3) == 0) ST[tid >> 2] = (f32x2){mean, 1.0f / sqrtf(fmaxf(var, 0.f) + NORM_EPS)}; }
        __syncthreads();
#pragma unroll
        for (int i = 0; i < 4; ++i) { const int j = (tid + 512 * i) >> 4; float v[8]; unpack8(vraw[i], v);
            const f32x2 st = ST[j];
            for (int e = 0; e < 8; ++e) v[e] = (v[e] - st.x) * st.y * gam[e] + bet[e];
            u32x4 w; w.x = cvt_pk_bf16(v[0], v[1]); w.y = cvt_pk_bf16(v[2], v[3]); w.z = cvt_pk_bf16(v[4], v[5]); w.w = cvt_pk_bf16(v[6], v[7]);
            *(LAS u32x4*)(VL + j * LDW + cc * 8) = w; }
        __syncthreads();
        u32x2 uw[2][4];
#pragma unroll
        for (int mb = 0; mb < 2; ++mb) { const bf16_t* up = H + (size_t)(c * 128 + i0 + mb * 16 + fr) * FF + g * 128 + d0 + 4 * fq;
#pragma unroll
            for (int nb = 0; nb < 4; ++nb) uw[mb][nb] = *(const u32x2*)(up + nb * 16); }
        if (un + F.G < 2048) SP_PREF(un + F.G);
        f32x4 acc[2][4];
#pragma unroll
        for (int mb = 0; mb < 2; ++mb)
#pragma unroll
            for (int nb = 0; nb < 4; ++nb) acc[mb][nb] = (f32x4){0.f, 0.f, 0.f, 0.f};
#pragma unroll
        for (int kk = 0; kk < 4; ++kk) {
            bf16x8 wf[2], vf[4];
#pragma unroll
            for (int mb = 0; mb < 2; ++mb) wf[mb] = *(const LAS bf16x8*)(WL + (i0 + mb * 16 + fr) * LDW + kk * 32 + fq * 8);
#pragma unroll
            for (int nb = 0; nb < 4; ++nb) { const LAS bf16_t* p = VL + (kk * 32 + fq * 8) * LDW + d0 + nb * 16 + fr;
#pragma unroll
                for (int e = 0; e < 8; ++e) vf[nb][e] = (short)p[e * LDW]; }
#pragma unroll
            for (int mb = 0; mb < 2; ++mb)
#pragma unroll
                for (int nb = 0; nb < 4; ++nb) acc[mb][nb] = __builtin_amdgcn_mfma_f32_16x16x32_bf16(vf[nb], wf[mb], acc[mb][nb], 0, 0, 0);
        }
#pragma unroll
        for (int mb = 0; mb < 2; ++mb) { bf16_t* up = H + (size_t)(c * 128 + i0 + mb * 16 + fr) * FF + g * 128 + d0 + 4 * fq;
#pragma unroll
            for (int nb = 0; nb < 4; ++nb) { const f32x4 a = acc[mb][nb]; const u32x2 w = uw[mb][nb];
                const float o0 = (a[0] + bsv[mb]) * bf_lo(w.x), o1 = (a[1] + bsv[mb]) * bf_hi(w.x), o2 = (a[2] + bsv[mb]) * bf_lo(w.y), o3 = (a[3] + bsv[mb]) * bf_hi(w.y);
                *(u32x2*)(up + nb * 16) = (u32x2){cvt_pk_bf16(o0, o1), cvt_pk_bf16(o2, o3)}; } }
    }
#undef SP_PREF
    __syncthreads();
}

__device__ __forceinline__ void final_phase(Frame& F, const Args& A) {
    const int gw = blockIdx.x * NWAVES + F.wave, NGW = F.G * NWAVES, col = F.lane * 16;
    const bf16_t* XBp = (const bf16_t*)(F.ws + WS_XB);
    float gv[16];
#pragma unroll
    for (int i = 0; i < 16; ++i) gv[i] = A.in[3][col + i];
    for (int m = gw; m < M; m += NGW) {
        const u32x4 a = *(const u32x4*)(XBp + (size_t)m * D + col), b = *(const u32x4*)(XBp + (size_t)m * D + col + 8);
        float v[16]; { float t[8]; unpack8(a, t); for (int i = 0; i < 8; ++i) v[i] = t[i]; unpack8(b, t); for (int i = 0; i < 8; ++i) v[8 + i] = t[i]; }
        float s = 0.f;
#pragma unroll
        for (int i = 0; i < 16; ++i) s += v[i] * v[i];
        const float rs = 1.0f / sqrtf(wave_sum(s) * (1.f / D) + NORM_EPS);
        float* op = F.out + (size_t)m * D + col;
#pragma unroll
        for (int i = 0; i < 16; i += 4) *(f32x4*)(op + i) = (f32x4){v[i] * rs * gv[i], v[i + 1] * rs * gv[i + 1], v[i + 2] * rs * gv[i + 2], v[i + 3] * rs * gv[i + 3]};
    }
}

#define XB_TMO      128
#define XB_XCNT(j)  (256  + 64 * (j))
#define XB_XSUB(j)  (1280 + 64 * (j))
#define XB_XGEN(j)  (2304 + 64 * (j))
#define XB_TOP      3328
#define XB_TOPGEN   3392
#define XCD_BAR_WORDS 3456
#define XB_SPIN_CAP (1u << 18)
__device__ __forceinline__ unsigned xb_ld(unsigned* p)              { return __hip_atomic_load(p, __ATOMIC_RELAXED, __HIP_MEMORY_SCOPE_AGENT); }
__device__ __forceinline__ unsigned xb_add(unsigned* p, unsigned v) { return __hip_atomic_fetch_add(p, v, __ATOMIC_RELAXED, __HIP_MEMORY_SCOPE_AGENT); }
__device__ __forceinline__ unsigned xb_xcc_id() { return (unsigned)__builtin_amdgcn_s_getreg((3 << 11) | 20) & 0xFu; }
#define XB_SPIN(cond, bar) do { unsigned _sp = 0; while (cond) { __builtin_amdgcn_s_sleep(1); \
    if ((++_sp & 255u) == 0u) { if (xb_ld(&(bar)[XB_TMO])) break; if (_sp > XB_SPIN_CAP) { atomicAdd(&(bar)[XB_TMO], 1u); break; } } } } while (0)
struct XcdBarrier { unsigned* bar; unsigned x; volatile LAS unsigned* st; };
__device__ __forceinline__ XcdBarrier xcd_barrier_post(unsigned* bar, volatile LAS unsigned* st) {
    XcdBarrier b; b.bar = bar; b.x = xb_xcc_id(); b.st = st;
    if (threadIdx.x == 0) (void)xb_add(&bar[XB_XCNT(b.x)], 1u);
    return b;
}
__device__ __forceinline__ void xcd_barrier_complete(unsigned* bar, unsigned x, unsigned& nloc, unsigned& nx) {
    const unsigned G = gridDim.x * gridDim.y * gridDim.z;
    unsigned sum, cnt, mine, sp = 0u;
    for (;;) {
        sum = 0u; cnt = 0u; mine = 0u;
#pragma unroll
        for (unsigned j = 0; j < 16; ++j) { const unsigned c = xb_ld(&bar[XB_XCNT(j)]); sum += c; cnt += (c > 0u) ? 1u : 0u; mine = (j == x) ? c : mine; }
        if (sum == G) break;
        __builtin_amdgcn_s_sleep(1);
        if ((++sp & 255u) == 0u) { if (xb_ld(&bar[XB_TMO])) break; if (sp > XB_SPIN_CAP) { atomicAdd(&bar[XB_TMO], 1u); break; } }
    }
    nloc = mine > 0u ? mine : 1u; nx = cnt > 0u ? cnt : 1u;
}
__device__ __forceinline__ void xcd_barrier(const XcdBarrier& b) {
    asm volatile("s_waitcnt vmcnt(0)" ::: "memory");
    __syncthreads();
    if (threadIdx.x == 0) {
        unsigned* bar = b.bar;
        __builtin_amdgcn_s_waitcnt(0);
        unsigned nloc = b.st[0], nx = b.st[1];
        if (nloc == 0u) { xcd_barrier_complete(bar, b.x, nloc, nx); b.st[0] = nloc; b.st[1] = nx; }
        const unsigned old = xb_add(&bar[XB_XSUB(b.x)], 1u);
        const unsigned gen = old / nloc;
        if (old + 1u == (gen + 1u) * nloc) {
            __builtin_amdgcn_fence(__ATOMIC_RELEASE, "agent");
            asm volatile("s_waitcnt vmcnt(0)" ::: "memory");
            const unsigned og = xb_add(&bar[XB_TOP], 1u);
            const unsigned tg = og / nx;
            if (og + 1u == (tg + 1u) * nx) xb_add(&bar[XB_TOPGEN], 1u);
            else XB_SPIN(xb_ld(&bar[XB_TOPGEN]) == tg, bar);
            __builtin_amdgcn_fence(__ATOMIC_ACQUIRE, "agent");
            xb_add(&bar[XB_XGEN(b.x)], 1u);
            asm volatile("s_waitcnt vmcnt(0)" ::: "memory");
        } else {
            XB_SPIN(xb_ld(&bar[XB_XGEN(b.x)]) == gen, bar);
            __builtin_amdgcn_fence(__ATOMIC_ACQUIRE, "agent");
            asm volatile("s_waitcnt vmcnt(0)" ::: "memory");
        }
    }
    __syncthreads();
}

struct EpiFinal {
    const bf16_t* base; float* out; const float* g; float* ss; XcdBarrier xb;
    __device__ __forceinline__ void operator()(f32x4 (&acc)[2][2][4][2], const pg8::Unit& u, int ui, int wr, int wc, int fr, int fq) const {
        using namespace pg8;
        const int col0 = u.pn * BM + wc * 32 + 8 * fq;
#pragma unroll
        for (int ai = 0; ai < 2; ++ai)
#pragma unroll
            for (int m = 0; m < 4; ++m) { const int row = u.pm * BM + ai * HALF + wr * 64 + m * 16 + fr; const size_t off = (size_t)row * D + col0; float sq = 0.f;
#pragma unroll
                for (int bj = 0; bj < 2; ++bj) { const u32x4 w = *(const u32x4*)(base + off + bj * HALF); float t[8]; unpack8(w, t); const f32x4 b0 = {t[0], t[1], t[2], t[3]}, b1 = {t[4], t[5], t[6], t[7]};
                    const f32x4 v0 = acc[ai][bj][m][0] + b0, v1 = acc[ai][bj][m][1] + b1; acc[ai][bj][m][0] = v0; acc[ai][bj][m][1] = v1;
                    sq += (v0[0] * v0[0] + v0[1] * v0[1]) + (v0[2] * v0[2] + v0[3] * v0[3]) + (v1[0] * v1[0] + v1[1] * v1[1]) + (v1[2] * v1[2] + v1[3] * v1[3]); }
                sq += __shfl_xor(sq, 16); sq += __shfl_xor(sq, 32);
                if (fq == 0) ss[(size_t)row * 16 + u.pn * 4 + wc] = sq; if (m & 1) asm volatile("" ::: "memory"); }
        xcd_barrier(xb);
        f32x4 gv[2][2];
#pragma unroll
        for (int bj = 0; bj < 2; ++bj) { gv[bj][0] = *(const f32x4*)(g + col0 + bj * HALF); gv[bj][1] = *(const f32x4*)(g + col0 + bj * HALF + 4); }
#pragma unroll
        for (int ai = 0; ai < 2; ++ai)
#pragma unroll
            for (int m = 0; m < 4; ++m) { const int row = u.pm * BM + ai * HALF + wr * 64 + m * 16 + fr; const size_t off = (size_t)row * D + col0;
                const f32x4* p = (const f32x4*)(ss + (size_t)row * 16); const f32x4 t = (p[0] + p[1]) + (p[2] + p[3]);
                const float rs = 1.0f / sqrtf(((t[0] + t[1]) + (t[2] + t[3])) * (1.f / D) + NORM_EPS);
#pragma unroll
                for (int bj = 0; bj < 2; ++bj) { float* op = out + off + bj * HALF; *(f32x4*)op = acc[ai][bj][m][0] * rs * gv[bj][0]; *(f32x4*)(op + 4) = acc[ai][bj][m][1] * rs * gv[bj][1]; }
                if (m & 1) asm volatile("" ::: "memory"); }
    }
};

constexpr int NPHASE = 15;
__global__ void __launch_bounds__(NTHR, 2) fwd_kernel(Args args) {
    extern __shared__ __attribute__((aligned(16))) unsigned char lds_raw[];
    Frame F;
    F.lds = (LAS unsigned char*)lds_raw; F.tid = threadIdx.x; F.lane = F.tid & 63; F.wave = __builtin_amdgcn_readfirstlane(F.tid >> 6); F.G = gridDim.x;
    F.out = args.out; F.ws = args.ws;
    const int lo = args.ph_lo, hi = args.ph_hi;
    cg::grid_group grid = cg::this_grid();
    volatile LAS unsigned* MISC = (volatile LAS unsigned*)(F.lds + RING_BYTES + 512);
    if (F.tid < 2) MISC[F.tid] = 0u;
    __syncthreads();
    XcdBarrier xbar = xcd_barrier_post((unsigned*)(args.ws + WS_BAR), MISC);
#ifndef PHMASK
#define PHMASK 0x7fff
#endif
#define IN(k) (((PHMASK >> (k)) & 1) && lo <= (k) && (k) < hi)
#define SEAM(k) do { if (IN(k) && IN((k) + 1)) { if (hi > 1000) grid.sync(); else xcd_barrier(xbar); } } while (0)
    unsigned char* ws = args.ws;
    bf16_t* XB = (bf16_t*)(ws + WS_XB); bf16_t* HB = (bf16_t*)(ws + WS_H); float* SS = (float*)(ws + WS_SS);
    const LAS float* RS = (const LAS float*)(F.lds + RS_OFF);
    const int bx = blockIdx.x;

    if (IN(0)) { p0_phase(F, args); }
    SEAM(0);
    if (IN(1)) {
        __syncthreads();
        const bool bal = (F.G == 256);
        { pg8::Gemm g{(const bf16_t*)F.out, (const bf16_t*)(ws + WS_L1), M, 512, 2048, 2048, 1 << 20, 0}; pg8::StaticOrder S;
          if (bal) S.init_sub(M, 512, 128, bx >= 128 ? bx - 128 : -1, 0, 1); else S.init(M, 512, F.G, bx);
          pg8::EpiLora1 E{(bf16_t*)(ws + WS_A2), (bf16_t*)(ws + WS_SG)}; pg8::gemm_phase(F.lds, g, S, E); }
        { pg8::Gemm g{(const bf16_t*)(ws + WS_XR), (const bf16_t*)(ws + WS_WRKV), M, 3072, 1024, 1024, 4, (size_t)M * D * 2}; pg8::StaticOrder S;
          if (bal) { if (bx < 128) S.init_sub(M, 3072, 128, bx, 0, 4); else S.init_sub(M, 3072, 128, bx - 128, 512, 2); } else S.init(M, 3072, F.G, bx);
          pg8::EpiSplit E{(bf16_t*)(ws + WS_R), D, D, (size_t)M * D}; pg8::gemm_phase(F.lds, g, S, E); }
    }
    SEAM(1);
    if (IN(2)) {
        pg8::Gemm g{(const bf16_t*)(ws + WS_A2), (const bf16_t*)(ws + WS_L2), M, 4096, 128, 256, 8, 256}; pg8::StaticOrder S; S.init(M, 4096, F.G, bx);
        pg8::EpiLora2 E{(bf16_t*)F.out, (bf16_t*)(ws + WS_AA), args.in[9], args.in[12]}; pg8::gemm_phase(F.lds, g, S, E);
    }
    SEAM(2);
    if (IN(3)) { scan_phase<0>(F, args); }
    SEAM(3);
    if (IN(4)) { z_phase(F, args); }
    SEAM(4);
    if (IN(5)) {
        convB_phase(F, args); __syncthreads();
        pg8::Gemm g{(const bf16_t*)(ws + WS_SG), (const bf16_t*)(ws + WS_G2), M, 1024, 128, 256, 1 << 20, 0}; pg8::StaticOrder S; S.init(M, 1024, F.G, bx);
        pg8::EpiG E{(bf16_t*)(ws + WS_OD)}; pg8::gemm_phase(F.lds, g, S, E);
    }
    SEAM(5);
    if (IN(6)) {
        pg8::Gemm g{(const bf16_t*)(ws + WS_OD), (const bf16_t*)(ws + WS_WO), M, 1024, 1024, 1024, 1 << 20, 0}; pg8::StaticOrder S; S.init(M, 1024, F.G, bx);
        pg8::EpiRes<true> E{args.in[0], XB, SS}; pg8::gemm_phase(F.lds, g, S, E);
    }
    SEAM(6);
    if (IN(7)) {
        pg8::Gemm g{XB, (const bf16_t*)(ws + WS_W1_0), M, FF, 1024, 1024, 1 << 20, 0}; pg8::StaticOrder S; S.init(M, FF, F.G, bx);
        rs_table(F, S);
        pg8::EpiSq E{HB, RS}; pg8::gemm_phase(F.lds, g, S, E);
    }
    SEAM(7);
    if (IN(8)) {
        pg8::Gemm g{HB, (const bf16_t*)(ws + WS_W2_0), M, 1024, FF, FF, 1 << 20, 0}; pg8::StaticOrder S; S.init(M, 1024, F.G, bx);
        pg8::EpiRes<false> E{nullptr, XB, SS}; pg8::gemm_phase(F.lds, g, S, E);
    }
    SEAM(8);
    if (IN(9)) {
        pg8::Gemm g{XB, (const bf16_t*)(ws + WS_WIN), M, FF, 1024, 1024, 1 << 20, 0}; pg8::StaticOrder S; S.init(M, FF, F.G, bx);
        rs_table(F, S);
        pg8::EpiGelu E{HB, RS, (f32x2*)(ws + WS_LNP)}; pg8::gemm_phase(F.lds, g, S, E);
    }
    SEAM(9);
    if (IN(10)) { __syncthreads(); spatial_phase(F, args); }
    SEAM(10);
    if (IN(11)) {
        __syncthreads();
        pg8::Gemm g{HB, (const bf16_t*)(ws + WS_WOUT), M, 1024, 2048, FF, 1 << 20, 0}; pg8::StaticOrder S; S.init(M, 1024, F.G, bx);
        pg8::EpiRes<false> E{nullptr, XB, SS}; pg8::gemm_phase(F.lds, g, S, E);
    }
    SEAM(11);
    if (IN(12)) {
        pg8::Gemm g{XB, (const bf16_t*)(ws + WS_W1_1), M, FF, 1024, 1024, 1 << 20, 0}; pg8::StaticOrder S; S.init(M, FF, F.G, bx);
        rs_table(F, S);
        pg8::EpiSq E{HB, RS}; pg8::gemm_phase(F.lds, g, S, E);
    }
    SEAM(12);
    const bool fuse_final = IN(13) && IN(14) && F.G == 256;
    if (IN(13)) {
        pg8::Gemm g{HB, (const bf16_t*)(ws + WS_W2_1), M, 1024, FF, FF, 1 << 20, 0}; pg8::StaticOrder S; S.init(M, 1024, F.G, bx);
        if (fuse_final) { EpiFinal E{XB, F.out, args.in[3], SS, xbar}; pg8::gemm_phase(F.lds, g, S, E); }
        else { pg8::EpiRes<false> E{nullptr, XB, SS}; pg8::gemm_phase(F.lds, g, S, E); }
    }
    if (!fuse_final) { SEAM(13); }
    if (IN(14) && !fuse_final) { final_phase(F, args); }
}

extern "C" void kernel_launch(void* const* d_in, const int* in_sizes, int n_in, void* d_out, int out_size, void* d_ws, size_t ws_size, hipStream_t stream) {
    static int grid = 0;
    if (grid == 0) {
        if (n_in != 30 || out_size != M * D || ws_size < WS_END) { fprintf(stderr, "kernel_launch: unexpected shapes (n_in %d out %d ws %zu)\n", n_in, out_size, ws_size); grid = -1; return; }
        int dev = 0, cus = 0, per_cu = 0;
        (void)hipGetDevice(&dev); (void)hipDeviceGetAttribute(&cus, hipDeviceAttributeMultiprocessorCount, dev);
        (void)hipFuncSetAttribute((const void*)fwd_kernel, hipFuncAttributeMaxDynamicSharedMemorySize, LDS_BYTES);
        (void)hipOccupancyMaxActiveBlocksPerMultiprocessor(&per_cu, (const void*)fwd_kernel, NTHR, LDS_BYTES);
        if (per_cu < 1) { fprintf(stderr, "kernel_launch: occupancy query says %d blocks per CU\n", per_cu); per_cu = 1; }
        (void)hipGetLastError();
        grid = cus;
        if (grid > 256) grid = 256;
    }
    if (grid < 0) return;
    if (hipMemsetAsync((char*)d_ws + WS_BAR, 0, 16384, stream) != hipSuccess) { fprintf(stderr, "memset failed\n"); return; }
    Args a{};
    for (int i = 0; i < 30; ++i) a.in[i] = (const float*)d_in[i];
    a.out = (float*)d_out; a.ws = (unsigned char*)d_ws;
#if MK_SINGLE
    a.ph_lo = 0; a.ph_hi = NPHASE;
    void* kargs[] = {&a};
    hipError_t e = hipLaunchCooperativeKernel((const void*)fwd_kernel, dim3(grid), dim3(NTHR), kargs, LDS_BYTES, stream);
    if (e != hipSuccess) fprintf(stderr, "cooperative launch failed: %s (grid %d)\n", hipGetErrorString(e), grid);
#else
    for (int p = 0; p < NPHASE; ++p) { a.ph_lo = p; a.ph_hi = p + 1; hipLaunchKernelGGL(fwd_kernel, dim3(grid), dim3(NTHR), LDS_BYTES, stream, a); }
#endif
}
```

```cpp
#include <hip/hip_runtime.h>
#include <hip/hip_cooperative_groups.h>
#include <cstdio>
#include <cstdint>
namespace cg = cooperative_groups;

#ifndef MK_SINGLE
#define MK_SINGLE 1
#endif

#define LAS __attribute__((address_space(3)))
typedef unsigned short bf16_t;
typedef short bf16x8 __attribute__((ext_vector_type(8)));
typedef float f32x4 __attribute__((ext_vector_type(4)));
typedef float f32x2 __attribute__((ext_vector_type(2)));
typedef unsigned u32x4 __attribute__((ext_vector_type(4)));
typedef unsigned u32x2 __attribute__((ext_vector_type(2)));

constexpr int BATCH = 2, T = 8192, D = 1024, FF = 4096, M = BATCH * T;
constexpr int NWAVES = 8, NTHR = 512;
constexpr float NORM_EPS = 1e-5f, GN_EPS = 64e-5f;

constexpr size_t MiB = 1u << 20;
constexpr size_t WS_SS = 0;
constexpr size_t WS_BAR = 1 * MiB + 65536;
constexpr size_t WS_WRKV = 2 * MiB;
constexpr size_t WS_WO = 8 * MiB;
constexpr size_t WS_L1 = 10 * MiB;
constexpr size_t WS_L2 = 12 * MiB;
constexpr size_t WS_G2 = 14 * MiB;
constexpr size_t WS_R = 15 * MiB, WS_K = 47 * MiB, WS_V = 79 * MiB;
constexpr size_t WS_XR = 111 * MiB;
constexpr size_t WS_AA = 111 * MiB;
constexpr size_t WS_OD = 175 * MiB;
constexpr size_t WS_A2 = 239 * MiB;
constexpr size_t WS_SG = 247 * MiB;
constexpr size_t WS_W1_0 = 15 * MiB, WS_W2_0 = 23 * MiB, WS_WIN = 31 * MiB, WS_WOUT = 39 * MiB, WS_WSB = 43 * MiB, WS_W1_1 = 44 * MiB, WS_W2_1 = 52 * MiB;
constexpr size_t WS_XB = 60 * MiB;
constexpr size_t WS_H = 92 * MiB;
constexpr size_t WS_LNP = 220 * MiB;
constexpr size_t WS_END = 256 * MiB;

constexpr int RING_BYTES = 131072, RS_OFF = RING_BYTES + 1024, LDS_BYTES = 147456;

__device__ __forceinline__ unsigned cvt_pk_bf16(float lo, float hi) { unsigned r; asm volatile("v_cvt_pk_bf16_f32 %0, %1, %2" : "=v"(r) : "v"(lo), "v"(hi)); return r; }
__device__ __forceinline__ float bf_lo(unsigned w) { return __builtin_bit_cast(float, w << 16); }
__device__ __forceinline__ float bf_hi(unsigned w) { return __builtin_bit_cast(float, w & 0xffff0000u); }
__device__ __forceinline__ float wave_sum(float v) {
#pragma unroll
    for (int o = 1; o < 64; o <<= 1) v += __shfl_xor(v, o);
    return v;
}
template <int CTRL> __device__ __forceinline__ float dpp_f(float x) { return __builtin_bit_cast(float, __builtin_amdgcn_update_dpp(0, __builtin_bit_cast(int, x), CTRL, 0xF, 0xF, true)); }
__device__ __forceinline__ float row16_allsum(float x) { x += dpp_f<0x128>(x); x += dpp_f<0x124>(x); x += dpp_f<0x122>(x); x += dpp_f<0x121>(x); return x; }
__device__ __forceinline__ float sigmoidf_(float x) { return __builtin_amdgcn_rcpf(1.0f + __expf(-x)); }
__device__ __forceinline__ float tanhf_(float x) { return 1.0f - 2.0f * __builtin_amdgcn_rcpf(__expf(2.0f * x) + 1.0f); }
__device__ __forceinline__ f32x2 gelu_pk(f32x2 v) {
    const f32x2 av = __builtin_elementwise_abs(v), d = av * 0.2316418882f + 1.0f;
    f32x2 t; t.x = __builtin_amdgcn_rcpf(d.x); t.y = __builtin_amdgcn_rcpf(d.y);
    f32x2 q = t * 0.5307027145f + (-0.7265760135f); q = q * t + 0.7107068705f; q = q * t + (-0.142248368f); q = q * t + 0.127414796f; q = q * t;
    const f32x2 s = (v * v) * (-0.72134752044f);
    f32x2 e; e.x = __builtin_amdgcn_exp2f(s.x); e.y = __builtin_amdgcn_exp2f(s.y);
    const f32x2 m = v * (q * e), r = v - m;
    f32x2 o; o.x = v.x < 0.f ? m.x : r.x; o.y = v.y < 0.f ? m.y : r.y; return o;
}
__device__ __forceinline__ u32x4 pack8(const f32x4 a, const f32x4 b) { u32x4 w; w.x = cvt_pk_bf16(a[0], a[1]); w.y = cvt_pk_bf16(a[2], a[3]); w.z = cvt_pk_bf16(b[0], b[1]); w.w = cvt_pk_bf16(b[2], b[3]); return w; }
__device__ __forceinline__ void unpack8(const u32x4 w, float (&f)[8]) { f[0] = bf_lo(w.x); f[1] = bf_hi(w.x); f[2] = bf_lo(w.y); f[3] = bf_hi(w.y); f[4] = bf_lo(w.z); f[5] = bf_hi(w.z); f[6] = bf_lo(w.w); f[7] = bf_hi(w.w); }

namespace pg8 {
constexpr int BM = 256, BK = 64, HALF = 128, HTB = HALF * BK * 2, NXCD = 8, WGM = 4;
__host__ __device__ __forceinline__ int lds_byte(int r, int c) { const int st = (r >> 4) * 2 + (c >> 5), rr = r & 15, cc = c & 31, ob = rr * 64 + cc * 2; return st * 1024 + (ob ^ (((ob >> 9) & 1) << 5)); }
__host__ __device__ __forceinline__ void stage_rc(int b, int& R, int& C) { const int st = b / 1024, sb = b % 1024, swz = sb ^ (((sb >> 9) & 1) << 5); R = (st >> 1) * 16 + swz / 64; C = (st & 1) * 32 + (swz % 64) / 2; }
__host__ __device__ __forceinline__ int perm32(int rho) { const int n = rho >> 4, i = rho & 15; return 8 * (i >> 2) + 4 * n + (i & 3); }

struct Unit { int pm, pn; };
struct Gemm { const bf16_t* A; const bf16_t* Bt; int M, N, K, lda; int agrp; size_t astride; };

struct StaticOrder {
    int nM, nN, nwg, G, c, L0, cnt;
    __host__ __device__ void init(int M_, int N_, int G_, int c_) { nM = M_ / BM; nN = N_ / BM; nwg = nM * nN; G = G_; c = c_; L0 = 0; cnt = 1 << 20; }
    __host__ __device__ void init_sub(int M_, int N_, int G_, int c_, int L0_, int cnt_) { init(M_, N_, G_, c_); L0 = L0_; cnt = cnt_; }
    __host__ __device__ bool next(int i, Unit& u) const {
        if (i >= cnt || c < 0) return false;
        const long L = (long)L0 + (long)i * G + c; if (L >= nwg) return false;
        int wgid = (int)L; { const int q = nwg / NXCD, r = nwg % NXCD, xcd = wgid % NXCD, off = wgid / NXCD; wgid = (xcd < r ? xcd * (q + 1) : r * (q + 1) + (xcd - r) * q) + off; }
        const int nig = WGM * nN, gid = wgid / nig, fm = gid * WGM, gsz = (nM - fm) < WGM ? (nM - fm) : WGM;
        u.pm = fm + ((wgid % nig) % gsz); u.pn = (wgid % nig) / gsz; return true;
    }
};

template <class Epi>
__device__ __forceinline__ void gemm_phase(LAS unsigned char* lds, const Gemm g, const StaticOrder& S, const Epi& E) {
    const int tid = threadIdx.x, wid = __builtin_amdgcn_readfirstlane(tid >> 6), lane = tid & 63, wr = wid >> 2, wc = wid & 3, fr = lane & 15, fq = lane >> 4;
    const int K = g.K, nt = K / BK;
    unsigned voffA[2], voffB[2];
#pragma unroll
    for (int i = 0; i < 2; ++i) { int R, C; stage_rc(tid * 16 + i * 8192, R, C); const int Rb = (R & ~31) + perm32(R & 31);
        voffA[i] = (unsigned)(R * g.lda + C) * 2u; voffB[i] = (unsigned)(Rb * K + C) * 2u; }
    const size_t kstep = (size_t)(BK * 2);
    const size_t hA = (size_t)HALF * g.lda * 2, tA = 2 * hA, hB = (size_t)HALF * K * 2, tB = 2 * hB;
    const unsigned ldsw = (unsigned)wid * 1024u;
    const int aoff = lds_byte(wr * 64 + fr, fq * 8), boff = lds_byte(wc * 32 + fr, fq * 8);
#define PG8_SA(b, h) (((b) * 2 + (h)) * HTB)
#define PG8_SB(b, h) ((4 + (b) * 2 + (h)) * HTB)
#define PG8_STAGE(bufoff, gbase, voff) do { _Pragma("unroll") for (int _i = 0; _i < 2; ++_i) \
        __builtin_amdgcn_global_load_lds((const unsigned*)((const char*)(gbase) + (voff)[_i]), (LAS unsigned*)(lds + (bufoff) + ldsw + _i * 8192), 16, 0, 0); } while (0)
#define PG8_LDA(dst, b, h) do { _Pragma("unroll") for (int m = 0; m < 4; ++m) _Pragma("unroll") for (int k = 0; k < 2; ++k) dst[m][k] = *(const LAS bf16x8*)(lds + PG8_SA(b, h) + aoff + m * 2048 + k * 1024); } while (0)
#define PG8_LDB(dst, b, h) do { _Pragma("unroll") for (int n = 0; n < 2; ++n) _Pragma("unroll") for (int k = 0; k < 2; ++k) dst[n][k] = *(const LAS bf16x8*)(lds + PG8_SB(b, h) + boff + n * 2048 + k * 1024); } while (0)
#define PG8_MMA(ai, bj, At, Bt) do { __builtin_amdgcn_s_setprio(1); _Pragma("unroll") for (int m = 0; m < 4; ++m) _Pragma("unroll") for (int n = 0; n < 2; ++n) _Pragma("unroll") for (int k = 0; k < 2; ++k) \
        acc[ai][bj][m][n] = __builtin_amdgcn_mfma_f32_16x16x32_bf16(Bt[n][k], At[m][k], acc[ai][bj][m][n], 0, 0, 0); __builtin_amdgcn_s_setprio(0); } while (0)
#define PG8_WAIT_V(n) asm volatile("s_waitcnt vmcnt(" #n ")" ::: "memory")
#define PG8_WAIT_L(n) asm volatile("s_waitcnt lgkmcnt(" #n ")" ::: "memory")
#define PG8_BAR __builtin_amdgcn_s_barrier()
#define PG8_SCHED __builtin_amdgcn_sched_barrier(0)
    Unit cur, nxt; int ui = 0;
    if (!S.next(0, cur)) return;
    f32x4 acc[2][2][4][2];
#pragma unroll
    for (int a = 0; a < 2; ++a)
#pragma unroll
        for (int b = 0; b < 2; ++b)
#pragma unroll
            for (int m = 0; m < 4; ++m)
#pragma unroll
                for (int n = 0; n < 2; ++n) acc[a][b][m][n] = (f32x4){0.f, 0.f, 0.f, 0.f};
    bf16x8 At[4][2], B0[2][2], B1[2][2];
    const char* cA = (const char*)g.A + (size_t)cur.pm * tA + (size_t)(cur.pn / g.agrp) * g.astride; const char* cB = (const char*)g.Bt + (size_t)cur.pn * tB;
    PG8_STAGE(PG8_SB(0, 0), cB, voffB); PG8_STAGE(PG8_SB(0, 1), cB + hB, voffB); PG8_STAGE(PG8_SA(0, 0), cA, voffA); PG8_STAGE(PG8_SA(0, 1), cA + hA, voffA);
    if (wr == 1) PG8_BAR;
    PG8_WAIT_V(2); PG8_BAR;
    PG8_STAGE(PG8_SB(1, 0), cB + kstep, voffB); PG8_STAGE(PG8_SA(1, 0), cA + kstep, voffA); PG8_STAGE(PG8_SB(1, 1), cB + hB + kstep, voffB);
    PG8_WAIT_V(6); PG8_BAR;
    for (;;) {
        const bool has_next = S.next(ui + 1, nxt);
        const char* nA = has_next ? (const char*)g.A + (size_t)nxt.pm * tA + (size_t)(nxt.pn / g.agrp) * g.astride : cA; const char* nB = has_next ? (const char*)g.Bt + (size_t)nxt.pn * tB : cB;
#pragma nounroll
        for (int t = 0; t < nt; t += 2) {
            const bool last = (t == nt - 2);
            const char* a1 = cA + (size_t)(t + 1) * kstep;
            const char* a2 = last ? nA : cA + (size_t)(t + 2) * kstep; const char* b2 = last ? nB : cB + (size_t)(t + 2) * kstep;
            const char* a3 = a2 + kstep; const char* b3 = b2 + kstep;
            PG8_LDB(B0, 0, 0); PG8_LDB(B1, 0, 1); PG8_SCHED; PG8_LDA(At, 0, 0); PG8_STAGE(PG8_SA(1, 1), a1 + hA, voffA);
            PG8_WAIT_V(8); PG8_WAIT_L(0); PG8_BAR; PG8_MMA(0, 0, At, B0); PG8_MMA(0, 1, At, B1); PG8_BAR; PG8_SCHED;
            PG8_LDA(At, 0, 1); PG8_STAGE(PG8_SB(0, 0), b2, voffB); PG8_STAGE(PG8_SB(0, 1), b2 + hB, voffB); PG8_STAGE(PG8_SA(0, 0), a2, voffA);
            PG8_WAIT_V(8); PG8_WAIT_L(0); PG8_BAR; PG8_MMA(1, 0, At, B0); PG8_MMA(1, 1, At, B1); PG8_BAR; PG8_SCHED;
            PG8_LDB(B0, 1, 0); PG8_LDB(B1, 1, 1); PG8_SCHED; PG8_LDA(At, 1, 0); PG8_STAGE(PG8_SA(0, 1), a2 + hA, voffA);
            PG8_WAIT_V(8); PG8_WAIT_L(0); PG8_BAR; PG8_MMA(0, 0, At, B0); PG8_MMA(0, 1, At, B1); PG8_BAR; PG8_SCHED;
            PG8_LDA(At, 1, 1); PG8_STAGE(PG8_SB(1, 0), b3, voffB); PG8_STAGE(PG8_SB(1, 1), b3 + hB, voffB); PG8_STAGE(PG8_SA(1, 0), a3, voffA);
            PG8_WAIT_V(8); PG8_WAIT_L(0); PG8_BAR; PG8_MMA(1, 0, At, B0); PG8_MMA(1, 1, At, B1); PG8_BAR; PG8_SCHED;
        }
        if (wr == 0) PG8_BAR;
        E(acc, cur, ui, wr, wc, fr, fq);
        if (!has_next) break;
#pragma unroll
        for (int a = 0; a < 2; ++a)
#pragma unroll
            for (int b = 0; b < 2; ++b)
#pragma unroll
                for (int m = 0; m < 4; ++m)
#pragma unroll
                    for (int n = 0; n < 2; ++n) acc[a][b][m][n] = (f32x4){0.f, 0.f, 0.f, 0.f};
        cur = nxt; cA = nA; cB = nB; ++ui;
        if (wr == 1) PG8_BAR;
    }
    PG8_WAIT_V(0);
    PG8_BAR;
#undef PG8_SA
#undef PG8_SB
#undef PG8_STAGE
#undef PG8_LDA
#undef PG8_LDB
#undef PG8_MMA
#undef PG8_WAIT_V
#undef PG8_WAIT_L
#undef PG8_BAR
#undef PG8_SCHED
}

#define EPI_ARGS const f32x4 (&acc)[2][2][4][2], const Unit& u, int ui, int wr, int wc, int fr, int fq
#define EPI_ROWS for (int ai = 0; ai < 2; ++ai) _Pragma("unroll") for (int m = 0; m < 4; ++m)
struct EpiSplit {
    bf16_t* O; int ldc; int split_cols; size_t split_stride;
    __device__ __forceinline__ void operator()(EPI_ARGS) const {
        int colt = u.pn * BM; const int t = colt / split_cols; bf16_t* base = O + (size_t)t * split_stride; colt -= t * split_cols;
        const int col0 = colt + wc * 32 + 8 * fq;
#pragma unroll
        EPI_ROWS { bf16_t* rowp = base + (size_t)(u.pm * BM + ai * HALF + wr * 64 + m * 16 + fr) * ldc + col0;
#pragma unroll
            for (int bj = 0; bj < 2; ++bj) *(u32x4*)(rowp + bj * HALF) = pack8(acc[ai][bj][m][0], acc[ai][bj][m][1]); }
    }
};
struct EpiLora1 {
    bf16_t* A2; bf16_t* SG;
    __device__ __forceinline__ void operator()(EPI_ARGS) const {
        bf16_t* base = u.pn == 0 ? A2 : SG; const int col0 = wc * 32 + 8 * fq;
#pragma unroll
        EPI_ROWS { bf16_t* rowp = base + (size_t)(u.pm * BM + ai * HALF + wr * 64 + m * 16 + fr) * 256 + col0;
            f32x4 v0 = acc[ai][0][m][0], v1 = acc[ai][0][m][1];
            if (u.pn == 0) { for (int e = 0; e < 4; ++e) { v0[e] = tanhf_(v0[e]); v1[e] = tanhf_(v1[e]); } }
            else { for (int e = 0; e < 4; ++e) { v0[e] = sigmoidf_(v0[e]); v1[e] = sigmoidf_(v1[e]); } }
            *(u32x4*)(rowp) = pack8(v0, v1);
            f32x4 w0 = acc[ai][1][m][0], w1 = acc[ai][1][m][1];
            if (u.pn != 0) { w0 = (f32x4){0.f, 0.f, 0.f, 0.f}; w1 = w0; }
            *(u32x4*)(rowp + HALF) = pack8(w0, w1); }
    }
};
struct EpiLora2 {
    bf16_t* EW; bf16_t* AA; const float* w0; const float* a0;
    __device__ __forceinline__ void operator()(EPI_ARGS) const {
        const int grp = u.pn >> 2, c0 = (u.pn & 3) * BM + wc * 32 + 8 * fq;
        const float* bias = (grp < 2 ? w0 + grp * D : a0 + (grp - 2) * D) + c0;
        bf16_t* base = (grp < 2 ? EW + (size_t)grp * M * D : AA + (size_t)(grp - 2) * M * D) + c0;
        const float sc = grp < 2 ? 0.60653065971f : 1.0f;
#pragma unroll
        EPI_ROWS { bf16_t* rowp = base + (size_t)(u.pm * BM + ai * HALF + wr * 64 + m * 16 + fr) * D;
#pragma unroll
            for (int bj = 0; bj < 2; ++bj) { f32x4 v0 = acc[ai][bj][m][0] + *(const f32x4*)(bias + bj * HALF), v1 = acc[ai][bj][m][1] + *(const f32x4*)(bias + bj * HALF + 4);
                for (int e = 0; e < 4; ++e) { v0[e] = sigmoidf_(v0[e]) * sc; v1[e] = sigmoidf_(v1[e]) * sc; }
                *(u32x4*)(rowp + bj * HALF) = pack8(v0, v1); } if (m & 1) asm volatile("" ::: "memory"); }
    }
};
struct EpiG {
    bf16_t* Z;
    __device__ __forceinline__ void operator()(EPI_ARGS) const {
        const int col0 = u.pn * BM + wc * 32 + 8 * fq;
#pragma unroll
        EPI_ROWS { bf16_t* rowp = Z + (size_t)(u.pm * BM + ai * HALF + wr * 64 + m * 16 + fr) * D + col0;
#pragma unroll
            for (int bj = 0; bj < 2; ++bj) { const u32x4 zw = *(const u32x4*)(rowp + bj * HALF); float z[8]; unpack8(zw, z);
                f32x4 v0 = acc[ai][bj][m][0], v1 = acc[ai][bj][m][1];
                for (int e = 0; e < 4; ++e) { v0[e] *= z[e]; v1[e] *= z[4 + e]; }
                *(u32x4*)(rowp + bj * HALF) = pack8(v0, v1); } if (m & 1) asm volatile("" ::: "memory"); }
    }
};
template <bool BASE_F32> struct EpiRes {
    const float* basef; bf16_t* xb; float* ss;
    __device__ __forceinline__ void operator()(EPI_ARGS) const {
        const int col0 = u.pn * BM + wc * 32 + 8 * fq;
#pragma unroll
        EPI_ROWS { const int row = u.pm * BM + ai * HALF + wr * 64 + m * 16 + fr; const size_t off = (size_t)row * D + col0; float sq = 0.f;
#pragma unroll
            for (int bj = 0; bj < 2; ++bj) { f32x4 b0, b1;
                if (BASE_F32) { const float* bp = basef + off + bj * HALF; b0 = *(const f32x4*)bp; b1 = *(const f32x4*)(bp + 4); }
                else { const u32x4 w = *(const u32x4*)(xb + off + bj * HALF); float t[8]; unpack8(w, t); b0 = (f32x4){t[0], t[1], t[2], t[3]}; b1 = (f32x4){t[4], t[5], t[6], t[7]}; }
                const f32x4 v0 = acc[ai][bj][m][0] + b0, v1 = acc[ai][bj][m][1] + b1;
                *(u32x4*)(xb + off + bj * HALF) = pack8(v0, v1);
                sq += (v0[0] * v0[0] + v0[1] * v0[1]) + (v0[2] * v0[2] + v0[3] * v0[3]) + (v1[0] * v1[0] + v1[1] * v1[1]) + (v1[2] * v1[2] + v1[3] * v1[3]); }
            sq += __shfl_xor(sq, 16); sq += __shfl_xor(sq, 32);
            if (fq == 0) ss[(size_t)row * 16 + u.pn * 4 + wc] = sq; if (m & 1) asm volatile("" ::: "memory"); }
    }
};
struct EpiSq {
    bf16_t* H; const LAS float* RS;
    __device__ __forceinline__ void operator()(EPI_ARGS) const {
        const int col0 = u.pn * BM + wc * 32 + 8 * fq;
#pragma unroll
        EPI_ROWS { const int rl = ai * HALF + wr * 64 + m * 16 + fr; const float rs = RS[ui * 256 + rl]; bf16_t* rowp = H + (size_t)(u.pm * BM + rl) * FF + col0;
#pragma unroll
            for (int bj = 0; bj < 2; ++bj) { f32x4 v0 = acc[ai][bj][m][0] * rs, v1 = acc[ai][bj][m][1] * rs;
                for (int e = 0; e < 4; ++e) { const float a = fmaxf(v0[e], 0.f), b = fmaxf(v1[e], 0.f); v0[e] = a * a; v1[e] = b * b; }
                *(u32x4*)(rowp + bj * HALF) = pack8(v0, v1); } }
    }
};
struct EpiGelu {
    bf16_t* H; const LAS float* RS; f32x2* LNP;
    __device__ __forceinline__ void operator()(EPI_ARGS) const {
        const int col0 = u.pn * BM + wc * 32 + 8 * fq;
#pragma unroll
        EPI_ROWS { const int rl = ai * HALF + wr * 64 + m * 16 + fr; const float rs = RS[ui * 256 + rl]; const int row = u.pm * BM + rl; bf16_t* rowp = H + (size_t)row * FF + col0; float s = 0.f, q = 0.f;
#pragma unroll
            for (int bj = 0; bj < 2; ++bj) { f32x4 v0 = acc[ai][bj][m][0] * rs, v1 = acc[ai][bj][m][1] * rs;
                const f32x2 g0 = gelu_pk((f32x2){v0[0], v0[1]}), g1 = gelu_pk((f32x2){v0[2], v0[3]}), g2 = gelu_pk((f32x2){v1[0], v1[1]}), g3 = gelu_pk((f32x2){v1[2], v1[3]});
                v0 = (f32x4){g0.x, g0.y, g1.x, g1.y}; v1 = (f32x4){g2.x, g2.y, g3.x, g3.y};
                s += (v0[0] + v0[1]) + (v0[2] + v0[3]) + (v1[0] + v1[1]) + (v1[2] + v1[3]);
                q += (v0[0] * v0[0] + v0[1] * v0[1]) + (v0[2] * v0[2] + v0[3] * v0[3]) + (v1[0] * v1[0] + v1[1] * v1[1]) + (v1[2] * v1[2] + v1[3] * v1[3]);
                *(u32x4*)(rowp + bj * HALF) = pack8(v0, v1); }
            if (u.pn >= 8) { s += __shfl_xor(s, 16); s += __shfl_xor(s, 32); q += __shfl_xor(q, 16); q += __shfl_xor(q, 32);
                if (fq == 0) LNP[(size_t)row * 32 + (u.pn - 8) * 4 + wc] = (f32x2){s, q}; } }
    }
};
}

struct Args { const float* in[30]; float* out; unsigned char* ws; int ph_lo, ph_hi; };
struct Frame {
    LAS unsigned char* lds;
    int tid, lane, wave, G;
    float* out; unsigned char* ws;
};
#define LDS_WAIT() asm volatile("s_waitcnt lgkmcnt(0)" ::: "memory")

__device__ __forceinline__ void tr_item(const float* W, int ldw, bf16_t* WT, int ldt, int drow0, int dcol0, const float* ks, LAS float* scr, int k0, int n0, int lane) {
#pragma unroll 8
    for (int i = 0; i < 32; ++i) { const int kk = 2 * i + (lane >> 5); float v = W[(size_t)(k0 + kk) * ldw + n0 + (lane & 31)]; if (ks) v *= ks[k0 + kk]; scr[kk * 33 + (lane & 31)] = v; }
    LDS_WAIT(); asm volatile("" ::: "memory");
    const int c = lane & 7;
#pragma unroll
    for (int j = 0; j < 4; ++j) { const int n = (lane >> 3) + 8 * j; const LAS float* s = scr + (8 * c) * 33 + n;
        u32x4 o; o.x = cvt_pk_bf16(s[0 * 33], s[1 * 33]); o.y = cvt_pk_bf16(s[2 * 33], s[3 * 33]); o.z = cvt_pk_bf16(s[4 * 33], s[5 * 33]); o.w = cvt_pk_bf16(s[6 * 33], s[7 * 33]);
        *(u32x4*)(WT + (size_t)(drow0 + n0 + n) * ldt + dcol0 + k0 + 8 * c) = o; }
    LDS_WAIT(); asm volatile("" ::: "memory");
}
__device__ __forceinline__ void zero_item(bf16_t* WT, int ldt, int row0, int col0, int lane) {
#pragma unroll
    for (int j = 0; j < 4; ++j) { const int q = lane + 64 * j, r = q >> 3, c = q & 7; *(u32x4*)(WT + (size_t)(row0 + r) * ldt + col0 + 8 * c) = (u32x4){0u, 0u, 0u, 0u}; }
}
#define TR_MAT(W, KK, NN, WT, LDT, DR, DC, KS) { const int _n = ((KK) / 64) * ((NN) / 32); if (r < _n) { const int _nb = (NN) / 32; tr_item(W, NN, WT, LDT, DR, DC, KS, scr, 64 * (r / _nb), 32 * (r % _nb), F.lane); continue; } r -= _n; }

__device__ __forceinline__ void p0_phase(Frame& F, const Args& A) {
    LAS float* scr = (LAS float*)(F.lds + F.wave * 16384);
    const int gw = blockIdx.x * NWAVES + F.wave, NGW = F.G * NWAVES;
    bf16_t* WRKV = (bf16_t*)(F.ws + WS_WRKV); bf16_t* WO = (bf16_t*)(F.ws + WS_WO); bf16_t* L1 = (bf16_t*)(F.ws + WS_L1); bf16_t* L2 = (bf16_t*)(F.ws + WS_L2); bf16_t* G2 = (bf16_t*)(F.ws + WS_G2);
    const float* mu = A.in[4];
    constexpr int NZ1 = 128, NZ2 = 128;
    constexpr int NTOT = 4 * 512 + 2 * (4 * 32 + 64) + 4 * 32 + 64 + NZ1 + NZ2;
    for (int it = gw; it < NTOT; it += NGW) {
        int r = it;
        TR_MAT(A.in[5], 1024, 1024, WRKV, 1024, 0, 0, nullptr)
        TR_MAT(A.in[6], 1024, 1024, WRKV, 1024, 1024, 0, nullptr)
        TR_MAT(A.in[7], 1024, 1024, WRKV, 1024, 2048, 0, nullptr)
        TR_MAT(A.in[8], 1024, 1024, WO, 1024, 0, 0, nullptr)
        TR_MAT(A.in[10], 1024, 64, L1, 2048, 0, 0, nullptr)
        TR_MAT(A.in[10] + 1024 * 64, 1024, 64, L1, 2048, 64, 0, nullptr)
        TR_MAT(A.in[13], 1024, 64, L1, 2048, 128, 0, nullptr)
        TR_MAT(A.in[13] + 1024 * 64, 1024, 64, L1, 2048, 192, 0, nullptr)
        TR_MAT(A.in[15], 1024, 128, L1, 2048, 256, 0, nullptr)
        TR_MAT(A.in[10], 1024, 64, L1, 2048, 0, 1024, mu + 1 * D)
        TR_MAT(A.in[10] + 1024 * 64, 1024, 64, L1, 2048, 64, 1024, mu + 1 * D)
        TR_MAT(A.in[13], 1024, 64, L1, 2048, 128, 1024, mu + 4 * D)
        TR_MAT(A.in[13] + 1024 * 64, 1024, 64, L1, 2048, 192, 1024, mu + 4 * D)
        TR_MAT(A.in[15], 1024, 128, L1, 2048, 256, 1024, mu + 5 * D)
        TR_MAT(A.in[11], 64, 1024, L2, 128, 0, 0, nullptr)
        TR_MAT(A.in[11] + 64 * 1024, 64, 1024, L2, 128, 1024, 64, nullptr)
        TR_MAT(A.in[14], 64, 1024, L2, 128, 2048, 0, nullptr)
        TR_MAT(A.in[14] + 64 * 1024, 64, 1024, L2, 128, 3072, 64, nullptr)
        TR_MAT(A.in[16], 128, 1024, G2, 128, 0, 0, nullptr)
        if (r < NZ1) { zero_item(L1, 2048, 384 + 32 * (r / 32), 64 * (r % 32), F.lane); continue; } r -= NZ1;
        { const int grp = r / 32; zero_item(L2, 128, 32 * r, 64 * (1 - (grp & 1)), F.lane); }
    }
    const float* x = A.in[0]; const float* gn = A.in[1];
    bf16_t* XNXX = (bf16_t*)F.out; bf16_t* XR = (bf16_t*)(F.ws + WS_XR);
    f32x4 gv[4], m0[4], m2[4], m3[4];
#pragma unroll
    for (int j = 0; j < 4; ++j) { gv[j] = ((const f32x4*)gn)[64 * j + F.lane]; m0[j] = ((const f32x4*)mu)[64 * j + F.lane]; m2[j] = ((const f32x4*)(mu + 2 * D))[64 * j + F.lane]; m3[j] = ((const f32x4*)(mu + 3 * D))[64 * j + F.lane]; }
    for (int m = gw; m < M; m += NGW) {
        const int t = m & (T - 1); const bool hp = t > 0, hn = t < T - 1;
        const f32x4* xc = (const f32x4*)(x + (size_t)m * D) + F.lane; const f32x4* xp = xc - D / 4; const f32x4* xq = xc + D / 4;
        f32x4 vc[4], vp[4], vn[4]; float sc = 0.f, sp = 0.f, sn = 0.f; const f32x4 z4 = {0.f, 0.f, 0.f, 0.f};
#pragma unroll
        for (int j = 0; j < 4; ++j) { vc[j] = xc[64 * j]; vp[j] = hp ? xp[64 * j] : z4; vn[j] = hn ? xq[64 * j] : z4;
            sc += (vc[j].x * vc[j].x + vc[j].y * vc[j].y) + (vc[j].z * vc[j].z + vc[j].w * vc[j].w);
            sp += (vp[j].x * vp[j].x + vp[j].y * vp[j].y) + (vp[j].z * vp[j].z + vp[j].w * vp[j].w);
            sn += (vn[j].x * vn[j].x + vn[j].y * vn[j].y) + (vn[j].z * vn[j].z + vn[j].w * vn[j].w); }
        const float rc = 1.0f / sqrtf(wave_sum(sc) * (1.f / D) + NORM_EPS), rp = 1.0f / sqrtf(wave_sum(sp) * (1.f / D) + NORM_EPS), rn = 1.0f / sqrtf(wave_sum(sn) * (1.f / D) + NORM_EPS);
#pragma unroll
        for (int j = 0; j < 4; ++j) { const int col = 4 * (64 * j + F.lane);
            const f32x4 a = vc[j] * rc * gv[j], xx = (vp[j] * rp + vn[j] * rn) * gv[j] * 0.5f - a;
            const f32x4 vr = a + xx * m0[j], vk = a + xx * m2[j], vv = a + xx * m3[j];
            *(u32x2*)(XNXX + (size_t)m * 2048 + col) = (u32x2){cvt_pk_bf16(a[0], a[1]), cvt_pk_bf16(a[2], a[3])};
            *(u32x2*)(XNXX + (size_t)m * 2048 + 1024 + col) = (u32x2){cvt_pk_bf16(xx[0], xx[1]), cvt_pk_bf16(xx[2], xx[3])};
            *(u32x2*)(XR + (size_t)m * D + col) = (u32x2){cvt_pk_bf16(vr[0], vr[1]), cvt_pk_bf16(vr[2], vr[3])};
            *(u32x2*)(XR + (size_t)M * D + (size_t)m * D + col) = (u32x2){cvt_pk_bf16(vk[0], vk[1]), cvt_pk_bf16(vk[2], vk[3])};
            *(u32x2*)(XR + 2 * (size_t)M * D + (size_t)m * D + col) = (u32x2){cvt_pk_bf16(vv[0], vv[1]), cvt_pk_bf16(vv[2], vv[3])}; }
    }
}

__device__ __forceinline__ void convB_phase(Frame& F, const Args& A) {
    LAS float* scr = (LAS float*)(F.lds + F.wave * 16384);
    const int gw = blockIdx.x * NWAVES + F.wave, NGW = F.G * NWAVES;
    bf16_t* W1_0 = (bf16_t*)(F.ws + WS_W1_0); bf16_t* W2_0 = (bf16_t*)(F.ws + WS_W2_0); bf16_t* WIN = (bf16_t*)(F.ws + WS_WIN); bf16_t* WOUT = (bf16_t*)(F.ws + WS_WOUT);
    bf16_t* WSB = (bf16_t*)(F.ws + WS_WSB); bf16_t* W1_1 = (bf16_t*)(F.ws + WS_W1_1); bf16_t* W2_1 = (bf16_t*)(F.ws + WS_W2_1);
    constexpr int NTOT = 5 * 2048 + 1024 + 512;
    for (int it = gw; it < NTOT; it += NGW) {
        int r = it;
        TR_MAT(A.in[28], 1024, 4096, W1_0, 1024, 0, 0, A.in[2])
        TR_MAT(A.in[29], 4096, 1024, W2_0, 4096, 0, 0, nullptr)
        TR_MAT(A.in[22], 1024, 4096, WIN, 1024, 0, 0, A.in[1] + D)
        TR_MAT(A.in[28] + (size_t)D * FF, 1024, 4096, W1_1, 1024, 0, 0, A.in[2] + D)
        TR_MAT(A.in[29] + (size_t)D * FF, 4096, 1024, W2_1, 4096, 0, 0, nullptr)
        TR_MAT(A.in[27], 2048, 1024, WOUT, 2048, 0, 0, nullptr)
        { const float* s = A.in[25] + (size_t)r * 512 + F.lane * 8; const f32x4 a = *(const f32x4*)s, b = *(const f32x4*)(s + 4); *(u32x4*)(WSB + (size_t)r * 512 + F.lane * 8) = pack8(a, b); }
    }
}

constexpr int TC = 16, NCH = T / TC, SREC = 336;
template <int VAR>
__device__ __forceinline__ void scan_phase(Frame& F, const Args& A) {
    LAS float* BUF = (LAS float*)(F.lds);
    LAS float* OP = (LAS float*)(F.lds + 4 * TC * SREC * 4);
    LAS unsigned* FL = (LAS unsigned*)(F.lds + 4 * TC * SREC * 4 + 2 * TC * 256 * 4);
    const int tid = F.tid, lane = F.lane, wave = F.wave;
    const bool prod = wave >= 4; const int ptid = tid - 256;
    const bf16_t* Rg = (const bf16_t*)(F.ws + WS_R); const bf16_t* Kg = (const bf16_t*)(F.ws + WS_K); const bf16_t* Vg = (const bf16_t*)(F.ws + WS_V);
    const bf16_t* EWg = (const bf16_t*)F.out; const bf16_t* AAg = (const bf16_t*)(F.ws + WS_AA); bf16_t* ODg = (bf16_t*)(F.ws + WS_OD);
    for (int it0 = blockIdx.x; it0 < 256; it0 += F.G) {
        const int item = (F.G == 256) ? ((it0 & 7) * 32 + (it0 >> 3)) : it0;
        const int chain = item >> 2, quarter = item & 3, dir = chain & 1, bh = chain >> 1, b = bh >> 4, h = bh & 15, row0 = quarter * 16;
        const size_t boff = (size_t)b * T * D + h * 64;
        const bf16_t* Rp = Rg + boff; const bf16_t* Kp = Kg + boff; const bf16_t* Vp = Vg + boff;
        const bf16_t* Ep = EWg + (size_t)dir * M * D + boff; const bf16_t* Ap = AAg + (size_t)dir * M * D + boff; bf16_t* Op = ODg + (size_t)dir * M * D + boff + row0;
        const int pw = wave - 4, tq = lane >> 4, c4 = (lane & 15) * 4;
        u32x2 raw[4][5];
#pragma unroll
        for (int j = 0; j < 4; ++j) for (int q = 0; q < 5; ++q) raw[j][q] = (u32x2){0u, 0u};
        f32x4 kk4 = {0, 0, 0, 0}, ka4 = {0, 0, 0, 0};
        if (prod) { kk4 = *(const f32x4*)(A.in[17] + h * 64 + c4); ka4 = *(const f32x4*)(A.in[18] + h * 64 + c4); }
        asm volatile("s_waitcnt vmcnt(0)" : "+v"(kk4), "+v"(ka4) :: "memory");
#define SC_LOAD(c) do { _Pragma("unroll") for (int j = 0; j < 4; ++j) { const int step = (c) * TC + tq + 4 * j; const int tt = dir ? (T - 1 - step) : step; const size_t o = (size_t)tt * D + c4; \
        raw[j][0] = *(const u32x2*)(Rp + o); raw[j][1] = *(const u32x2*)(Kp + o); raw[j][2] = *(const u32x2*)(Vp + o); raw[j][3] = *(const u32x2*)(Ep + o); raw[j][4] = *(const u32x2*)(Ap + o); } } while (0)
#define SC_PROC(c) do { _Pragma("unroll") for (int j = 0; j < 4; ++j) { const int tl = tq + 4 * j; const u32x2 rr = raw[j][0], rk = raw[j][1], rv = raw[j][2], re = raw[j][3], ra = raw[j][4]; \
        const f32x4 r4 = {bf_lo(rr.x), bf_hi(rr.x), bf_lo(rr.y), bf_hi(rr.y)}, k4 = {bf_lo(rk.x), bf_hi(rk.x), bf_lo(rk.y), bf_hi(rk.y)}, v4 = {bf_lo(rv.x), bf_hi(rv.x), bf_lo(rv.y), bf_hi(rv.y)}; \
        const f32x4 e4 = {bf_lo(re.x), bf_hi(re.x), bf_lo(re.y), bf_hi(re.y)}, a4 = {bf_lo(ra.x), bf_hi(ra.x), bf_lo(ra.y), bf_hi(ra.y)}; \
        f32x4 kk = k4 * kk4; float ss = (kk[0] * kk[0] + kk[1] * kk[1]) + (kk[2] * kk[2] + kk[3] * kk[3]); ss = row16_allsum(ss); \
        const float inv = __builtin_amdgcn_rsqf(fmaxf(ss, 1e-24f)); kk = kk * inv; \
        f32x4 dec; dec[0] = __expf(-e4[0]); dec[1] = __expf(-e4[1]); dec[2] = __expf(-e4[2]); dec[3] = __expf(-e4[3]); \
        const f32x4 kd = k4 * (1.0f + (a4 - 1.0f) * ka4); \
        LAS float* dst = BUF + ((c) & 3) * TC * SREC + tl * SREC + c4; \
        *(LAS f32x4*)(dst) = dec; *(LAS f32x4*)(dst + 64) = -kk; *(LAS f32x4*)(dst + 128) = kk * a4; *(LAS f32x4*)(dst + 192) = kd; *(LAS f32x4*)(dst + 256) = r4; \
        if ((c4 >> 4) == quarter) *(LAS f32x4*)(BUF + ((c) & 3) * TC * SREC + tl * SREC + 320 + c4 - row0) = v4; } } while (0)
#define SC_RED(c, ok) do { const int row = lane & 15; const LAS float* src = OP + ((c) & 1) * TC * 256 + tq * 1024 + ((row >> 2) * 64 + (row & 3) * 16) * 4; \
        f32x4 o4 = {0.f, 0.f, 0.f, 0.f}; \
        _Pragma("unroll") for (int j = 0; j < 16; ++j) o4 += *(const LAS f32x4*)(src + (((j + row) & 15) << 2));     \
        _Pragma("unroll") for (int e = 0; e < 4; ++e) { const int step = (c) * TC + 4 * tq + e; const int tt = dir ? (T - 1 - step) : step; \
            if (ok) Op[(size_t)tt * D + row] = (bf16_t)(cvt_pk_bf16(o4[e], 0.f) & 0xffffu); } } while (0)
#define SC_SPIN_GE(p_, v_) do { unsigned n_ = 0; while (*(volatile LAS unsigned*)(p_) < (unsigned)(v_)) { __builtin_amdgcn_s_sleep(1); if (++n_ > (1u << 22)) break; } asm volatile("" ::: "memory"); } while (0)
        if (tid < 16) FL[tid] = 0u;
        __syncthreads();
        if (prod) {
            SC_LOAD(pw);
#pragma nounroll
            for (int m = 0; m < NCH / 4; ++m) {
                const int k = pw + 4 * m;
                SC_PROC(k);
                asm volatile("s_waitcnt lgkmcnt(0)" ::: "memory");
                if (lane == 0) *(volatile LAS unsigned*)(FL + pw) = (unsigned)(m + 1);
                { const int kl = (k + 4 < NCH) ? k + 4 : NCH - 1; SC_LOAD(kl); }
                SC_SPIN_GE(FL + 4 + pw, 4 * (m + 1));
                SC_RED(k, true);
                asm volatile("s_waitcnt lgkmcnt(0)" ::: "memory");
                if (lane == 0) (void)__hip_atomic_fetch_add(FL + 8 + (k & 1), 1u, __ATOMIC_RELAXED, __HIP_MEMORY_SCOPE_WORKGROUP);
            }
        } else {
            f32x2 S01 = {0.f, 0.f}, S23 = {0.f, 0.f};
            const int ks = lane & 15, rl = lane >> 4;
            unsigned fl_rdy = 0u, fl_red = 0u;
#pragma nounroll
            for (int c = 0; c < NCH; ++c) {
                if (fl_rdy < (unsigned)((c >> 2) + 1)) SC_SPIN_GE(FL + (c & 3), (c >> 2) + 1);
                if (c >= 2 && fl_red < (unsigned)(c >> 1)) SC_SPIN_GE(FL + 8 + (c & 1), c >> 1);
                const LAS float* bp = BUF + (c & 3) * TC * SREC + ks * 4; const LAS float* vp = BUF + (c & 3) * TC * SREC + 320 + wave * 4 + rl;
                LAS float* op = OP + (c & 1) * TC * 256 + tid * 4;
                f32x4 oq = {0.f, 0.f, 0.f, 0.f};
                constexpr int PD = 2;
                f32x4 pw_[PD], pa_[PD], pb_[PD], pk_[PD], pr_[PD]; float pv_[PD];
#pragma unroll
                for (int j = 0; j < PD; ++j) { const LAS float* q = bp + j * SREC; pw_[j] = *(const LAS f32x4*)(q); pa_[j] = *(const LAS f32x4*)(q + 64); pb_[j] = *(const LAS f32x4*)(q + 128); pk_[j] = *(const LAS f32x4*)(q + 192); pr_[j] = *(const LAS f32x4*)(q + 256); pv_[j] = vp[j * SREC]; }
#pragma unroll
                for (int i = 0; i < TC; ++i) {
                    const int sl = i % PD;
                    const f32x4 w = pw_[sl], a = pa_[sl], bb = pb_[sl], k = pk_[sl], r = pr_[sl]; const float v = pv_[sl];
                    if (i == 10) { fl_rdy = *(volatile LAS unsigned*)(FL + ((c + 1) & 3)); fl_red = *(volatile LAS unsigned*)(FL + 8 + ((c + 1) & 1)); }
                    if (i + PD < TC) { const LAS float* q = bp + (i + PD) * SREC; pw_[sl] = *(const LAS f32x4*)(q); pa_[sl] = *(const LAS f32x4*)(q + 64); pb_[sl] = *(const LAS f32x4*)(q + 128); pk_[sl] = *(const LAS f32x4*)(q + 192); pr_[sl] = *(const LAS f32x4*)(q + 256); pv_[sl] = vp[(i + PD) * SREC]; }
                    f32x2 p = S01 * (f32x2){a[0], a[1]}; p = S23 * (f32x2){a[2], a[3]} + p;
                    float sa = p.x + p.y; sa = row16_allsum(sa);
                    const f32x2 vk01 = (f32x2){k[0], k[1]} * v, vk23 = (f32x2){k[2], k[3]} * v;
                    const f32x2 t01 = (f32x2){bb[0], bb[1]} * sa + vk01, t23 = (f32x2){bb[2], bb[3]} * sa + vk23;
                    S01 = S01 * (f32x2){w[0], w[1]} + t01; S23 = S23 * (f32x2){w[2], w[3]} + t23;
                    f32x2 q2 = S01 * (f32x2){r[0], r[1]}; q2 = S23 * (f32x2){r[2], r[3]} + q2;
                    oq[i & 3] = q2.x + q2.y; if ((i & 3) == 3) *(LAS f32x4*)(op + (i >> 2) * 1024) = oq;
                }
                asm volatile("s_waitcnt lgkmcnt(0)" ::: "memory");
                if (lane == 0) (void)__hip_atomic_fetch_add(FL + 4 + (c & 3), 1u, __ATOMIC_RELAXED, __HIP_MEMORY_SCOPE_WORKGROUP);
            }
        }
        __syncthreads();
#undef SC_SPIN_GE
#undef SC_LOAD
#undef SC_PROC
#undef SC_RED
    }
}

__device__ __forceinline__ void z_phase(Frame& F, const Args& A) {
    const int gw = blockIdx.x * NWAVES + F.wave, NGW = F.G * NWAVES, col = F.lane * 16;
    const bf16_t* Rg = (const bf16_t*)(F.ws + WS_R); const bf16_t* Kg = (const bf16_t*)(F.ws + WS_K); const bf16_t* Vg = (const bf16_t*)(F.ws + WS_V);
    const bf16_t* A0 = (const bf16_t*)(F.ws + WS_AA); const bf16_t* A1 = A0 + (size_t)M * D; bf16_t* OF = (bf16_t*)(F.ws + WS_OD); const bf16_t* OB = OF + (size_t)M * D;
    float ka[16], rkc[16], lg[16], lb[16];
#pragma unroll
    for (int i = 0; i < 16; ++i) { ka[i] = A.in[18][col + i]; rkc[i] = A.in[19][col + i]; lg[i] = A.in[20][col + i]; lb[i] = A.in[21][col + i]; }
    for (int m = gw; m < M; m += NGW) {
        const size_t o = (size_t)m * D + col;
        float of[16], ob[16], r[16], k[16], v[16], a0[16], a1[16];
#define LD16(dst, P) { const u32x4 _a = *(const u32x4*)((P) + o), _b = *(const u32x4*)((P) + o + 8); float _t[8]; unpack8(_a, _t); for (int i = 0; i < 8; ++i) dst[i] = _t[i]; unpack8(_b, _t); for (int i = 0; i < 8; ++i) dst[8 + i] = _t[i]; }
        LD16(of, OF) LD16(ob, OB) LD16(r, Rg) LD16(k, Kg) LD16(v, Vg) LD16(a0, A0) LD16(a1, A1)
#undef LD16
        float s = 0.f, dot = 0.f;
#pragma unroll
        for (int i = 0; i < 16; ++i) { of[i] += ob[i]; s += of[i]; dot += r[i] * rkc[i] * k[i] * (2.0f + (a0[i] + a1[i] - 2.0f) * ka[i]); }
        s += __shfl_xor(s, 1); s += __shfl_xor(s, 2); dot += __shfl_xor(dot, 1); dot += __shfl_xor(dot, 2);
        const float mean = s * (1.f / 64.f); float q = 0.f;
#pragma unroll
        for (int i = 0; i < 16; ++i) { of[i] -= mean; q += of[i] * of[i]; }
        q += __shfl_xor(q, 1); q += __shfl_xor(q, 2);
        const float rstd = 1.0f / sqrtf(q * (1.f / 64.f) + GN_EPS);
        float z[16];
#pragma unroll
        for (int i = 0; i < 16; ++i) z[i] = of[i] * rstd * lg[i] + lb[i] + dot * v[i];
        u32x4 w0, w1; w0.x = cvt_pk_bf16(z[0], z[1]); w0.y = cvt_pk_bf16(z[2], z[3]); w0.z = cvt_pk_bf16(z[4], z[5]); w0.w = cvt_pk_bf16(z[6], z[7]);
        w1.x = cvt_pk_bf16(z[8], z[9]); w1.y = cvt_pk_bf16(z[10], z[11]); w1.z = cvt_pk_bf16(z[12], z[13]); w1.w = cvt_pk_bf16(z[14], z[15]);
        *(u32x4*)(OF + o) = w0; *(u32x4*)(OF + o + 8) = w1;
    }
}

__device__ __forceinline__ void rs_table(Frame& F, const pg8::StaticOrder& S) {
    LAS float* RS = (LAS float*)(F.lds + RS_OFF); const float* SS = (const float*)(F.ws + WS_SS);
    pg8::Unit u;
    for (int i = 0; i < 8 && S.next(i, u); ++i) {
        if (F.tid < 256) { const f32x4* p = (const f32x4*)(SS + (size_t)(u.pm * 256 + F.tid) * 16); const f32x4 a = p[0], b = p[1], c = p[2], d = p[3]; const f32x4 t = (a + b) + (c + d);
            RS[i * 256 + F.tid] = 1.0f / sqrtf(((t[0] + t[1]) + (t[2] + t[3])) * (1.f / D) + NORM_EPS); }
    }
    __syncthreads();
}

__device__ __forceinline__ void spatial_phase(Frame& F, const Args& A) {
    constexpr int LDW = 136;
    LAS bf16_t* WL = (LAS bf16_t*)(F.lds); LAS bf16_t* VL = (LAS bf16_t*)(F.lds + 128 * LDW * 2); LAS f32x2* ST = (LAS f32x2*)(F.lds + 2 * 128 * LDW * 2);
    bf16_t* H = (bf16_t*)(F.ws + WS_H); const bf16_t* WSB = (const bf16_t*)(F.ws + WS_WSB); const f32x2* LNP = (const f32x2*)(F.ws + WS_LNP);
    const float* lng = A.in[23]; const float* lnb = A.in[24]; const float* bs = A.in[26];
    const int tid = F.tid, lane = F.lane, wave = F.wave, fr = lane & 15, fq = lane >> 4;
    const int i0 = (wave >> 1) * 32, d0 = (wave & 1) * 64, cc = tid & 15;
    int gcur = -1; float gam[8], bet[8], bsv[2];
#pragma unroll
    for (int e = 0; e < 8; ++e) { gam[e] = 0.f; bet[e] = 0.f; }
    bsv[0] = bsv[1] = 0.f;
    u32x4 vraw[4]; f32x4 lnp[4];
#define SP_PREF(un_) do { const int c_ = (un_) >> 4, g_ = (un_) & 15; \
        _Pragma("unroll") for (int i = 0; i < 4; ++i) { const int j = (tid + 512 * i) >> 4; vraw[i] = *(const u32x4*)(H + (size_t)(c_ * 128 + j) * FF + 2048 + g_ * 128 + cc * 8); } \
        const f32x4* p_ = (const f32x4*)(LNP + (size_t)(c_ * 128 + (tid >> 2)) * 32) + (tid & 3) * 4; \
        _Pragma("unroll") for (int i = 0; i < 4; ++i) lnp[i] = p_[i]; } while (0)
    int un = blockIdx.x;
    if (un < 2048) SP_PREF(un);
    for (; un < 2048; un += F.G) {
        const int c = un >> 4, g = un & 15;
        if (g != gcur) {
            __syncthreads();
#pragma unroll
            for (int i = 0; i < 4; ++i) { const int q = tid + 512 * i, row = q >> 4, c8 = q & 15; *(LAS u32x4*)(WL + row * LDW + c8 * 8) = *(const u32x4*)(WSB + (size_t)g * 16384 + row * 128 + c8 * 8); }
#pragma unroll
            for (int e = 0; e < 8; ++e) { gam[e] = lng[g * 128 + cc * 8 + e]; bet[e] = lnb[g * 128 + cc * 8 + e]; }
            bsv[0] = bs[g * 128 + i0 + fr]; bsv[1] = bs[g * 128 + i0 + 16 + fr];
            gcur = g;
        }
        { float s_ = 0.f, q_ = 0.f;
#pragma unroll
          for (int i = 0; i < 4; ++i) { s_ += lnp[i][0] + lnp[i][2]; q_ += lnp[i][1] + lnp[i][3]; }
          s_ += __shfl_xor(s_, 1); s_ += __shfl_xor(s_, 2); q_ += __shfl_xor(q_, 1); q_ += __shfl_xor(q_, 2);
          const float mean = s_ * (1.f / 2048.f), var = q_ * (1.f / 2048.f) - mean * mean;
          if ((tid & 3) == 0) ST[tid >> 2] = (f32x2){mean, 1.0f / sqrtf(fmaxf(var, 0.f) + NORM_EPS)}; }
        __syncthreads();
#pragma unroll
        for (int i = 0; i < 4; ++i) { const int j = (tid + 512 * i) >> 4; float v[8]; unpack8(vraw[i], v);
            const f32x2 st = ST[j];
            for (int e = 0; e < 8; ++e) v[e] = (v[e] - st.x) * st.y * gam[e] + bet[e];
            u32x4 w; w.x = cvt_pk_bf16(v[0], v[1]); w.y = cvt_pk_bf16(v[2], v[3]); w.z = cvt_pk_bf16(v[4], v[5]); w.w = cvt_pk_bf16(v[6], v[7]);
            *(LAS u32x4*)(VL + j * LDW + cc * 8) = w; }
        __syncthreads();
        u32x2 uw[2][4];
#pragma unroll
        for (int mb = 0; mb < 2; ++mb) { const bf16_t* up = H + (size_t)(c * 128 + i0 + mb * 16 + fr) * FF + g * 128 + d0 + 4 * fq;
#pragma unroll
            for (int nb = 0; nb < 4; ++nb) uw[mb][nb] = *(const u32x2*)(up + nb * 16); }
        if (un + F.G < 2048) SP_PREF(un + F.G);
        f32x4 acc[2][4];
#pragma unroll
        for (int mb = 0; mb < 2; ++mb)
#pragma unroll
            for (int nb = 0; nb < 4; ++nb) acc[mb][nb] = (f32x4){0.f, 0.f, 0.f, 0.f};
#pragma unroll
        for (int kk = 0; kk < 4; ++kk) {
            bf16x8 wf[2], vf[4];
#pragma unroll
            for (int mb = 0; mb < 2; ++mb) wf[mb] = *(const LAS bf16x8*)(WL + (i0 + mb * 16 + fr) * LDW + kk * 32 + fq * 8);
#pragma unroll
            for (int nb = 0; nb < 4; ++nb) { const LAS bf16_t* p = VL + (kk * 32 + fq * 8) * LDW + d0 + nb * 16 + fr;
#pragma unroll
                for (int e = 0; e < 8; ++e) vf[nb][e] = (short)p[e * LDW]; }
#pragma unroll
            for (int mb = 0; mb < 2; ++mb)
#pragma unroll
                for (int nb = 0; nb < 4; ++nb) acc[mb][nb] = __builtin_amdgcn_mfma_f32_16x16x32_bf16(vf[nb], wf[mb], acc[mb][nb], 0, 0, 0);
        }
#pragma unroll
        for (int mb = 0; mb < 2; ++mb) { bf16_t* up = H + (size_t)(c * 128 + i0 + mb * 16 + fr) * FF + g * 128 + d0 + 4 * fq;
#pragma unroll
            for (int nb = 0; nb < 4; ++nb) { const f32x4 a = acc[mb][nb]; const u32x2 w = uw[mb][nb];
                const float o0 = (a[0] + bsv[mb]) * bf_lo(w.x), o1 = (a[1] + bsv[mb]) * bf_hi(w.x), o2 = (a[2] + bsv[mb]) * bf_lo(w.y), o3 = (a[3] + bsv[mb]) * bf_hi(w.y);
                *(u32x2*)(up + nb * 16) = (u32x2){cvt_pk_bf16(o0, o1), cvt_pk_bf16(o2, o3)}; } }
    }
#undef SP_PREF
    __syncthreads();
}

__device__ __forceinline__ void final_phase(Frame& F, const Args& A) {
    const int gw = blockIdx.x * NWAVES + F.wave, NGW = F.G * NWAVES, col = F.lane * 16;
    const bf16_t* XBp = (const bf16_t*)(F.ws + WS_XB);
    float gv[16];
#pragma unroll
    for (int i = 0; i < 16; ++i) gv[i] = A.in[3][col + i];
    for (int m = gw; m < M; m += NGW) {
        const u32x4 a = *(const u32x4*)(XBp + (size_t)m * D + col), b = *(const u32x4*)(XBp + (size_t)m * D + col + 8);
        float v[16]; { float t[8]; unpack8(a, t); for (int i = 0; i < 8; ++i) v[i] = t[i]; unpack8(b, t); for (int i = 0; i < 8; ++i) v[8 + i] = t[i]; }
        float s = 0.f;
#pragma unroll
        for (int i = 0; i < 16; ++i) s += v[i] * v[i];
        const float rs = 1.0f / sqrtf(wave_sum(s) * (1.f / D) + NORM_EPS);
        float* op = F.out + (size_t)m * D + col;
#pragma unroll
        for (int i = 0; i < 16; i += 4) *(f32x4*)(op + i) = (f32x4){v[i] * rs * gv[i], v[i + 1] * rs * gv[i + 1], v[i + 2] * rs * gv[i + 2], v[i + 3] * rs * gv[i + 3]};
    }
}

#define XB_TMO      128
#define XB_XCNT(j)  (256  + 64 * (j))
#define XB_XSUB(j)  (1280 + 64 * (j))
#define XB_XGEN(j)  (2304 + 64 * (j))
#define XB_TOP      3328
#define XB_TOPGEN   3392
#define XCD_BAR_WORDS 3456
#define XB_SPIN_CAP (1u << 18)
__device__ __forceinline__ unsigned xb_ld(unsigned* p)              { return __hip_atomic_load(p, __ATOMIC_RELAXED, __HIP_MEMORY_SCOPE_AGENT); }
__device__ __forceinline__ unsigned xb_add(unsigned* p, unsigned v) { return __hip_atomic_fetch_add(p, v, __ATOMIC_RELAXED, __HIP_MEMORY_SCOPE_AGENT); }
__device__ __forceinline__ unsigned xb_xcc_id() { return (unsigned)__builtin_amdgcn_s_getreg((3 << 11) | 20) & 0xFu; }
#define XB_SPIN(cond, bar) do { unsigned _sp = 0; while (cond) { __builtin_amdgcn_s_sleep(1); \
    if ((++_sp & 255u) == 0u) { if (xb_ld(&(bar)[XB_TMO])) break; if (_sp > XB_SPIN_CAP) { atomicAdd(&(bar)[XB_TMO], 1u); break; } } } } while (0)
struct XcdBarrier { unsigned* bar; unsigned x; volatile LAS unsigned* st; };
__device__ __forceinline__ XcdBarrier xcd_barrier_post(unsigned* bar, volatile LAS unsigned* st) {
    XcdBarrier b; b.bar = bar; b.x = xb_xcc_id(); b.st = st;
    if (threadIdx.x == 0) (void)xb_add(&bar[XB_XCNT(b.x)], 1u);
    return b;
}
__device__ __forceinline__ void xcd_barrier_complete(unsigned* bar, unsigned x, unsigned& nloc, unsigned& nx) {
    const unsigned G = gridDim.x * gridDim.y * gridDim.z;
    unsigned sum, cnt, mine, sp = 0u;
    for (;;) {
        sum = 0u; cnt = 0u; mine = 0u;
#pragma unroll
        for (unsigned j = 0; j < 16; ++j) { const unsigned c = xb_ld(&bar[XB_XCNT(j)]); sum += c; cnt += (c > 0u) ? 1u : 0u; mine = (j == x) ? c : mine; }
        if (sum == G) break;
        __builtin_amdgcn_s_sleep(1);
        if ((++sp & 255u) == 0u) { if (xb_ld(&bar[XB_TMO])) break; if (sp > XB_SPIN_CAP) { atomicAdd(&bar[XB_TMO], 1u); break; } }
    }
    nloc = mine > 0u ? mine : 1u; nx = cnt > 0u ? cnt : 1u;
}
__device__ __forceinline__ void xcd_barrier(const XcdBarrier& b) {
    asm volatile("s_waitcnt vmcnt(0)" ::: "memory");
    __syncthreads();
    if (threadIdx.x == 0) {
        unsigned* bar = b.bar;
        __builtin_amdgcn_s_waitcnt(0);
        unsigned nloc = b.st[0], nx = b.st[1];
        if (nloc == 0u) { xcd_barrier_complete(bar, b.x, nloc, nx); b.st[0] = nloc; b.st[1] = nx; }
        const unsigned old = xb_add(&bar[XB_XSUB(b.x)], 1u);
        const unsigned gen = old / nloc;
        if (old + 1u == (gen + 1u) * nloc) {
            __builtin_amdgcn_fence(__ATOMIC_RELEASE, "agent");
            asm volatile("s_waitcnt vmcnt(0)" ::: "memory");
            const unsigned og = xb_add(&bar[XB_TOP], 1u);
            const unsigned tg = og / nx;
            if (og + 1u == (tg + 1u) * nx) xb_add(&bar[XB_TOPGEN], 1u);
            else XB_SPIN(xb_ld(&bar[XB_TOPGEN]) == tg, bar);
            __builtin_amdgcn_fence(__ATOMIC_ACQUIRE, "agent");
            xb_add(&bar[XB_XGEN(b.x)], 1u);
            asm volatile("s_waitcnt vmcnt(0)" ::: "memory");
        } else {
            XB_SPIN(xb_ld(&bar[XB_XGEN(b.x)]) == gen, bar);
            __builtin_amdgcn_fence(__ATOMIC_ACQUIRE, "agent");
            asm volatile("s_waitcnt vmcnt(0)" ::: "memory");
        }
    }
    __syncthreads();
}

struct EpiFinal {
    const bf16_t* base; float* out; const float* g; float* ss; XcdBarrier xb;
    __device__ __forceinline__ void operator()(f32x4 (&acc)[2][2][4][2], const pg8::Unit& u, int ui, int wr, int wc, int fr, int fq) const {
        using namespace pg8;
        const int col0 = u.pn * BM + wc * 32 + 8 * fq;
#pragma unroll
        for (int ai = 0; ai < 2; ++ai)
#pragma unroll
            for (int m = 0; m < 4; ++m) { const int row = u.pm * BM + ai * HALF + wr * 64 + m * 16 + fr; const size_t off = (size_t)row * D + col0; float sq = 0.f;
#pragma unroll
                for (int bj = 0; bj < 2; ++bj) { const u32x4 w = *(const u32x4*)(base + off + bj * HALF); float t[8]; unpack8(w, t); const f32x4 b0 = {t[0], t[1], t[2], t[3]}, b1 = {t[4], t[5], t[6], t[7]};
                    const f32x4 v0 = acc[ai][bj][m][0] + b0, v1 = acc[ai][bj][m][1] + b1; acc[ai][bj][m][0] = v0; acc[ai][bj][m][1] = v1;
                    sq += (v0[0] * v0[0] + v0[1] * v0[1]) + (v0[2] * v0[2] + v0[3] * v0[3]) + (v1[0] * v1[0] + v1[1] * v1[1]) + (v1[2] * v1[2] + v1[3] * v1[3]); }
                sq += __shfl_xor(sq, 16); sq += __shfl_xor(sq, 32);
                if (fq == 0) ss[(size_t)row * 16 + u.pn * 4 + wc] = sq; if (m & 1) asm volatile("" ::: "memory"); }
        xcd_barrier(xb);
        f32x4 gv[2][2];
#pragma unroll
        for (int bj = 0; bj < 2; ++bj) { gv[bj][0] = *(const f32x4*)(g + col0 + bj * HALF); gv[bj][1] = *(const f32x4*)(g + col0 + bj * HALF + 4); }
#pragma unroll
        for (int ai = 0; ai < 2; ++ai)
#pragma unroll
            for (int m = 0; m < 4; ++m) { const int row = u.pm * BM + ai * HALF + wr * 64 + m * 16 + fr; const size_t off = (size_t)row * D + col0;
                const f32x4* p = (const f32x4*)(ss + (size_t)row * 16); const f32x4 t = (p[0] + p[1]) + (p[2] + p[3]);
                const float rs = 1.0f / sqrtf(((t[0] + t[1]) + (t[2] + t[3])) * (1.f / D) + NORM_EPS);
#pragma unroll
                for (int bj = 0; bj < 2; ++bj) { float* op = out + off + bj * HALF; *(f32x4*)op = acc[ai][bj][m][0] * rs * gv[bj][0]; *(f32x4*)(op + 4) = acc[ai][bj][m][1] * rs * gv[bj][1]; }
                if (m & 1) asm volatile("" ::: "memory"); }
    }
};

constexpr int NPHASE = 15;
__global__ void __launch_bounds__(NTHR, 2) fwd_kernel(Args args) {
    extern __shared__ __attribute__((aligned(16))) unsigned char lds_raw[];
    Frame F;
    F.lds = (LAS unsigned char*)lds_raw; F.tid = threadIdx.x; F.lane = F.tid & 63; F.wave = __builtin_amdgcn_readfirstlane(F.tid >> 6); F.G = gridDim.x;
    F.out = args.out; F.ws = args.ws;
    const int lo = args.ph_lo, hi = args.ph_hi;
    cg::grid_group grid = cg::this_grid();
    volatile LAS unsigned* MISC = (volatile LAS unsigned*)(F.lds + RING_BYTES + 512);
    if (F.tid < 2) MISC[F.tid] = 0u;
    __syncthreads();
    XcdBarrier xbar = xcd_barrier_post((unsigned*)(args.ws + WS_BAR), MISC);
#ifndef PHMASK
#define PHMASK 0x7fff
#endif
#define IN(k) (((PHMASK >> (k)) & 1) && lo <= (k) && (k) < hi)
#define SEAM(k) do { if (IN(k) && IN((k) + 1)) { if (hi > 1000) grid.sync(); else xcd_barrier(xbar); } } while (0)
    unsigned char* ws = args.ws;
    bf16_t* XB = (bf16_t*)(ws + WS_XB); bf16_t* HB = (bf16_t*)(ws + WS_H); float* SS = (float*)(ws + WS_SS);
    const LAS float* RS = (const LAS float*)(F.lds + RS_OFF);
    const int bx = blockIdx.x;

    if (IN(0)) { p0_phase(F, args); }
    SEAM(0);
    if (IN(1)) {
        __syncthreads();
        const bool bal = (F.G == 256);
        { pg8::Gemm g{(const bf16_t*)F.out, (const bf16_t*)(ws + WS_L1), M, 512, 2048, 2048, 1 << 20, 0}; pg8::StaticOrder S;
          if (bal) S.init_sub(M, 512, 128, bx >= 128 ? bx - 128 : -1, 0, 1); else S.init(M, 512, F.G, bx);
          pg8::EpiLora1 E{(bf16_t*)(ws + WS_A2), (bf16_t*)(ws + WS_SG)}; pg8::gemm_phase(F.lds, g, S, E); }
        { pg8::Gemm g{(const bf16_t*)(ws + WS_XR), (const bf16_t*)(ws + WS_WRKV), M, 3072, 1024, 1024, 4, (size_t)M * D * 2}; pg8::StaticOrder S;
          if (bal) { if (bx < 128) S.init_sub(M, 3072, 128, bx, 0, 4); else S.init_sub(M, 3072, 128, bx - 128, 512, 2); } else S.init(M, 3072, F.G, bx);
          pg8::EpiSplit E{(bf16_t*)(ws + WS_R), D, D, (size_t)M * D}; pg8::gemm_phase(F.lds, g, S, E); }
    }
    SEAM(1);
    if (IN(2)) {
        pg8::Gemm g{(const bf16_t*)(ws + WS_A2), (const bf16_t*)(ws + WS_L2), M, 4096, 128, 256, 8, 256}; pg8::StaticOrder S; S.init(M, 4096, F.G, bx);
        pg8::EpiLora2 E{(bf16_t*)F.out, (bf16_t*)(ws + WS_AA), args.in[9], args.in[12]}; pg8::gemm_phase(F.lds, g, S, E);
    }
    SEAM(2);
    if (IN(3)) { scan_phase<0>(F, args); }
    SEAM(3);
    if (IN(4)) { z_phase(F, args); }
    SEAM(4);
    if (IN(5)) {
        convB_phase(F, args); __syncthreads();
        pg8::Gemm g{(const bf16_t*)(ws + WS_SG), (const bf16_t*)(ws + WS_G2), M, 1024, 128, 256, 1 << 20, 0}; pg8::StaticOrder S; S.init(M, 1024, F.G, bx);
        pg8::EpiG E{(bf16_t*)(ws + WS_OD)}; pg8::gemm_phase(F.lds, g, S, E);
    }
    SEAM(5);
    if (IN(6)) {
        pg8::Gemm g{(const bf16_t*)(ws + WS_OD), (const bf16_t*)(ws + WS_WO), M, 1024, 1024, 1024, 1 << 20, 0}; pg8::StaticOrder S; S.init(M, 1024, F.G, bx);
        pg8::EpiRes<true> E{args.in[0], XB, SS}; pg8::gemm_phase(F.lds, g, S, E);
    }
    SEAM(6);
    if (IN(7)) {
        pg8::Gemm g{XB, (const bf16_t*)(ws + WS_W1_0), M, FF, 1024, 1024, 1 << 20, 0}; pg8::StaticOrder S; S.init(M, FF, F.G, bx);
        rs_table(F, S);
        pg8::EpiSq E{HB, RS}; pg8::gemm_phase(F.lds, g, S, E);
    }
    SEAM(7);
    if (IN(8)) {
        pg8::Gemm g{HB, (const bf16_t*)(ws + WS_W2_0), M, 1024, FF, FF, 1 << 20, 0}; pg8::StaticOrder S; S.init(M, 1024, F.G, bx);
        pg8::EpiRes<false> E{nullptr, XB, SS}; pg8::gemm_phase(F.lds, g, S, E);
    }
    SEAM(8);
    if (IN(9)) {
        pg8::Gemm g{XB, (const bf16_t*)(ws + WS_WIN), M, FF, 1024, 1024, 1 << 20, 0}; pg8::StaticOrder S; S.init(M, FF, F.G, bx);
        rs_table(F, S);
        pg8::EpiGelu E{HB, RS, (f32x2*)(ws + WS_LNP)}; pg8::gemm_phase(F.lds, g, S, E);
    }
    SEAM(9);
    if (IN(10)) { __syncthreads(); spatial_phase(F, args); }
    SEAM(10);
    if (IN(11)) {
        __syncthreads();
        pg8::Gemm g{HB, (const bf16_t*)(ws + WS_WOUT), M, 1024, 2048, FF, 1 << 20, 0}; pg8::StaticOrder S; S.init(M, 1024, F.G, bx);
        pg8::EpiRes<false> E{nullptr, XB, SS}; pg8::gemm_phase(F.lds, g, S, E);
    }
    SEAM(11);
    if (IN(12)) {
        pg8::Gemm g{XB, (const bf16_t*)(ws + WS_W1_1), M, FF, 1024, 1024, 1 << 20, 0}; pg8::StaticOrder S; S.init(M, FF, F.G, bx);
        rs_table(F, S);
        pg8::EpiSq E{HB, RS}; pg8::gemm_phase(F.lds, g, S, E);
    }
    SEAM(12);
    const bool fuse_final = IN(13) && IN(14) && F.G == 256;
    if (IN(13)) {
        pg8::Gemm g{HB, (const bf16_t*)(ws + WS_W2_1), M, 1024, FF, FF, 1 << 20, 0}; pg8::StaticOrder S; S.init(M, 1024, F.G, bx);
        if (fuse_final) { EpiFinal E{XB, F.out, args.in[3], SS, xbar}; pg8::gemm_phase(F.lds, g, S, E); }
        else { pg8::EpiRes<false> E{nullptr, XB, SS}; pg8::gemm_phase(F.lds, g, S, E); }
    }
    if (!fuse_final) { SEAM(13); }
    if (IN(14) && !fuse_final) { final_phase(F, args); }
}

extern "C" void kernel_launch(void* const* d_in, const int* in_sizes, int n_in, void* d_out, int out_size, void* d_ws, size_t ws_size, hipStream_t stream) {
    static int grid = 0;
    if (grid == 0) {
        if (n_in != 30 || out_size != M * D || ws_size < WS_END) { fprintf(stderr, "kernel_launch: unexpected shapes (n_in %d out %d ws %zu)\n", n_in, out_size, ws_size); grid = -1; return; }
        int dev = 0, cus = 0, per_cu = 0;
        (void)hipGetDevice(&dev); (void)hipDeviceGetAttribute(&cus, hipDeviceAttributeMultiprocessorCount, dev);
        (void)hipFuncSetAttribute((const void*)fwd_kernel, hipFuncAttributeMaxDynamicSharedMemorySize, LDS_BYTES);
        (void)hipOccupancyMaxActiveBlocksPerMultiprocessor(&per_cu, (const void*)fwd_kernel, NTHR, LDS_BYTES);
        if (per_cu < 1) { fprintf(stderr, "kernel_launch: occupancy query says %d blocks per CU\n", per_cu); per_cu = 1; }
        (void)hipGetLastError();
        grid = cus;
        if (grid > 256) grid = 256;
    }
    if (grid < 0) return;
    if (hipMemsetAsync((char*)d_ws + WS_BAR, 0, 16384, stream) != hipSuccess) { fprintf(stderr, "memset failed\n"); return; }
    Args a{};
    for (int i = 0; i < 30; ++i) a.in[i] = (const float*)d_in[i];
    a.out = (float*)d_out; a.ws = (unsigned char*)d_ws;
#if MK_SINGLE
    a.ph_lo = 0; a.ph_hi = NPHASE;
    void* kargs[] = {&a};
    hipError_t e = hipLaunchCooperativeKernel((const void*)fwd_kernel, dim3(grid), dim3(NTHR), kargs, LDS_BYTES, stream);
    if (e != hipSuccess) fprintf(stderr, "cooperative launch failed: %s (grid %d)\n", hipGetErrorString(e), grid);
#else
    for (int p = 0; p < NPHASE; ++p) { a.ph_lo = p; a.ph_hi = p + 1; hipLaunchKernelGGL(fwd_kernel, dim3(grid), dim3(NTHR), LDS_BYTES, stream, a); }
#endif
}
```

```cpp
#include <hip/hip_runtime.h>
#include <hip/hip_cooperative_groups.h>
#include <cstdio>
#include <cstdint>
namespace cg = cooperative_groups;

#ifndef MK_SINGLE
#define MK_SINGLE 1
#endif

#define LAS __attribute__((address_space(3)))
typedef unsigned short bf16_t;
typedef short bf16x8 __attribute__((ext_vector_type(8)));
typedef float f32x4 __attribute__((ext_vector_type(4)));
typedef float f32x2 __attribute__((ext_vector_type(2)));
typedef unsigned u32x4 __attribute__((ext_vector_type(4)));
typedef unsigned u32x2 __attribute__((ext_vector_type(2)));

constexpr int BATCH = 2, T = 8192, D = 1024, FF = 4096, M = BATCH * T;
constexpr int NWAVES = 8, NTHR = 512;
constexpr float NORM_EPS = 1e-5f, GN_EPS = 64e-5f;

constexpr size_t MiB = 1u << 20;
constexpr size_t WS_SS = 0;
constexpr size_t WS_BAR = 1 * MiB + 65536;
constexpr size_t WS_WRKV = 2 * MiB;
constexpr size_t WS_WO = 8 * MiB;
constexpr size_t WS_L1 = 10 * MiB;
constexpr size_t WS_L2 = 12 * MiB;
constexpr size_t WS_G2 = 14 * MiB;
constexpr size_t WS_R = 15 * MiB, WS_K = 47 * MiB, WS_V = 79 * MiB;
constexpr size_t WS_XR = 111 * MiB;
constexpr size_t WS_AA = 111 * MiB;
constexpr size_t WS_OD = 175 * MiB;
constexpr size_t WS_A2 = 239 * MiB;
constexpr size_t WS_SG = 247 * MiB;
constexpr size_t WS_DOT = 255 * MiB;
constexpr size_t WS_W1_0 = 15 * MiB, WS_W2_0 = 23 * MiB, WS_WIN = 31 * MiB, WS_WOUT = 39 * MiB, WS_WSB = 43 * MiB, WS_W1_1 = 44 * MiB, WS_W2_1 = 52 * MiB;
constexpr size_t WS_XB = 60 * MiB;
constexpr size_t WS_H = 92 * MiB;
constexpr size_t WS_LNP = 220 * MiB;
constexpr size_t WS_END = 256 * MiB;

constexpr int RING_BYTES = 131072, RS_OFF = RING_BYTES + 1024, LDS_BYTES = 147456;

__device__ __forceinline__ unsigned cvt_pk_bf16(float lo, float hi) { unsigned r; asm volatile("v_cvt_pk_bf16_f32 %0, %1, %2" : "=v"(r) : "v"(lo), "v"(hi)); return r; }
__device__ __forceinline__ float bf_lo(unsigned w) { return __builtin_bit_cast(float, w << 16); }
__device__ __forceinline__ float bf_hi(unsigned w) { return __builtin_bit_cast(float, w & 0xffff0000u); }
__device__ __forceinline__ float wave_sum(float v) {
#pragma unroll
    for (int o = 1; o < 64; o <<= 1) v += __shfl_xor(v, o);
    return v;
}
template <int CTRL> __device__ __forceinline__ float dpp_f(float x) { return __builtin_bit_cast(float, __builtin_amdgcn_update_dpp(0, __builtin_bit_cast(int, x), CTRL, 0xF, 0xF, true)); }
__device__ __forceinline__ float row16_allsum(float x) { x += dpp_f<0x128>(x); x += dpp_f<0x124>(x); x += dpp_f<0x122>(x); x += dpp_f<0x121>(x); return x; }
__device__ __forceinline__ float sigmoidf_(float x) { return __builtin_amdgcn_rcpf(1.0f + __expf(-x)); }
__device__ __forceinline__ float tanhf_(float x) { return 1.0f - 2.0f * __builtin_amdgcn_rcpf(__expf(2.0f * x) + 1.0f); }
__device__ __forceinline__ f32x2 gelu_pk(f32x2 v) {
    const f32x2 av = __builtin_elementwise_abs(v), d = av * 0.2316418882f + 1.0f;
    f32x2 t; t.x = __builtin_amdgcn_rcpf(d.x); t.y = __builtin_amdgcn_rcpf(d.y);
    f32x2 q = t * 0.5307027145f + (-0.7265760135f); q = q * t + 0.7107068705f; q = q * t + (-0.142248368f); q = q * t + 0.127414796f; q = q * t;
    const f32x2 s = (v * v) * (-0.72134752044f);
    f32x2 e; e.x = __builtin_amdgcn_exp2f(s.x); e.y = __builtin_amdgcn_exp2f(s.y);
    const f32x2 m = v * (q * e), r = v - m;
    f32x2 o; o.x = v.x < 0.f ? m.x : r.x; o.y = v.y < 0.f ? m.y : r.y; return o;
}
__device__ __forceinline__ u32x4 pack8(const f32x4 a, const f32x4 b) { u32x4 w; w.x = cvt_pk_bf16(a[0], a[1]); w.y = cvt_pk_bf16(a[2], a[3]); w.z = cvt_pk_bf16(b[0], b[1]); w.w = cvt_pk_bf16(b[2], b[3]); return w; }
__device__ __forceinline__ void unpack8(const u32x4 w, float (&f)[8]) { f[0] = bf_lo(w.x); f[1] = bf_hi(w.x); f[2] = bf_lo(w.y); f[3] = bf_hi(w.y); f[4] = bf_lo(w.z); f[5] = bf_hi(w.z); f[6] = bf_lo(w.w); f[7] = bf_hi(w.w); }

namespace pg8 {
constexpr int BM = 256, BK = 64, HALF = 128, HTB = HALF * BK * 2, NXCD = 8, WGM = 4;
__host__ __device__ __forceinline__ int lds_byte(int r, int c) { const int st = (r >> 4) * 2 + (c >> 5), rr = r & 15, cc = c & 31, ob = rr * 64 + cc * 2; return st * 1024 + (ob ^ (((ob >> 9) & 1) << 5)); }
__host__ __device__ __forceinline__ void stage_rc(int b, int& R, int& C) { const int st = b / 1024, sb = b % 1024, swz = sb ^ (((sb >> 9) & 1) << 5); R = (st >> 1) * 16 + swz / 64; C = (st & 1) * 32 + (swz % 64) / 2; }
__host__ __device__ __forceinline__ int perm32(int rho) { const int n = rho >> 4, i = rho & 15; return 8 * (i >> 2) + 4 * n + (i & 3); }

struct Unit { int pm, pn; };
struct Gemm { const bf16_t* A; const bf16_t* Bt; int M, N, K, lda; int agrp; size_t astride; };

struct StaticOrder {
    int nM, nN, nwg, G, c, L0, cnt;
    __host__ __device__ void init(int M_, int N_, int G_, int c_) { nM = M_ / BM; nN = N_ / BM; nwg = nM * nN; G = G_; c = c_; L0 = 0; cnt = 1 << 20; }
    __host__ __device__ void init_sub(int M_, int N_, int G_, int c_, int L0_, int cnt_) { init(M_, N_, G_, c_); L0 = L0_; cnt = cnt_; }
    __host__ __device__ bool next(int i, Unit& u) const {
        if (i >= cnt || c < 0) return false;
        const long L = (long)L0 + (long)i * G + c; if (L >= nwg) return false;
        int wgid = (int)L; { const int q = nwg / NXCD, r = nwg % NXCD, xcd = wgid % NXCD, off = wgid / NXCD; wgid = (xcd < r ? xcd * (q + 1) : r * (q + 1) + (xcd - r) * q) + off; }
        const int nig = WGM * nN, gid = wgid / nig, fm = gid * WGM, gsz = (nM - fm) < WGM ? (nM - fm) : WGM;
        u.pm = fm + ((wgid % nig) % gsz); u.pn = (wgid % nig) / gsz; return true;
    }
};

template <class Epi>
__device__ __forceinline__ void gemm_phase(LAS unsigned char* lds, const Gemm g, const StaticOrder& S, const Epi& E) {
    const int tid = threadIdx.x, wid = __builtin_amdgcn_readfirstlane(tid >> 6), lane = tid & 63, wr = wid >> 2, wc = wid & 3, fr = lane & 15, fq = lane >> 4;
    const int K = g.K, nt = K / BK;
    unsigned voffA[2], voffB[2];
#pragma unroll
    for (int i = 0; i < 2; ++i) { int R, C; stage_rc(tid * 16 + i * 8192, R, C); const int Rb = (R & ~31) + perm32(R & 31);
        voffA[i] = (unsigned)(R * g.lda + C) * 2u; voffB[i] = (unsigned)(Rb * K + C) * 2u; }
    const size_t kstep = (size_t)(BK * 2);
    const size_t hA = (size_t)HALF * g.lda * 2, tA = 2 * hA, hB = (size_t)HALF * K * 2, tB = 2 * hB;
    const unsigned ldsw = (unsigned)wid * 1024u;
    const int aoff = lds_byte(wr * 64 + fr, fq * 8), boff = lds_byte(wc * 32 + fr, fq * 8);
#define PG8_SA(b, h) (((b) * 2 + (h)) * HTB)
#define PG8_SB(b, h) ((4 + (b) * 2 + (h)) * HTB)
#define PG8_STAGE(bufoff, gbase, voff) do { _Pragma("unroll") for (int _i = 0; _i < 2; ++_i) \
        __builtin_amdgcn_global_load_lds((const unsigned*)((const char*)(gbase) + (voff)[_i]), (LAS unsigned*)(lds + (bufoff) + ldsw + _i * 8192), 16, 0, 0); } while (0)
#define PG8_LDA(dst, b, h) do { _Pragma("unroll") for (int m = 0; m < 4; ++m) _Pragma("unroll") for (int k = 0; k < 2; ++k) dst[m][k] = *(const LAS bf16x8*)(lds + PG8_SA(b, h) + aoff + m * 2048 + k * 1024); } while (0)
#define PG8_LDB(dst, b, h) do { _Pragma("unroll") for (int n = 0; n < 2; ++n) _Pragma("unroll") for (int k = 0; k < 2; ++k) dst[n][k] = *(const LAS bf16x8*)(lds + PG8_SB(b, h) + boff + n * 2048 + k * 1024); } while (0)
#define PG8_MMA(ai, bj, At, Bt) do { __builtin_amdgcn_s_setprio(1); _Pragma("unroll") for (int m = 0; m < 4; ++m) _Pragma("unroll") for (int n = 0; n < 2; ++n) _Pragma("unroll") for (int k = 0; k < 2; ++k) \
        acc[ai][bj][m][n] = __builtin_amdgcn_mfma_f32_16x16x32_bf16(Bt[n][k], At[m][k], acc[ai][bj][m][n], 0, 0, 0); __builtin_amdgcn_s_setprio(0); } while (0)
#define PG8_WAIT_V(n) asm volatile("s_waitcnt vmcnt(" #n ")" ::: "memory")
#define PG8_WAIT_L(n) asm volatile("s_waitcnt lgkmcnt(" #n ")" ::: "memory")
#define PG8_BAR __builtin_amdgcn_s_barrier()
#define PG8_SCHED __builtin_amdgcn_sched_barrier(0)
    Unit cur, nxt; int ui = 0;
    if (!S.next(0, cur)) return;
    f32x4 acc[2][2][4][2];
#pragma unroll
    for (int a = 0; a < 2; ++a)
#pragma unroll
        for (int b = 0; b < 2; ++b)
#pragma unroll
            for (int m = 0; m < 4; ++m)
#pragma unroll
                for (int n = 0; n < 2; ++n) acc[a][b][m][n] = (f32x4){0.f, 0.f, 0.f, 0.f};
    bf16x8 At[4][2], B0[2][2], B1[2][2];
    const char* cA = (const char*)g.A + (size_t)cur.pm * tA + (size_t)(cur.pn / g.agrp) * g.astride; const char* cB = (const char*)g.Bt + (size_t)cur.pn * tB;
    PG8_STAGE(PG8_SB(0, 0), cB, voffB); PG8_STAGE(PG8_SB(0, 1), cB + hB, voffB); PG8_STAGE(PG8_SA(0, 0), cA, voffA); PG8_STAGE(PG8_SA(0, 1), cA + hA, voffA);
    if (wr == 1) PG8_BAR;
    PG8_WAIT_V(2); PG8_BAR;
    PG8_STAGE(PG8_SB(1, 0), cB + kstep, voffB); PG8_STAGE(PG8_SA(1, 0), cA + kstep, voffA); PG8_STAGE(PG8_SB(1, 1), cB + hB + kstep, voffB);
    PG8_WAIT_V(6); PG8_BAR;
    for (;;) {
        const bool has_next = S.next(ui + 1, nxt);
        const char* nA = has_next ? (const char*)g.A + (size_t)nxt.pm * tA + (size_t)(nxt.pn / g.agrp) * g.astride : cA; const char* nB = has_next ? (const char*)g.Bt + (size_t)nxt.pn * tB : cB;
#pragma nounroll
        for (int t = 0; t < nt; t += 2) {
            const bool last = (t == nt - 2);
            const char* a1 = cA + (size_t)(t + 1) * kstep;
            const char* a2 = last ? nA : cA + (size_t)(t + 2) * kstep; const char* b2 = last ? nB : cB + (size_t)(t + 2) * kstep;
            const char* a3 = a2 + kstep; const char* b3 = b2 + kstep;
            PG8_LDB(B0, 0, 0); PG8_LDB(B1, 0, 1); PG8_SCHED; PG8_LDA(At, 0, 0); PG8_STAGE(PG8_SA(1, 1), a1 + hA, voffA);
            PG8_WAIT_V(8); PG8_WAIT_L(0); PG8_BAR; PG8_MMA(0, 0, At, B0); PG8_MMA(0, 1, At, B1); PG8_BAR; PG8_SCHED;
            PG8_LDA(At, 0, 1); PG8_STAGE(PG8_SB(0, 0), b2, voffB); PG8_STAGE(PG8_SB(0, 1), b2 + hB, voffB); PG8_STAGE(PG8_SA(0, 0), a2, voffA);
            PG8_WAIT_V(8); PG8_WAIT_L(0); PG8_BAR; PG8_MMA(1, 0, At, B0); PG8_MMA(1, 1, At, B1); PG8_BAR; PG8_SCHED;
            PG8_LDB(B0, 1, 0); PG8_LDB(B1, 1, 1); PG8_SCHED; PG8_LDA(At, 1, 0); PG8_STAGE(PG8_SA(0, 1), a2 + hA, voffA);
            PG8_WAIT_V(8); PG8_WAIT_L(0); PG8_BAR; PG8_MMA(0, 0, At, B0); PG8_MMA(0, 1, At, B1); PG8_BAR; PG8_SCHED;
            PG8_LDA(At, 1, 1); PG8_STAGE(PG8_SB(1, 0), b3, voffB); PG8_STAGE(PG8_SB(1, 1), b3 + hB, voffB); PG8_STAGE(PG8_SA(1, 0), a3, voffA);
            PG8_WAIT_V(8); PG8_WAIT_L(0); PG8_BAR; PG8_MMA(1, 0, At, B0); PG8_MMA(1, 1, At, B1); PG8_BAR; PG8_SCHED;
        }
        if (wr == 0) PG8_BAR;
        E(acc, cur, ui, wr, wc, fr, fq);
        if (!has_next) break;
#pragma unroll
        for (int a = 0; a < 2; ++a)
#pragma unroll
            for (int b = 0; b < 2; ++b)
#pragma unroll
                for (int m = 0; m < 4; ++m)
#pragma unroll
                    for (int n = 0; n < 2; ++n) acc[a][b][m][n] = (f32x4){0.f, 0.f, 0.f, 0.f};
        cur = nxt; cA = nA; cB = nB; ++ui;
        if (wr == 1) PG8_BAR;
    }
    PG8_WAIT_V(0);
    PG8_BAR;
#undef PG8_SA
#undef PG8_SB
#undef PG8_STAGE
#undef PG8_LDA
#undef PG8_LDB
#undef PG8_MMA
#undef PG8_WAIT_V
#undef PG8_WAIT_L
#undef PG8_BAR
#undef PG8_SCHED
}

#define EPI_ARGS const f32x4 (&acc)[2][2][4][2], const Unit& u, int ui, int wr, int wc, int fr, int fq
#define EPI_ROWS for (int ai = 0; ai < 2; ++ai) _Pragma("unroll") for (int m = 0; m < 4; ++m)
struct EpiSplit {
    bf16_t* O; int ldc; int split_cols; size_t split_stride;
    __device__ __forceinline__ void operator()(EPI_ARGS) const {
        int colt = u.pn * BM; const int t = colt / split_cols; bf16_t* base = O + (size_t)t * split_stride; colt -= t * split_cols;
        const int col0 = colt + wc * 32 + 8 * fq;
#pragma unroll
        EPI_ROWS { bf16_t* rowp = base + (size_t)(u.pm * BM + ai * HALF + wr * 64 + m * 16 + fr) * ldc + col0;
#pragma unroll
            for (int bj = 0; bj < 2; ++bj) *(u32x4*)(rowp + bj * HALF) = pack8(acc[ai][bj][m][0], acc[ai][bj][m][1]); }
    }
};
struct EpiLora1 {
    bf16_t* A2; bf16_t* SG;
    __device__ __forceinline__ void operator()(EPI_ARGS) const {
        bf16_t* base = u.pn == 0 ? A2 : SG; const int col0 = wc * 32 + 8 * fq;
#pragma unroll
        EPI_ROWS { bf16_t* rowp = base + (size_t)(u.pm * BM + ai * HALF + wr * 64 + m * 16 + fr) * 256 + col0;
            f32x4 v0 = acc[ai][0][m][0], v1 = acc[ai][0][m][1];
            if (u.pn == 0) { for (int e = 0; e < 4; ++e) { v0[e] = tanhf_(v0[e]); v1[e] = tanhf_(v1[e]); } }
            else { for (int e = 0; e < 4; ++e) { v0[e] = sigmoidf_(v0[e]); v1[e] = sigmoidf_(v1[e]); } }
            *(u32x4*)(rowp) = pack8(v0, v1);
            f32x4 w0 = acc[ai][1][m][0], w1 = acc[ai][1][m][1];
            if (u.pn != 0) { w0 = (f32x4){0.f, 0.f, 0.f, 0.f}; w1 = w0; }
            *(u32x4*)(rowp + HALF) = pack8(w0, w1); }
    }
};
struct EpiLora2 {
    bf16_t* EW; bf16_t* AA; const float* w0; const float* a0;
    __device__ __forceinline__ void operator()(EPI_ARGS) const {
        const int grp = u.pn >> 2, c0 = (u.pn & 3) * BM + wc * 32 + 8 * fq;
        const float* bias = (grp < 2 ? w0 + grp * D : a0 + (grp - 2) * D) + c0;
        bf16_t* base = (grp < 2 ? EW + (size_t)grp * M * D : AA + (size_t)(grp - 2) * M * D) + c0;
        const float sc = grp < 2 ? 0.60653065971f : 1.0f;
#pragma unroll
        EPI_ROWS { bf16_t* rowp = base + (size_t)(u.pm * BM + ai * HALF + wr * 64 + m * 16 + fr) * D;
#pragma unroll
            for (int bj = 0; bj < 2; ++bj) { f32x4 v0 = acc[ai][bj][m][0] + *(const f32x4*)(bias + bj * HALF), v1 = acc[ai][bj][m][1] + *(const f32x4*)(bias + bj * HALF + 4);
                for (int e = 0; e < 4; ++e) { v0[e] = sigmoidf_(v0[e]) * sc; v1[e] = sigmoidf_(v1[e]) * sc; }
                *(u32x4*)(rowp + bj * HALF) = pack8(v0, v1); } if (m & 1) asm volatile("" ::: "memory"); }
    }
};
struct EpiG {
    bf16_t* Z;
    __device__ __forceinline__ void operator()(EPI_ARGS) const {
        const int col0 = u.pn * BM + wc * 32 + 8 * fq;
#pragma unroll
        EPI_ROWS { bf16_t* rowp = Z + (size_t)(u.pm * BM + ai * HALF + wr * 64 + m * 16 + fr) * D + col0;
#pragma unroll
            for (int bj = 0; bj < 2; ++bj) { const u32x4 zw = *(const u32x4*)(rowp + bj * HALF); float z[8]; unpack8(zw, z);
                f32x4 v0 = acc[ai][bj][m][0], v1 = acc[ai][bj][m][1];
                for (int e = 0; e < 4; ++e) { v0[e] *= z[e]; v1[e] *= z[4 + e]; }
                *(u32x4*)(rowp + bj * HALF) = pack8(v0, v1); } if (m & 1) asm volatile("" ::: "memory"); }
    }
};
template <bool BASE_F32> struct EpiRes {
    const float* basef; bf16_t* xb; float* ss;
    __device__ __forceinline__ void operator()(EPI_ARGS) const {
        const int col0 = u.pn * BM + wc * 32 + 8 * fq;
#pragma unroll
        EPI_ROWS { const int row = u.pm * BM + ai * HALF + wr * 64 + m * 16 + fr; const size_t off = (size_t)row * D + col0; float sq = 0.f;
#pragma unroll
            for (int bj = 0; bj < 2; ++bj) { f32x4 b0, b1;
                if (BASE_F32) { const float* bp = basef + off + bj * HALF; b0 = *(const f32x4*)bp; b1 = *(const f32x4*)(bp + 4); }
                else { const u32x4 w = *(const u32x4*)(xb + off + bj * HALF); float t[8]; unpack8(w, t); b0 = (f32x4){t[0], t[1], t[2], t[3]}; b1 = (f32x4){t[4], t[5], t[6], t[7]}; }
                const f32x4 v0 = acc[ai][bj][m][0] + b0, v1 = acc[ai][bj][m][1] + b1;
                *(u32x4*)(xb + off + bj * HALF) = pack8(v0, v1);
                sq += (v0[0] * v0[0] + v0[1] * v0[1]) + (v0[2] * v0[2] + v0[3] * v0[3]) + (v1[0] * v1[0] + v1[1] * v1[1]) + (v1[2] * v1[2] + v1[3] * v1[3]); }
            sq += __shfl_xor(sq, 16); sq += __shfl_xor(sq, 32);
            if (fq == 0) ss[(size_t)row * 16 + u.pn * 4 + wc] = sq; if (m & 1) asm volatile("" ::: "memory"); }
    }
};
struct EpiSq {
    bf16_t* H; const LAS float* RS;
    __device__ __forceinline__ void operator()(EPI_ARGS) const {
        const int col0 = u.pn * BM + wc * 32 + 8 * fq;
#pragma unroll
        EPI_ROWS { const int rl = ai * HALF + wr * 64 + m * 16 + fr; const float rs = RS[ui * 256 + rl]; bf16_t* rowp = H + (size_t)(u.pm * BM + rl) * FF + col0;
#pragma unroll
            for (int bj = 0; bj < 2; ++bj) { f32x4 v0 = acc[ai][bj][m][0] * rs, v1 = acc[ai][bj][m][1] * rs;
                for (int e = 0; e < 4; ++e) { const float a = fmaxf(v0[e], 0.f), b = fmaxf(v1[e], 0.f); v0[e] = a * a; v1[e] = b * b; }
                *(u32x4*)(rowp + bj * HALF) = pack8(v0, v1); } }
    }
};
struct EpiGelu {
    bf16_t* H; const LAS float* RS; f32x2* LNP;
    __device__ __forceinline__ void operator()(EPI_ARGS) const {
        const int col0 = u.pn * BM + wc * 32 + 8 * fq;
#pragma unroll
        EPI_ROWS { const int rl = ai * HALF + wr * 64 + m * 16 + fr; const float rs = RS[ui * 256 + rl]; const int row = u.pm * BM + rl; bf16_t* rowp = H + (size_t)row * FF + col0; float s = 0.f, q = 0.f;
#pragma unroll
            for (int bj = 0; bj < 2; ++bj) { f32x4 v0 = acc[ai][bj][m][0] * rs, v1 = acc[ai][bj][m][1] * rs;
                const f32x2 g0 = gelu_pk((f32x2){v0[0], v0[1]}), g1 = gelu_pk((f32x2){v0[2], v0[3]}), g2 = gelu_pk((f32x2){v1[0], v1[1]}), g3 = gelu_pk((f32x2){v1[2], v1[3]});
                v0 = (f32x4){g0.x, g0.y, g1.x, g1.y}; v1 = (f32x4){g2.x, g2.y, g3.x, g3.y};
                s += (v0[0] + v0[1]) + (v0[2] + v0[3]) + (v1[0] + v1[1]) + (v1[2] + v1[3]);
                q += (v0[0] * v0[0] + v0[1] * v0[1]) + (v0[2] * v0[2] + v0[3] * v0[3]) + (v1[0] * v1[0] + v1[1] * v1[1]) + (v1[2] * v1[2] + v1[3] * v1[3]);
                *(u32x4*)(rowp + bj * HALF) = pack8(v0, v1); }
            if (u.pn >= 8) { s += __shfl_xor(s, 16); s += __shfl_xor(s, 32); q += __shfl_xor(q, 16); q += __shfl_xor(q, 32);
                if (fq == 0) LNP[(size_t)row * 32 + (u.pn - 8) * 4 + wc] = (f32x2){s, q}; } }
    }
};
}

struct Args { const float* in[30]; float* out; unsigned char* ws; int ph_lo, ph_hi; };
struct Frame {
    LAS unsigned char* lds;
    int tid, lane, wave, G;
    float* out; unsigned char* ws;
};
#define LDS_WAIT() asm volatile("s_waitcnt lgkmcnt(0)" ::: "memory")

__device__ __forceinline__ void tr_item(const float* W, int ldw, bf16_t* WT, int ldt, int drow0, int dcol0, const float* ks, LAS float* scr, int k0, int n0, int lane) {
#pragma unroll 8
    for (int i = 0; i < 32; ++i) { const int kk = 2 * i + (lane >> 5); float v = W[(size_t)(k0 + kk) * ldw + n0 + (lane & 31)]; if (ks) v *= ks[k0 + kk]; scr[kk * 33 + (lane & 31)] = v; }
    LDS_WAIT(); asm volatile("" ::: "memory");
    const int c = lane & 7;
#pragma unroll
    for (int j = 0; j < 4; ++j) { const int n = (lane >> 3) + 8 * j; const LAS float* s = scr + (8 * c) * 33 + n;
        u32x4 o; o.x = cvt_pk_bf16(s[0 * 33], s[1 * 33]); o.y = cvt_pk_bf16(s[2 * 33], s[3 * 33]); o.z = cvt_pk_bf16(s[4 * 33], s[5 * 33]); o.w = cvt_pk_bf16(s[6 * 33], s[7 * 33]);
        *(u32x4*)(WT + (size_t)(drow0 + n0 + n) * ldt + dcol0 + k0 + 8 * c) = o; }
    LDS_WAIT(); asm volatile("" ::: "memory");
}
__device__ __forceinline__ void zero_item(bf16_t* WT, int ldt, int row0, int col0, int lane) {
#pragma unroll
    for (int j = 0; j < 4; ++j) { const int q = lane + 64 * j, r = q >> 3, c = q & 7; *(u32x4*)(WT + (size_t)(row0 + r) * ldt + col0 + 8 * c) = (u32x4){0u, 0u, 0u, 0u}; }
}
#define TR_MAT(W, KK, NN, WT, LDT, DR, DC, KS) { const int _n = ((KK) / 64) * ((NN) / 32); if (r < _n) { const int _nb = (NN) / 32; tr_item(W, NN, WT, LDT, DR, DC, KS, scr, 64 * (r / _nb), 32 * (r % _nb), F.lane); continue; } r -= _n; }

__device__ __forceinline__ void p0_phase(Frame& F, const Args& A) {
    LAS float* scr = (LAS float*)(F.lds + F.wave * 16384);
    const int gw = blockIdx.x * NWAVES + F.wave, NGW = F.G * NWAVES;
    bf16_t* WRKV = (bf16_t*)(F.ws + WS_WRKV); bf16_t* WO = (bf16_t*)(F.ws + WS_WO); bf16_t* L1 = (bf16_t*)(F.ws + WS_L1); bf16_t* L2 = (bf16_t*)(F.ws + WS_L2); bf16_t* G2 = (bf16_t*)(F.ws + WS_G2);
    const float* mu = A.in[4];
    constexpr int NZ1 = 128, NZ2 = 128;
    constexpr int NTOT = 4 * 512 + 2 * (4 * 32 + 64) + 4 * 32 + 64 + NZ1 + NZ2;
    for (int it = gw; it < NTOT; it += NGW) {
        int r = it;
        TR_MAT(A.in[5], 1024, 1024, WRKV, 1024, 0, 0, nullptr)
        TR_MAT(A.in[6], 1024, 1024, WRKV, 1024, 1024, 0, nullptr)
        TR_MAT(A.in[7], 1024, 1024, WRKV, 1024, 2048, 0, nullptr)
        TR_MAT(A.in[8], 1024, 1024, WO, 1024, 0, 0, nullptr)
        TR_MAT(A.in[10], 1024, 64, L1, 2048, 0, 0, nullptr)
        TR_MAT(A.in[10] + 1024 * 64, 1024, 64, L1, 2048, 64, 0, nullptr)
        TR_MAT(A.in[13], 1024, 64, L1, 2048, 128, 0, nullptr)
        TR_MAT(A.in[13] + 1024 * 64, 1024, 64, L1, 2048, 192, 0, nullptr)
        TR_MAT(A.in[15], 1024, 128, L1, 2048, 256, 0, nullptr)
        TR_MAT(A.in[10], 1024, 64, L1, 2048, 0, 1024, mu + 1 * D)
        TR_MAT(A.in[10] + 1024 * 64, 1024, 64, L1, 2048, 64, 1024, mu + 1 * D)
        TR_MAT(A.in[13], 1024, 64, L1, 2048, 128, 1024, mu + 4 * D)
        TR_MAT(A.in[13] + 1024 * 64, 1024, 64, L1, 2048, 192, 1024, mu + 4 * D)
        TR_MAT(A.in[15], 1024, 128, L1, 2048, 256, 1024, mu + 5 * D)
        TR_MAT(A.in[11], 64, 1024, L2, 128, 0, 0, nullptr)
        TR_MAT(A.in[11] + 64 * 1024, 64, 1024, L2, 128, 1024, 64, nullptr)
        TR_MAT(A.in[14], 64, 1024, L2, 128, 2048, 0, nullptr)
        TR_MAT(A.in[14] + 64 * 1024, 64, 1024, L2, 128, 3072, 64, nullptr)
        TR_MAT(A.in[16], 128, 1024, G2, 128, 0, 0, nullptr)
        if (r < NZ1) { zero_item(L1, 2048, 384 + 32 * (r / 32), 64 * (r % 32), F.lane); continue; } r -= NZ1;
        { const int grp = r / 32; zero_item(L2, 128, 32 * r, 64 * (1 - (grp & 1)), F.lane); }
    }
    const float* x = A.in[0]; const float* gn = A.in[1];
    bf16_t* XNXX = (bf16_t*)F.out; bf16_t* XR = (bf16_t*)(F.ws + WS_XR);
    f32x4 gv[4], m0[4], m2[4], m3[4];
#pragma unroll
    for (int j = 0; j < 4; ++j) { gv[j] = ((const f32x4*)gn)[64 * j + F.lane]; m0[j] = ((const f32x4*)mu)[64 * j + F.lane]; m2[j] = ((const f32x4*)(mu + 2 * D))[64 * j + F.lane]; m3[j] = ((const f32x4*)(mu + 3 * D))[64 * j + F.lane]; }
    for (int m = gw; m < M; m += NGW) {
        const int t = m & (T - 1); const bool hp = t > 0, hn = t < T - 1;
        const f32x4* xc = (const f32x4*)(x + (size_t)m * D) + F.lane; const f32x4* xp = xc - D / 4; const f32x4* xq = xc + D / 4;
        f32x4 vc[4], vp[4], vn[4]; float sc = 0.f, sp = 0.f, sn = 0.f; const f32x4 z4 = {0.f, 0.f, 0.f, 0.f};
#pragma unroll
        for (int j = 0; j < 4; ++j) { vc[j] = xc[64 * j]; vp[j] = hp ? xp[64 * j] : z4; vn[j] = hn ? xq[64 * j] : z4;
            sc += (vc[j].x * vc[j].x + vc[j].y * vc[j].y) + (vc[j].z * vc[j].z + vc[j].w * vc[j].w);
            sp += (vp[j].x * vp[j].x + vp[j].y * vp[j].y) + (vp[j].z * vp[j].z + vp[j].w * vp[j].w);
            sn += (vn[j].x * vn[j].x + vn[j].y * vn[j].y) + (vn[j].z * vn[j].z + vn[j].w * vn[j].w); }
        const float rc = 1.0f / sqrtf(wave_sum(sc) * (1.f / D) + NORM_EPS), rp = 1.0f / sqrtf(wave_sum(sp) * (1.f / D) + NORM_EPS), rn = 1.0f / sqrtf(wave_sum(sn) * (1.f / D) + NORM_EPS);
#pragma unroll
        for (int j = 0; j < 4; ++j) { const int col = 4 * (64 * j + F.lane);
            const f32x4 a = vc[j] * rc * gv[j], xx = (vp[j] * rp + vn[j] * rn) * gv[j] * 0.5f - a;
            const f32x4 vr = a + xx * m0[j], vk = a + xx * m2[j], vv = a + xx * m3[j];
            *(u32x2*)(XNXX + (size_t)m * 2048 + col) = (u32x2){cvt_pk_bf16(a[0], a[1]), cvt_pk_bf16(a[2], a[3])};
            *(u32x2*)(XNXX + (size_t)m * 2048 + 1024 + col) = (u32x2){cvt_pk_bf16(xx[0], xx[1]), cvt_pk_bf16(xx[2], xx[3])};
            *(u32x2*)(XR + (size_t)m * D + col) = (u32x2){cvt_pk_bf16(vr[0], vr[1]), cvt_pk_bf16(vr[2], vr[3])};
            *(u32x2*)(XR + (size_t)M * D + (size_t)m * D + col) = (u32x2){cvt_pk_bf16(vk[0], vk[1]), cvt_pk_bf16(vk[2], vk[3])};
            *(u32x2*)(XR + 2 * (size_t)M * D + (size_t)m * D + col) = (u32x2){cvt_pk_bf16(vv[0], vv[1]), cvt_pk_bf16(vv[2], vv[3])}; }
    }
}

__device__ __forceinline__ void convB_phase(Frame& F, const Args& A) {
    LAS float* scr = (LAS float*)(F.lds + F.wave * 16384);
    const int gw = blockIdx.x * NWAVES + F.wave, NGW = F.G * NWAVES;
    bf16_t* W1_0 = (bf16_t*)(F.ws + WS_W1_0); bf16_t* W2_0 = (bf16_t*)(F.ws + WS_W2_0); bf16_t* WIN = (bf16_t*)(F.ws + WS_WIN); bf16_t* WOUT = (bf16_t*)(F.ws + WS_WOUT);
    bf16_t* WSB = (bf16_t*)(F.ws + WS_WSB); bf16_t* W1_1 = (bf16_t*)(F.ws + WS_W1_1); bf16_t* W2_1 = (bf16_t*)(F.ws + WS_W2_1);
    constexpr int NTOT = 5 * 2048 + 1024 + 512;
    for (int it = gw; it < NTOT; it += NGW) {
        int r = it;
        TR_MAT(A.in[28], 1024, 4096, W1_0, 1024, 0, 0, A.in[2])
        TR_MAT(A.in[29], 4096, 1024, W2_0, 4096, 0, 0, nullptr)
        TR_MAT(A.in[22], 1024, 4096, WIN, 1024, 0, 0, A.in[1] + D)
        TR_MAT(A.in[28] + (size_t)D * FF, 1024, 4096, W1_1, 1024, 0, 0, A.in[2] + D)
        TR_MAT(A.in[29] + (size_t)D * FF, 4096, 1024, W2_1, 4096, 0, 0, nullptr)
        TR_MAT(A.in[27], 2048, 1024, WOUT, 2048, 0, 0, nullptr)
        { const float* s = A.in[25] + (size_t)r * 512 + F.lane * 8; const f32x4 a = *(const f32x4*)s, b = *(const f32x4*)(s + 4); *(u32x4*)(WSB + (size_t)r * 512 + F.lane * 8) = pack8(a, b); }
    }
}

constexpr int TC = 16, NCH = T / TC, SREC = 336;
template <int VAR>
__device__ __forceinline__ void scan_phase(Frame& F, const Args& A) {
    LAS float* BUF = (LAS float*)(F.lds);
    LAS float* OP = (LAS float*)(F.lds + 4 * TC * SREC * 4);
    LAS unsigned* FL = (LAS unsigned*)(F.lds + 4 * TC * SREC * 4 + 2 * TC * 256 * 4);
    const int tid = F.tid, lane = F.lane, wave = F.wave;
    const bool prod = wave >= 4; const int ptid = tid - 256;
    const bf16_t* Rg = (const bf16_t*)(F.ws + WS_R); const bf16_t* Kg = (const bf16_t*)(F.ws + WS_K); const bf16_t* Vg = (const bf16_t*)(F.ws + WS_V);
    const bf16_t* EWg = (const bf16_t*)F.out; const bf16_t* AAg = (const bf16_t*)(F.ws + WS_AA); bf16_t* ODg = (bf16_t*)(F.ws + WS_OD);
    for (int it0 = blockIdx.x; it0 < 256; it0 += F.G) {
        const int item = (F.G == 256) ? ((it0 & 7) * 32 + (it0 >> 3)) : it0;
        const int chain = item >> 2, quarter = item & 3, dir = chain & 1, bh = chain >> 1, b = bh >> 4, h = bh & 15, row0 = quarter * 16;
        const size_t boff = (size_t)b * T * D + h * 64;
        const bf16_t* Rp = Rg + boff; const bf16_t* Kp = Kg + boff; const bf16_t* Vp = Vg + boff;
        const bf16_t* Ep = EWg + (size_t)dir * M * D + boff; const bf16_t* Ap = AAg + (size_t)dir * M * D + boff; bf16_t* Op = ODg + (size_t)dir * M * D + boff + row0;
        const int pw = wave - 4, tq = lane >> 4, c4 = (lane & 15) * 4;
        u32x2 raw[4][5];
#pragma unroll
        for (int j = 0; j < 4; ++j) for (int q = 0; q < 5; ++q) raw[j][q] = (u32x2){0u, 0u};
        f32x4 kk4 = {0, 0, 0, 0}, ka4 = {0, 0, 0, 0}, rk4 = {0, 0, 0, 0};
        if (prod) { kk4 = *(const f32x4*)(A.in[17] + h * 64 + c4); ka4 = *(const f32x4*)(A.in[18] + h * 64 + c4); rk4 = *(const f32x4*)(A.in[19] + h * 64 + c4); }
        asm volatile("s_waitcnt vmcnt(0)" : "+v"(kk4), "+v"(ka4), "+v"(rk4) :: "memory");
        bf16_t* Dp = (bf16_t*)(F.ws + WS_DOT) + ((size_t)dir * M + (size_t)b * T) * 16 + h;
#define SC_LOAD(c) do { _Pragma("unroll") for (int j = 0; j < 4; ++j) { const int step = (c) * TC + tq + 4 * j; const int tt = dir ? (T - 1 - step) : step; const size_t o = (size_t)tt * D + c4; \
        raw[j][0] = *(const u32x2*)(Rp + o); raw[j][1] = *(const u32x2*)(Kp + o); raw[j][2] = *(const u32x2*)(Vp + o); raw[j][3] = *(const u32x2*)(Ep + o); raw[j][4] = *(const u32x2*)(Ap + o); } } while (0)
#define SC_PROC(c) do { _Pragma("unroll") for (int j = 0; j < 4; ++j) { const int tl = tq + 4 * j; const u32x2 rr = raw[j][0], rk = raw[j][1], rv = raw[j][2], re = raw[j][3], ra = raw[j][4]; \
        const f32x4 r4 = {bf_lo(rr.x), bf_hi(rr.x), bf_lo(rr.y), bf_hi(rr.y)}, k4 = {bf_lo(rk.x), bf_hi(rk.x), bf_lo(rk.y), bf_hi(rk.y)}, v4 = {bf_lo(rv.x), bf_hi(rv.x), bf_lo(rv.y), bf_hi(rv.y)}; \
        const f32x4 e4 = {bf_lo(re.x), bf_hi(re.x), bf_lo(re.y), bf_hi(re.y)}, a4 = {bf_lo(ra.x), bf_hi(ra.x), bf_lo(ra.y), bf_hi(ra.y)}; \
        f32x4 kk = k4 * kk4; float ss = (kk[0] * kk[0] + kk[1] * kk[1]) + (kk[2] * kk[2] + kk[3] * kk[3]); ss = row16_allsum(ss); \
        const float inv = __builtin_amdgcn_rsqf(fmaxf(ss, 1e-24f)); kk = kk * inv; \
        f32x4 dec; dec[0] = __expf(-e4[0]); dec[1] = __expf(-e4[1]); dec[2] = __expf(-e4[2]); dec[3] = __expf(-e4[3]); \
        const f32x4 kd = k4 * (1.0f + (a4 - 1.0f) * ka4); \
        { const f32x4 pr_ = r4 * kd * rk4; float dt = (pr_[0] + pr_[1]) + (pr_[2] + pr_[3]); dt = row16_allsum(dt); \
          if (quarter == 0 && (lane & 15) == 0) { const int step_ = (c) * TC + tl; const int tt_ = dir ? (T - 1 - step_) : step_; Dp[(size_t)tt_ * 16] = (bf16_t)(cvt_pk_bf16(dt, 0.f) & 0xffffu); } } \
        LAS float* dst = BUF + ((c) & 3) * TC * SREC + tl * SREC + c4; \
        *(LAS f32x4*)(dst) = dec; *(LAS f32x4*)(dst + 64) = -kk; *(LAS f32x4*)(dst + 128) = kk * a4; *(LAS f32x4*)(dst + 192) = kd; *(LAS f32x4*)(dst + 256) = r4; \
        if ((c4 >> 4) == quarter) *(LAS f32x4*)(BUF + ((c) & 3) * TC * SREC + tl * SREC + 320 + c4 - row0) = v4; } } while (0)
#define SC_RED(c, ok) do { const int row = lane & 15; const LAS float* src = OP + ((c) & 1) * TC * 256 + tq * 1024 + ((row >> 2) * 64 + (row & 3) * 16) * 4; \
        f32x4 o4 = {0.f, 0.f, 0.f, 0.f}; \
        _Pragma("unroll") for (int j = 0; j < 16; ++j) o4 += *(const LAS f32x4*)(src + (((j + row) & 15) << 2));     \
        _Pragma("unroll") for (int e = 0; e < 4; ++e) { const int step = (c) * TC + 4 * tq + e; const int tt = dir ? (T - 1 - step) : step; \
            if (ok) Op[(size_t)tt * D + row] = (bf16_t)(cvt_pk_bf16(o4[e], 0.f) & 0xffffu); } } while (0)
#define SC_SPIN_GE(p_, v_) do { unsigned n_ = 0; while (*(volatile LAS unsigned*)(p_) < (unsigned)(v_)) { __builtin_amdgcn_s_sleep(1); if (++n_ > (1u << 22)) break; } asm volatile("" ::: "memory"); } while (0)
        if (tid < 16) FL[tid] = 0u;
        __syncthreads();
        if (prod) {
            SC_LOAD(pw);
#pragma nounroll
            for (int m = 0; m < NCH / 4; ++m) {
                const int k = pw + 4 * m;
                SC_PROC(k);
                asm volatile("s_waitcnt lgkmcnt(0)" ::: "memory");
                if (lane == 0) *(volatile LAS unsigned*)(FL + pw) = (unsigned)(m + 1);
                { const int kl = (k + 4 < NCH) ? k + 4 : NCH - 1; SC_LOAD(kl); }
                SC_SPIN_GE(FL + 4 + pw, 4 * (m + 1));
                SC_RED(k, true);
                asm volatile("s_waitcnt lgkmcnt(0)" ::: "memory");
                if (lane == 0) (void)__hip_atomic_fetch_add(FL + 8 + (k & 1), 1u, __ATOMIC_RELAXED, __HIP_MEMORY_SCOPE_WORKGROUP);
            }
        } else {
            f32x2 S01 = {0.f, 0.f}, S23 = {0.f, 0.f};
            const int ks = lane & 15, rl = lane >> 4;
            unsigned fl_rdy = 0u, fl_red = 0u;
#pragma nounroll
            for (int c = 0; c < NCH; ++c) {
                if (fl_rdy < (unsigned)((c >> 2) + 1)) SC_SPIN_GE(FL + (c & 3), (c >> 2) + 1);
                if (c >= 2 && fl_red < (unsigned)(c >> 1)) SC_SPIN_GE(FL + 8 + (c & 1), c >> 1);
                const LAS float* bp = BUF + (c & 3) * TC * SREC + ks * 4; const LAS float* vp = BUF + (c & 3) * TC * SREC + 320 + wave * 4 + rl;
                LAS float* op = OP + (c & 1) * TC * 256 + tid * 4;
                f32x4 oq = {0.f, 0.f, 0.f, 0.f};
                constexpr int PD = 2;
                f32x4 pw_[PD], pa_[PD], pb_[PD], pk_[PD], pr_[PD]; float pv_[PD];
#pragma unroll
                for (int j = 0; j < PD; ++j) { const LAS float* q = bp + j * SREC; pw_[j] = *(const LAS f32x4*)(q); pa_[j] = *(const LAS f32x4*)(q + 64); pb_[j] = *(const LAS f32x4*)(q + 128); pk_[j] = *(const LAS f32x4*)(q + 192); pr_[j] = *(const LAS f32x4*)(q + 256); pv_[j] = vp[j * SREC]; }
#pragma unroll
                for (int i = 0; i < TC; ++i) {
                    const int sl = i % PD;
                    const f32x4 w = pw_[sl], a = pa_[sl], bb = pb_[sl], k = pk_[sl], r = pr_[sl]; const float v = pv_[sl];
                    if (i == 10) { fl_rdy = *(volatile LAS unsigned*)(FL + ((c + 1) & 3)); fl_red = *(volatile LAS unsigned*)(FL + 8 + ((c + 1) & 1)); }
                    if (i + PD < TC) { const LAS float* q = bp + (i + PD) * SREC; pw_[sl] = *(const LAS f32x4*)(q); pa_[sl] = *(const LAS f32x4*)(q + 64); pb_[sl] = *(const LAS f32x4*)(q + 128); pk_[sl] = *(const LAS f32x4*)(q + 192); pr_[sl] = *(const LAS f32x4*)(q + 256); pv_[sl] = vp[(i + PD) * SREC]; }
                    f32x2 p = S01 * (f32x2){a[0], a[1]}; p = S23 * (f32x2){a[2], a[3]} + p;
                    float sa = p.x + p.y; sa = row16_allsum(sa);
                    const f32x2 vk01 = (f32x2){k[0], k[1]} * v, vk23 = (f32x2){k[2], k[3]} * v;
                    const f32x2 t01 = (f32x2){bb[0], bb[1]} * sa + vk01, t23 = (f32x2){bb[2], bb[3]} * sa + vk23;
                    S01 = S01 * (f32x2){w[0], w[1]} + t01; S23 = S23 * (f32x2){w[2], w[3]} + t23;
                    f32x2 q2 = S01 * (f32x2){r[0], r[1]}; q2 = S23 * (f32x2){r[2], r[3]} + q2;
                    oq[i & 3] = q2.x + q2.y; if ((i & 3) == 3) *(LAS f32x4*)(op + (i >> 2) * 1024) = oq;
                }
                asm volatile("s_waitcnt lgkmcnt(0)" ::: "memory");
                if (lane == 0) (void)__hip_atomic_fetch_add(FL + 4 + (c & 3), 1u, __ATOMIC_RELAXED, __HIP_MEMORY_SCOPE_WORKGROUP);
            }
        }
        __syncthreads();
#undef SC_SPIN_GE
#undef SC_LOAD
#undef SC_PROC
#undef SC_RED
    }
}

__device__ __forceinline__ void z_phase(Frame& F, const Args& A) {
    const int gw = blockIdx.x * NWAVES + F.wave, NGW = F.G * NWAVES, col = F.lane * 16;
    const bf16_t* Rg = (const bf16_t*)(F.ws + WS_R); const bf16_t* Kg = (const bf16_t*)(F.ws + WS_K); const bf16_t* Vg = (const bf16_t*)(F.ws + WS_V);
    const bf16_t* A0 = (const bf16_t*)(F.ws + WS_AA); const bf16_t* A1 = A0 + (size_t)M * D; bf16_t* OF = (bf16_t*)(F.ws + WS_OD); const bf16_t* OB = OF + (size_t)M * D;
    float lg[16], lb[16];
#pragma unroll
    for (int i = 0; i < 16; ++i) { lg[i] = A.in[20][col + i]; lb[i] = A.in[21][col + i]; }
    for (int m = gw; m < M; m += NGW) {
        const size_t o = (size_t)m * D + col;
        float of[16], ob[16], v[16];
#define LD16(dst, P) { const u32x4 _a = *(const u32x4*)((P) + o), _b = *(const u32x4*)((P) + o + 8); float _t[8]; unpack8(_a, _t); for (int i = 0; i < 8; ++i) dst[i] = _t[i]; unpack8(_b, _t); for (int i = 0; i < 8; ++i) dst[8 + i] = _t[i]; }
        LD16(of, OF) LD16(ob, OB) LD16(v, Vg)
#undef LD16
        const bf16_t* DT = (const bf16_t*)(F.ws + WS_DOT) + (size_t)m * 16 + (F.lane >> 2);
        const float dot = __builtin_bit_cast(float, (unsigned)DT[0] << 16) + __builtin_bit_cast(float, (unsigned)DT[(size_t)M * 16] << 16);
        float s = 0.f;
#pragma unroll
        for (int i = 0; i < 16; ++i) { of[i] += ob[i]; s += of[i]; }
        s += __shfl_xor(s, 1); s += __shfl_xor(s, 2);
        const float mean = s * (1.f / 64.f); float q = 0.f;
#pragma unroll
        for (int i = 0; i < 16; ++i) { of[i] -= mean; q += of[i] * of[i]; }
        q += __shfl_xor(q, 1); q += __shfl_xor(q, 2);
        const float rstd = 1.0f / sqrtf(q * (1.f / 64.f) + GN_EPS);
        float z[16];
#pragma unroll
        for (int i = 0; i < 16; ++i) z[i] = of[i] * rstd * lg[i] + lb[i] + dot * v[i];
        u32x4 w0, w1; w0.x = cvt_pk_bf16(z[0], z[1]); w0.y = cvt_pk_bf16(z[2], z[3]); w0.z = cvt_pk_bf16(z[4], z[5]); w0.w = cvt_pk_bf16(z[6], z[7]);
        w1.x = cvt_pk_bf16(z[8], z[9]); w1.y = cvt_pk_bf16(z[10], z[11]); w1.z = cvt_pk_bf16(z[12], z[13]); w1.w = cvt_pk_bf16(z[14], z[15]);
        *(u32x4*)(OF + o) = w0; *(u32x4*)(OF + o + 8) = w1;
    }
}

__device__ __forceinline__ void rs_table(Frame& F, const pg8::StaticOrder& S) {
    LAS float* RS = (LAS float*)(F.lds + RS_OFF); const float* SS = (const float*)(F.ws + WS_SS);
    pg8::Unit u;
    for (int i = 0; i < 8 && S.next(i, u); ++i) {
        if (F.tid < 256) { const f32x4* p = (const f32x4*)(SS + (size_t)(u.pm * 256 + F.tid) * 16); const f32x4 a = p[0], b = p[1], c = p[2], d = p[3]; const f32x4 t = (a + b) + (c + d);
            RS[i * 256 + F.tid] = 1.0f / sqrtf(((t[0] + t[1]) + (t[2] + t[3])) * (1.f / D) + NORM_EPS); }
    }
    __syncthreads();
}

__device__ __forceinline__ void spatial_phase(Frame& F, const Args& A) {
    constexpr int LDW = 136;
    LAS bf16_t* WL = (LAS bf16_t*)(F.lds); LAS bf16_t* VL = (LAS bf16_t*)(F.lds + 128 * LDW * 2); LAS f32x2* ST = (LAS f32x2*)(F.lds + 2 * 128 * LDW * 2);
    bf16_t* H = (bf16_t*)(F.ws + WS_H); const bf16_t* WSB = (const bf16_t*)(F.ws + WS_WSB); const f32x2* LNP = (const f32x2*)(F.ws + WS_LNP);
    const float* lng = A.in[23]; const float* lnb = A.in[24]; const float* bs = A.in[26];
    const int tid = F.tid, lane = F.lane, wave = F.wave, fr = lane & 15, fq = lane >> 4;
    const int i0 = (wave >> 1) * 32, d0 = (wave & 1) * 64, cc = tid & 15;
    int gcur = -1; float gam[8], bet[8], bsv[2];
#pragma unroll
    for (int e = 0; e < 8; ++e) { gam[e] = 0.f; bet[e] = 0.f; }
    bsv[0] = bsv[1] = 0.f;
    u32x4 vraw[4]; f32x4 lnp[4];
#define SP_PREF(un_) do { const int c_ = (un_) >> 4, g_ = (un_) & 15; \
        _Pragma("unroll") for (int i = 0; i < 4; ++i) { const int j = (tid + 512 * i) >> 4; vraw[i] = *(const u32x4*)(H + (size_t)(c_ * 128 + j) * FF + 2048 + g_ * 128 + cc * 8); } \
        const f32x4* p_ = (const f32x4*)(LNP + (size_t)(c_ * 128 + (tid >> 2)) * 32) + (tid & 3) * 4; \
        _Pragma("unroll") for (int i = 0; i < 4; ++i) lnp[i] = p_[i]; } while (0)
    int un = blockIdx.x;
    if (un < 2048) SP_PREF(un);
    for (; un < 2048; un += F.G) {
        const int c = un >> 4, g = un & 15;
        if (g != gcur) {
            __syncthreads();
#pragma unroll
            for (int i = 0; i < 4; ++i) { const int q = tid + 512 * i, row = q >> 4, c8 = q & 15; *(LAS u32x4*)(WL + row * LDW + c8 * 8) = *(const u32x4*)(WSB + (size_t)g * 16384 + row * 128 + c8 * 8); }
#pragma unroll
            for (int e = 0; e < 8; ++e) { gam[e] = lng[g * 128 + cc * 8 + e]; bet[e] = lnb[g * 128 + cc * 8 + e]; }
            bsv[0] = bs[g * 128 + i0 + fr]; bsv[1] = bs[g * 128 + i0 + 16 + fr];
            gcur = g;
        }
        { float s_ = 0.f, q_ = 0.f;
#pragma unroll
          for (int i = 0; i < 4; ++i) { s_ += lnp[i][0] + lnp[i][2]; q_ += lnp[i][1] + lnp[i][3]; }
          s_ += __shfl_xor(s_, 1); s_ += __shfl_xor(s_, 2); q_ += __shfl_xor(q_, 1); q_ += __shfl_xor(q_, 2);
          const float mean = s_ * (1.f / 2048.f), var = q_ * (1.f / 2048.f) - mean * mean;
          if ((tid & 3) == 0) ST[tid >> 2] = (f32x2){mean, 1.0f / sqrtf(fmaxf(var, 0.f) + NORM_EPS)}; }
        __syncthreads();
#pragma unroll
        for (int i = 0; i < 4; ++i) { const int j = (tid + 512 * i) >> 4; float v[8]; unpack8(vraw[i], v);
            const f32x2 st = ST[j];
            for (int e = 0; e < 8; ++e) v[e] = (v[e] - st.x) * st.y * gam[e] + bet[e];
            u32x4 w; w.x = cvt_pk_bf16(v[0], v[1]); w.y = cvt_pk_bf16(v[2], v[3]); w.z = cvt_pk_bf16(v[4], v[5]); w.w = cvt_pk_bf16(v[6], v[7]);
            *(LAS u32x4*)(VL + j * LDW + cc * 8) = w; }
        __syncthreads();
        u32x2 uw[2][4];
#pragma unroll
        for (int mb = 0; mb < 2; ++mb) { const bf16_t* up = H + (size_t)(c * 128 + i0 + mb * 16 + fr) * FF + g * 128 + d0 + 4 * fq;
#pragma unroll
            for (int nb = 0; nb < 4; ++nb) uw[mb][nb] = *(const u32x2*)(up + nb * 16); }
        if (un + F.G < 2048) SP_PREF(un + F.G);
        f32x4 acc[2][4];
#pragma unroll
        for (int mb = 0; mb < 2; ++mb)
#pragma unroll
            for (int nb = 0; nb < 4; ++nb) acc[mb][nb] = (f32x4){0.f, 0.f, 0.f, 0.f};
#pragma unroll
        for (int kk = 0; kk < 4; ++kk) {
            bf16x8 wf[2], vf[4];
#pragma unroll
            for (int mb = 0; mb < 2; ++mb) wf[mb] = *(const LAS bf16x8*)(WL + (i0 + mb * 16 + fr) * LDW + kk * 32 + fq * 8);
#pragma unroll
            for (int nb = 0; nb < 4; ++nb) { const LAS bf16_t* p = VL + (kk * 32 + fq * 8) * LDW + d0 + nb * 16 + fr;
#pragma unroll
                for (int e = 0; e < 8; ++e) vf[nb][e] = (short)p[e * LDW]; }
#pragma unroll
            for (int mb = 0; mb < 2; ++mb)
#pragma unroll
                for (int nb = 0; nb < 4; ++nb) acc[mb][nb] = __builtin_amdgcn_mfma_f32_16x16x32_bf16(vf[nb], wf[mb], acc[mb][nb], 0, 0, 0);
        }
#pragma unroll
        for (int mb = 0; mb < 2; ++mb) { bf16_t* up = H + (size_t)(c * 128 + i0 + mb * 16 + fr) * FF + g * 128 + d0 + 4 * fq;
#pragma unroll
            for (int nb = 0; nb < 4; ++nb) { const f32x4 a = acc[mb][nb]; const u32x2 w = uw[mb][nb];
                const float o0 = (a[0] + bsv[mb]) * bf_lo(w.x), o1 = (a[1] + bsv[mb]) * bf_hi(w.x), o2 = (a[2] + bsv[mb]) * bf_lo(w.y), o3 = (a[3] + bsv[mb]) * bf_hi(w.y);
                *(u32x2*)(up + nb * 16) = (u32x2){cvt_pk_bf16(o0, o1), cvt_pk_bf16(o2, o3)}; } }
    }
#undef SP_PREF
    __syncthreads();
}

__device__ __forceinline__ void final_phase(Frame& F, const Args& A) {
    const int gw = blockIdx.x * NWAVES + F.wave, NGW = F.G * NWAVES, col = F.lane * 16;
    const bf16_t* XBp = (const bf16_t*)(F.ws + WS_XB);
    float gv[16];
#pragma unroll
    for (int i = 0; i < 16; ++i) gv[i] = A.in[3][col + i];
    for (int m = gw; m < M; m += NGW) {
        const u32x4 a = *(const u32x4*)(XBp + (size_t)m * D + col), b = *(const u32x4*)(XBp + (size_t)m * D + col + 8);
        float v[16]; { float t[8]; unpack8(a, t); for (int i = 0; i < 8; ++i) v[i] = t[i]; unpack8(b, t); for (int i = 0; i < 8; ++i) v[8 + i] = t[i]; }
        float s = 0.f;
#pragma unroll
        for (int i = 0; i < 16; ++i) s += v[i] * v[i];
        const float rs = 1.0f / sqrtf(wave_sum(s) * (1.f / D) + NORM_EPS);
        float* op = F.out + (size_t)m * D + col;
#pragma unroll
        for (int i = 0; i < 16; i += 4) *(f32x4*)(op + i) = (f32x4){v[i] * rs * gv[i], v[i + 1] * rs * gv[i + 1], v[i + 2] * rs * gv[i + 2], v[i + 3] * rs * gv[i + 3]};
    }
}

#define XB_TMO      128
#define XB_XCNT(j)  (256  + 64 * (j))
#define XB_XSUB(j)  (1280 + 64 * (j))
#define XB_XGEN(j)  (2304 + 64 * (j))
#define XB_TOP      3328
#define XB_TOPGEN   3392
#define XCD_BAR_WORDS 3456
#define XB_SPIN_CAP (1u << 18)
__device__ __forceinline__ unsigned xb_ld(unsigned* p)              { return __hip_atomic_load(p, __ATOMIC_RELAXED, __HIP_MEMORY_SCOPE_AGENT); }
__device__ __forceinline__ unsigned xb_add(unsigned* p, unsigned v) { return __hip_atomic_fetch_add(p, v, __ATOMIC_RELAXED, __HIP_MEMORY_SCOPE_AGENT); }
__device__ __forceinline__ unsigned xb_xcc_id() { return (unsigned)__builtin_amdgcn_s_getreg((3 << 11) | 20) & 0xFu; }
#define XB_SPIN(cond, bar) do { unsigned _sp = 0; while (cond) { __builtin_amdgcn_s_sleep(1); \
    if ((++_sp & 255u) == 0u) { if (xb_ld(&(bar)[XB_TMO])) break; if (_sp > XB_SPIN_CAP) { atomicAdd(&(bar)[XB_TMO], 1u); break; } } } } while (0)
struct XcdBarrier { unsigned* bar; unsigned x; volatile LAS unsigned* st; };
__device__ __forceinline__ XcdBarrier xcd_barrier_post(unsigned* bar, volatile LAS unsigned* st) {
    XcdBarrier b; b.bar = bar; b.x = xb_xcc_id(); b.st = st;
    if (threadIdx.x == 0) (void)xb_add(&bar[XB_XCNT(b.x)], 1u);
    return b;
}
__device__ __forceinline__ void xcd_barrier_complete(unsigned* bar, unsigned x, unsigned& nloc, unsigned& nx) {
    const unsigned G = gridDim.x * gridDim.y * gridDim.z;
    unsigned sum, cnt, mine, sp = 0u;
    for (;;) {
        sum = 0u; cnt = 0u; mine = 0u;
#pragma unroll
        for (unsigned j = 0; j < 16; ++j) { const unsigned c = xb_ld(&bar[XB_XCNT(j)]); sum += c; cnt += (c > 0u) ? 1u : 0u; mine = (j == x) ? c : mine; }
        if (sum == G) break;
        __builtin_amdgcn_s_sleep(1);
        if ((++sp & 255u) == 0u) { if (xb_ld(&bar[XB_TMO])) break; if (sp > XB_SPIN_CAP) { atomicAdd(&bar[XB_TMO], 1u); break; } }
    }
    nloc = mine > 0u ? mine : 1u; nx = cnt > 0u ? cnt : 1u;
}
__device__ __forceinline__ void xcd_barrier(const XcdBarrier& b) {
    asm volatile("s_waitcnt vmcnt(0)" ::: "memory");
    __syncthreads();
    if (threadIdx.x == 0) {
        unsigned* bar = b.bar;
        __builtin_amdgcn_s_waitcnt(0);
        unsigned nloc = b.st[0], nx = b.st[1];
        if (nloc == 0u) { xcd_barrier_complete(bar, b.x, nloc, nx); b.st[0] = nloc; b.st[1] = nx; }
        const unsigned old = xb_add(&bar[XB_XSUB(b.x)], 1u);
        const unsigned gen = old / nloc;
        if (old + 1u == (gen + 1u) * nloc) {
            __builtin_amdgcn_fence(__ATOMIC_RELEASE, "agent");
            asm volatile("s_waitcnt vmcnt(0)" ::: "memory");
            const unsigned og = xb_add(&bar[XB_TOP], 1u);
            const unsigned tg = og / nx;
            if (og + 1u == (tg + 1u) * nx) xb_add(&bar[XB_TOPGEN], 1u);
            else XB_SPIN(xb_ld(&bar[XB_TOPGEN]) == tg, bar);
            __builtin_amdgcn_fence(__ATOMIC_ACQUIRE, "agent");
            xb_add(&bar[XB_XGEN(b.x)], 1u);
            asm volatile("s_waitcnt vmcnt(0)" ::: "memory");
        } else {
            XB_SPIN(xb_ld(&bar[XB_XGEN(b.x)]) == gen, bar);
            __builtin_amdgcn_fence(__ATOMIC_ACQUIRE, "agent");
            asm volatile("s_waitcnt vmcnt(0)" ::: "memory");
        }
    }
    __syncthreads();
}

struct EpiFinal {
    const bf16_t* base; float* out; const float* g; float* ss; XcdBarrier xb;
    __device__ __forceinline__ void operator()(f32x4 (&acc)[2][2][4][2], const pg8::Unit& u, int ui, int wr, int wc, int fr, int fq) const {
        using namespace pg8;
        const int col0 = u.pn * BM + wc * 32 + 8 * fq;
#pragma unroll
        for (int ai = 0; ai < 2; ++ai)
#pragma unroll
            for (int m = 0; m < 4; ++m) { const int row = u.pm * BM + ai * HALF + wr * 64 + m * 16 + fr; const size_t off = (size_t)row * D + col0; float sq = 0.f;
#pragma unroll
                for (int bj = 0; bj < 2; ++bj) { const u32x4 w = *(const u32x4*)(base + off + bj * HALF); float t[8]; unpack8(w, t); const f32x4 b0 = {t[0], t[1], t[2], t[3]}, b1 = {t[4], t[5], t[6], t[7]};
                    const f32x4 v0 = acc[ai][bj][m][0] + b0, v1 = acc[ai][bj][m][1] + b1; acc[ai][bj][m][0] = v0; acc[ai][bj][m][1] = v1;
                    sq += (v0[0] * v0[0] + v0[1] * v0[1]) + (v0[2] * v0[2] + v0[3] * v0[3]) + (v1[0] * v1[0] + v1[1] * v1[1]) + (v1[2] * v1[2] + v1[3] * v1[3]); }
                sq += __shfl_xor(sq, 16); sq += __shfl_xor(sq, 32);
                if (fq == 0) ss[(size_t)row * 16 + u.pn * 4 + wc] = sq; if (m & 1) asm volatile("" ::: "memory"); }
        xcd_barrier(xb);
        f32x4 gv[2][2];
#pragma unroll
        for (int bj = 0; bj < 2; ++bj) { gv[bj][0] = *(const f32x4*)(g + col0 + bj * HALF); gv[bj][1] = *(const f32x4*)(g + col0 + bj * HALF + 4); }
#pragma unroll
        for (int ai = 0; ai < 2; ++ai)
#pragma unroll
            for (int m = 0; m < 4; ++m) { const int row = u.pm * BM + ai * HALF + wr * 64 + m * 16 + fr; const size_t off = (size_t)row * D + col0;
                const f32x4* p = (const f32x4*)(ss + (size_t)row * 16); const f32x4 t = (p[0] + p[1]) + (p[2] + p[3]);
                const float rs = 1.0f / sqrtf(((t[0] + t[1]) + (t[2] + t[3])) * (1.f / D) + NORM_EPS);
#pragma unroll
                for (int bj = 0; bj < 2; ++bj) { float* op = out + off + bj * HALF; *(f32x4*)op = acc[ai][bj][m][0] * rs * gv[bj][0]; *(f32x4*)(op + 4) = acc[ai][bj][m][1] * rs * gv[bj][1]; }
                if (m & 1) asm volatile("" ::: "memory"); }
    }
};

constexpr int NPHASE = 15;
__global__ void __launch_bounds__(NTHR, 2) fwd_kernel(Args args) {
    extern __shared__ __attribute__((aligned(16))) unsigned char lds_raw[];
    Frame F;
    F.lds = (LAS unsigned char*)lds_raw; F.tid = threadIdx.x; F.lane = F.tid & 63; F.wave = __builtin_amdgcn_readfirstlane(F.tid >> 6); F.G = gridDim.x;
    F.out = args.out; F.ws = args.ws;
    const int lo = args.ph_lo, hi = args.ph_hi;
    cg::grid_group grid = cg::this_grid();
    volatile LAS unsigned* MISC = (volatile LAS unsigned*)(F.lds + RING_BYTES + 512);
    if (F.tid < 2) MISC[F.tid] = 0u;
    __syncthreads();
    XcdBarrier xbar = xcd_barrier_post((unsigned*)(args.ws + WS_BAR), MISC);
#ifndef PHMASK
#define PHMASK 0x7fff
#endif
#define IN(k) (((PHMASK >> (k)) & 1) && lo <= (k) && (k) < hi)
#define SEAM(k) do { if (IN(k) && IN((k) + 1)) { if (hi > 1000) grid.sync(); else xcd_barrier(xbar); } } while (0)
    unsigned char* ws = args.ws;
    bf16_t* XB = (bf16_t*)(ws + WS_XB); bf16_t* HB = (bf16_t*)(ws + WS_H); float* SS = (float*)(ws + WS_SS);
    const LAS float* RS = (const LAS float*)(F.lds + RS_OFF);
    const int bx = blockIdx.x;

    if (IN(0)) { p0_phase(F, args); }
    SEAM(0);
    if (IN(1)) {
        __syncthreads();
        const bool bal = (F.G == 256);
        { pg8::Gemm g{(const bf16_t*)F.out, (const bf16_t*)(ws + WS_L1), M, 512, 2048, 2048, 1 << 20, 0}; pg8::StaticOrder S;
          if (bal) S.init_sub(M, 512, 128, bx >= 128 ? bx - 128 : -1, 0, 1); else S.init(M, 512, F.G, bx);
          pg8::EpiLora1 E{(bf16_t*)(ws + WS_A2), (bf16_t*)(ws + WS_SG)}; pg8::gemm_phase(F.lds, g, S, E); }
        { pg8::Gemm g{(const bf16_t*)(ws + WS_XR), (const bf16_t*)(ws + WS_WRKV), M, 3072, 1024, 1024, 4, (size_t)M * D * 2}; pg8::StaticOrder S;
          if (bal) { if (bx < 128) S.init_sub(M, 3072, 128, bx, 0, 4); else S.init_sub(M, 3072, 128, bx - 128, 512, 2); } else S.init(M, 3072, F.G, bx);
          pg8::EpiSplit E{(bf16_t*)(ws + WS_R), D, D, (size_t)M * D}; pg8::gemm_phase(F.lds, g, S, E); }
    }
    SEAM(1);
    if (IN(2)) {
        pg8::Gemm g{(const bf16_t*)(ws + WS_A2), (const bf16_t*)(ws + WS_L2), M, 4096, 128, 256, 8, 256}; pg8::StaticOrder S; S.init(M, 4096, F.G, bx);
        pg8::EpiLora2 E{(bf16_t*)F.out, (bf16_t*)(ws + WS_AA), args.in[9], args.in[12]}; pg8::gemm_phase(F.lds, g, S, E);
    }
    SEAM(2);
    if (IN(3)) { scan_phase<0>(F, args); }
    SEAM(3);
    if (IN(4)) { z_phase(F, args); }
    SEAM(4);
    if (IN(5)) {
        convB_phase(F, args); __syncthreads();
        pg8::Gemm g{(const bf16_t*)(ws + WS_SG), (const bf16_t*)(ws + WS_G2), M, 1024, 128, 256, 1 << 20, 0}; pg8::StaticOrder S; S.init(M, 1024, F.G, bx);
        pg8::EpiG E{(bf16_t*)(ws + WS_OD)}; pg8::gemm_phase(F.lds, g, S, E);
    }
    SEAM(5);
    if (IN(6)) {
        pg8::Gemm g{(const bf16_t*)(ws + WS_OD), (const bf16_t*)(ws + WS_WO), M, 1024, 1024, 1024, 1 << 20, 0}; pg8::StaticOrder S; S.init(M, 1024, F.G, bx);
        pg8::EpiRes<true> E{args.in[0], XB, SS}; pg8::gemm_phase(F.lds, g, S, E);
    }
    SEAM(6);
    if (IN(7)) {
        pg8::Gemm g{XB, (const bf16_t*)(ws + WS_W1_0), M, FF, 1024, 1024, 1 << 20, 0}; pg8::StaticOrder S; S.init(M, FF, F.G, bx);
        rs_table(F, S);
        pg8::EpiSq E{HB, RS}; pg8::gemm_phase(F.lds, g, S, E);
    }
    SEAM(7);
    if (IN(8)) {
        pg8::Gemm g{HB, (const bf16_t*)(ws + WS_W2_0), M, 1024, FF, FF, 1 << 20, 0}; pg8::StaticOrder S; S.init(M, 1024, F.G, bx);
        pg8::EpiRes<false> E{nullptr, XB, SS}; pg8::gemm_phase(F.lds, g, S, E);
    }
    SEAM(8);
    if (IN(9)) {
        pg8::Gemm g{XB, (const bf16_t*)(ws + WS_WIN), M, FF, 1024, 1024, 1 << 20, 0}; pg8::StaticOrder S; S.init(M, FF, F.G, bx);
        rs_table(F, S);
        pg8::EpiGelu E{HB, RS, (f32x2*)(ws + WS_LNP)}; pg8::gemm_phase(F.lds, g, S, E);
    }
    SEAM(9);
    if (IN(10)) { __syncthreads(); spatial_phase(F, args); }
    SEAM(10);
    if (IN(11)) {
        __syncthreads();
        pg8::Gemm g{HB, (const bf16_t*)(ws + WS_WOUT), M, 1024, 2048, FF, 1 << 20, 0}; pg8::StaticOrder S; S.init(M, 1024, F.G, bx);
        pg8::EpiRes<false> E{nullptr, XB, SS}; pg8::gemm_phase(F.lds, g, S, E);
    }
    SEAM(11);
    if (IN(12)) {
        pg8::Gemm g{XB, (const bf16_t*)(ws + WS_W1_1), M, FF, 1024, 1024, 1 << 20, 0}; pg8::StaticOrder S; S.init(M, FF, F.G, bx);
        rs_table(F, S);
        pg8::EpiSq E{HB, RS}; pg8::gemm_phase(F.lds, g, S, E);
    }
    SEAM(12);
    const bool fuse_final = IN(13) && IN(14) && F.G == 256;
    if (IN(13)) {
        pg8::Gemm g{HB, (const bf16_t*)(ws + WS_W2_1), M, 1024, FF, FF, 1 << 20, 0}; pg8::StaticOrder S; S.init(M, 1024, F.G, bx);
        if (fuse_final) { EpiFinal E{XB, F.out, args.in[3], SS, xbar}; pg8::gemm_phase(F.lds, g, S, E); }
        else { pg8::EpiRes<false> E{nullptr, XB, SS}; pg8::gemm_phase(F.lds, g, S, E); }
    }
    if (!fuse_final) { SEAM(13); }
    if (IN(14) && !fuse_final) { final_phase(F, args); }
}

extern "C" void kernel_launch(void* const* d_in, const int* in_sizes, int n_in, void* d_out, int out_size, void* d_ws, size_t ws_size, hipStream_t stream) {
    static int grid = 0;
    if (grid == 0) {
        if (n_in != 30 || out_size != M * D || ws_size < WS_END) { fprintf(stderr, "kernel_launch: unexpected shapes (n_in %d out %d ws %zu)\n", n_in, out_size, ws_size); grid = -1; return; }
        int dev = 0, cus = 0, per_cu = 0;
        (void)hipGetDevice(&dev); (void)hipDeviceGetAttribute(&cus, hipDeviceAttributeMultiprocessorCount, dev);
        (void)hipFuncSetAttribute((const void*)fwd_kernel, hipFuncAttributeMaxDynamicSharedMemorySize, LDS_BYTES);
        (void)hipOccupancyMaxActiveBlocksPerMultiprocessor(&per_cu, (const void*)fwd_kernel, NTHR, LDS_BYTES);
        if (per_cu < 1) { fprintf(stderr, "kernel_launch: occupancy query says %d blocks per CU\n", per_cu); per_cu = 1; }
        (void)hipGetLastError();
        grid = cus;
        if (grid > 256) grid = 256;
    }
    if (grid < 0) return;
    if (hipMemsetAsync((char*)d_ws + WS_BAR, 0, 16384, stream) != hipSuccess) { fprintf(stderr, "memset failed\n"); return; }
    Args a{};
    for (int i = 0; i < 30; ++i) a.in[i] = (const float*)d_in[i];
    a.out = (float*)d_out; a.ws = (unsigned char*)d_ws;
#if MK_SINGLE
    a.ph_lo = 0; a.ph_hi = NPHASE;
    void* kargs[] = {&a};
    hipError_t e = hipLaunchCooperativeKernel((const void*)fwd_kernel, dim3(grid), dim3(NTHR), kargs, LDS_BYTES, stream);
    if (e != hipSuccess) fprintf(stderr, "cooperative launch failed: %s (grid %d)\n", hipGetErrorString(e), grid);
#else
    for (int p = 0; p < NPHASE; ++p) { a.ph_lo = p; a.ph_hi = p + 1; hipLaunchKernelGGL(fwd_kernel, dim3(grid), dim3(NTHR), LDS_BYTES, stream, a); }
#endif
}
```

```cpp
#include <hip/hip_runtime.h>
#include <hip/hip_cooperative_groups.h>
#include <cstdio>
#include <cstdint>
namespace cg = cooperative_groups;

#ifndef MK_SINGLE
#define MK_SINGLE 1
#endif

#define LAS __attribute__((address_space(3)))
typedef unsigned short bf16_t;
typedef short bf16x8 __attribute__((ext_vector_type(8)));
typedef float f32x4 __attribute__((ext_vector_type(4)));
typedef float f32x2 __attribute__((ext_vector_type(2)));
typedef unsigned u32x4 __attribute__((ext_vector_type(4)));
typedef unsigned u32x2 __attribute__((ext_vector_type(2)));

constexpr int BATCH = 2, T = 8192, D = 1024, FF = 4096, M = BATCH * T;
constexpr int NWAVES = 8, NTHR = 512;
constexpr float NORM_EPS = 1e-5f, GN_EPS = 64e-5f;

constexpr size_t MiB = 1u << 20;
constexpr size_t WS_SS = 0;
constexpr size_t WS_BAR = 1 * MiB + 65536;
constexpr size_t WS_WRKV = 2 * MiB;
constexpr size_t WS_WO = 8 * MiB;
constexpr size_t WS_L1 = 10 * MiB;
constexpr size_t WS_L2 = 12 * MiB;
constexpr size_t WS_G2 = 14 * MiB;
constexpr size_t WS_R = 15 * MiB, WS_K = 47 * MiB, WS_V = 79 * MiB;
constexpr size_t WS_XR = 111 * MiB;
constexpr size_t WS_AA = 111 * MiB;
constexpr size_t WS_OD = 175 * MiB;
constexpr size_t WS_A2 = 239 * MiB;
constexpr size_t WS_SG = 247 * MiB;
constexpr size_t WS_DOT = 255 * MiB;
constexpr size_t WS_W1_0 = 15 * MiB, WS_W2_0 = 23 * MiB, WS_WIN = 31 * MiB, WS_WOUT = 39 * MiB, WS_WSB = 43 * MiB, WS_W1_1 = 44 * MiB, WS_W2_1 = 52 * MiB;
constexpr size_t WS_XB = 60 * MiB;
constexpr size_t WS_H = 92 * MiB;
constexpr size_t WS_LNP = 220 * MiB;
constexpr size_t WS_END = 256 * MiB;

constexpr int RING_BYTES = 131072, RS_OFF = RING_BYTES + 1024, LDS_BYTES = 147456;

__device__ __forceinline__ unsigned cvt_pk_bf16(float lo, float hi) { unsigned r; asm volatile("v_cvt_pk_bf16_f32 %0, %1, %2" : "=v"(r) : "v"(lo), "v"(hi)); return r; }
__device__ __forceinline__ float bf_lo(unsigned w) { return __builtin_bit_cast(float, w << 16); }
__device__ __forceinline__ float bf_hi(unsigned w) { return __builtin_bit_cast(float, w & 0xffff0000u); }
__device__ __forceinline__ float wave_sum(float v) {
#pragma unroll
    for (int o = 1; o < 64; o <<= 1) v += __shfl_xor(v, o);
    return v;
}
template <int CTRL> __device__ __forceinline__ float dpp_f(float x) { return __builtin_bit_cast(float, __builtin_amdgcn_update_dpp(0, __builtin_bit_cast(int, x), CTRL, 0xF, 0xF, true)); }
__device__ __forceinline__ float row16_allsum(float x) { x += dpp_f<0x128>(x); x += dpp_f<0x124>(x); x += dpp_f<0x122>(x); x += dpp_f<0x121>(x); return x; }
__device__ __forceinline__ float sigmoidf_(float x) { return __builtin_amdgcn_rcpf(1.0f + __expf(-x)); }
__device__ __forceinline__ float tanhf_(float x) { return 1.0f - 2.0f * __builtin_amdgcn_rcpf(__expf(2.0f * x) + 1.0f); }
__device__ __forceinline__ f32x2 gelu_pk(f32x2 v) {
    const f32x2 av = __builtin_elementwise_abs(v), d = av * 0.2316418882f + 1.0f;
    f32x2 t; t.x = __builtin_amdgcn_rcpf(d.x); t.y = __builtin_amdgcn_rcpf(d.y);
    f32x2 q = t * 0.5307027145f + (-0.7265760135f); q = q * t + 0.7107068705f; q = q * t + (-0.142248368f); q = q * t + 0.127414796f; q = q * t;
    const f32x2 s = (v * v) * (-0.72134752044f);
    f32x2 e; e.x = __builtin_amdgcn_exp2f(s.x); e.y = __builtin_amdgcn_exp2f(s.y);
    const f32x2 m = v * (q * e), r = v - m;
    f32x2 o; o.x = v.x < 0.f ? m.x : r.x; o.y = v.y < 0.f ? m.y : r.y; return o;
}
__device__ __forceinline__ u32x4 pack8(const f32x4 a, const f32x4 b) { u32x4 w; w.x = cvt_pk_bf16(a[0], a[1]); w.y = cvt_pk_bf16(a[2], a[3]); w.z = cvt_pk_bf16(b[0], b[1]); w.w = cvt_pk_bf16(b[2], b[3]); return w; }
__device__ __forceinline__ void unpack8(const u32x4 w, float (&f)[8]) { f[0] = bf_lo(w.x); f[1] = bf_hi(w.x); f[2] = bf_lo(w.y); f[3] = bf_hi(w.y); f[4] = bf_lo(w.z); f[5] = bf_hi(w.z); f[6] = bf_lo(w.w); f[7] = bf_hi(w.w); }

namespace pg8 {
constexpr int BM = 256, BK = 64, HALF = 128, HTB = HALF * BK * 2, NXCD = 8, WGM = 4;
__host__ __device__ __forceinline__ int lds_byte(int r, int c) { const int st = (r >> 4) * 2 + (c >> 5), rr = r & 15, cc = c & 31, ob = rr * 64 + cc * 2; return st * 1024 + (ob ^ (((ob >> 9) & 1) << 5)); }
__host__ __device__ __forceinline__ void stage_rc(int b, int& R, int& C) { const int st = b / 1024, sb = b % 1024, swz = sb ^ (((sb >> 9) & 1) << 5); R = (st >> 1) * 16 + swz / 64; C = (st & 1) * 32 + (swz % 64) / 2; }
__host__ __device__ __forceinline__ int perm32(int rho) { const int n = rho >> 4, i = rho & 15; return 8 * (i >> 2) + 4 * n + (i & 3); }

struct Unit { int pm, pn; };
struct Gemm { const bf16_t* A; const bf16_t* Bt; int M, N, K, lda; int agrp; size_t astride; };

struct StaticOrder {
    int nM, nN, nwg, G, c, L0, cnt;
    __host__ __device__ void init(int M_, int N_, int G_, int c_) { nM = M_ / BM; nN = N_ / BM; nwg = nM * nN; G = G_; c = c_; L0 = 0; cnt = 1 << 20; }
    __host__ __device__ void init_sub(int M_, int N_, int G_, int c_, int L0_, int cnt_) { init(M_, N_, G_, c_); L0 = L0_; cnt = cnt_; }
    __host__ __device__ bool next(int i, Unit& u) const {
        if (i >= cnt || c < 0) return false;
        const long L = (long)L0 + (long)i * G + c; if (L >= nwg) return false;
        int wgid = (int)L; { const int q = nwg / NXCD, r = nwg % NXCD, xcd = wgid % NXCD, off = wgid / NXCD; wgid = (xcd < r ? xcd * (q + 1) : r * (q + 1) + (xcd - r) * q) + off; }
        const int nig = WGM * nN, gid = wgid / nig, fm = gid * WGM, gsz = (nM - fm) < WGM ? (nM - fm) : WGM;
        u.pm = fm + ((wgid % nig) % gsz); u.pn = (wgid % nig) / gsz; return true;
    }
};

template <class Epi>
__device__ __forceinline__ void gemm_phase(LAS unsigned char* lds, const Gemm g, const StaticOrder& S, const Epi& E) {
    const int tid = threadIdx.x, wid = __builtin_amdgcn_readfirstlane(tid >> 6), lane = tid & 63, wr = wid >> 2, wc = wid & 3, fr = lane & 15, fq = lane >> 4;
    const int K = g.K, nt = K / BK;
    unsigned voffA[2], voffB[2];
#pragma unroll
    for (int i = 0; i < 2; ++i) { int R, C; stage_rc(tid * 16 + i * 8192, R, C); const int Rb = (R & ~31) + perm32(R & 31);
        voffA[i] = (unsigned)(R * g.lda + C) * 2u; voffB[i] = (unsigned)(Rb * K + C) * 2u; }
    const size_t kstep = (size_t)(BK * 2);
    const size_t hA = (size_t)HALF * g.lda * 2, tA = 2 * hA, hB = (size_t)HALF * K * 2, tB = 2 * hB;
    const unsigned ldsw = (unsigned)wid * 1024u;
    const int aoff = lds_byte(wr * 64 + fr, fq * 8), boff = lds_byte(wc * 32 + fr, fq * 8);
#define PG8_SA(b, h) (((b) * 2 + (h)) * HTB)
#define PG8_SB(b, h) ((4 + (b) * 2 + (h)) * HTB)
#define PG8_STAGE(bufoff, gbase, voff) do { _Pragma("unroll") for (int _i = 0; _i < 2; ++_i) \
        __builtin_amdgcn_global_load_lds((const unsigned*)((const char*)(gbase) + (voff)[_i]), (LAS unsigned*)(lds + (bufoff) + ldsw + _i * 8192), 16, 0, 0); } while (0)
#define PG8_LDA(dst, b, h) do { _Pragma("unroll") for (int m = 0; m < 4; ++m) _Pragma("unroll") for (int k = 0; k < 2; ++k) dst[m][k] = *(const LAS bf16x8*)(lds + PG8_SA(b, h) + aoff + m * 2048 + k * 1024); } while (0)
#define PG8_LDB(dst, b, h) do { _Pragma("unroll") for (int n = 0; n < 2; ++n) _Pragma("unroll") for (int k = 0; k < 2; ++k) dst[n][k] = *(const LAS bf16x8*)(lds + PG8_SB(b, h) + boff + n * 2048 + k * 1024); } while (0)
#define PG8_MMA(ai, bj, At, Bt) do { __builtin_amdgcn_s_setprio(1); _Pragma("unroll") for (int m = 0; m < 4; ++m) _Pragma("unroll") for (int n = 0; n < 2; ++n) _Pragma("unroll") for (int k = 0; k < 2; ++k) \
        acc[ai][bj][m][n] = __builtin_amdgcn_mfma_f32_16x16x32_bf16(Bt[n][k], At[m][k], acc[ai][bj][m][n], 0, 0, 0); __builtin_amdgcn_s_setprio(0); } while (0)
#define PG8_WAIT_V(n) asm volatile("s_waitcnt vmcnt(" #n ")" ::: "memory")
#define PG8_WAIT_L(n) asm volatile("s_waitcnt lgkmcnt(" #n ")" ::: "memory")
#define PG8_BAR __builtin_amdgcn_s_barrier()
#define PG8_SCHED __builtin_amdgcn_sched_barrier(0)
    Unit cur, nxt; int ui = 0;
    if (!S.next(0, cur)) return;
    f32x4 acc[2][2][4][2];
#pragma unroll
    for (int a = 0; a < 2; ++a)
#pragma unroll
        for (int b = 0; b < 2; ++b)
#pragma unroll
            for (int m = 0; m < 4; ++m)
#pragma unroll
                for (int n = 0; n < 2; ++n) acc[a][b][m][n] = (f32x4){0.f, 0.f, 0.f, 0.f};
    bf16x8 At[4][2], B0[2][2], B1[2][2];
    const char* cA = (const char*)g.A + (size_t)cur.pm * tA + (size_t)(cur.pn / g.agrp) * g.astride; const char* cB = (const char*)g.Bt + (size_t)cur.pn * tB;
    PG8_STAGE(PG8_SB(0, 0), cB, voffB); PG8_STAGE(PG8_SB(0, 1), cB + hB, voffB); PG8_STAGE(PG8_SA(0, 0), cA, voffA); PG8_STAGE(PG8_SA(0, 1), cA + hA, voffA);
    if (wr == 1) PG8_BAR;
    PG8_WAIT_V(2); PG8_BAR;
    PG8_STAGE(PG8_SB(1, 0), cB + kstep, voffB); PG8_STAGE(PG8_SA(1, 0), cA + kstep, voffA); PG8_STAGE(PG8_SB(1, 1), cB + hB + kstep, voffB);
    PG8_WAIT_V(6); PG8_BAR;
    for (;;) {
        const bool has_next = S.next(ui + 1, nxt);
        const char* nA = has_next ? (const char*)g.A + (size_t)nxt.pm * tA + (size_t)(nxt.pn / g.agrp) * g.astride : cA; const char* nB = has_next ? (const char*)g.Bt + (size_t)nxt.pn * tB : cB;
#pragma nounroll
        for (int t = 0; t < nt; t += 2) {
            const bool last = (t == nt - 2);
            const char* a1 = cA + (size_t)(t + 1) * kstep;
            const char* a2 = last ? nA : cA + (size_t)(t + 2) * kstep; const char* b2 = last ? nB : cB + (size_t)(t + 2) * kstep;
            const char* a3 = a2 + kstep; const char* b3 = b2 + kstep;
            PG8_LDB(B0, 0, 0); PG8_LDB(B1, 0, 1); PG8_SCHED; PG8_LDA(At, 0, 0); PG8_STAGE(PG8_SA(1, 1), a1 + hA, voffA);
            PG8_WAIT_V(8); PG8_WAIT_L(0); PG8_BAR; PG8_MMA(0, 0, At, B0); PG8_MMA(0, 1, At, B1); PG8_BAR; PG8_SCHED;
            PG8_LDA(At, 0, 1); PG8_STAGE(PG8_SB(0, 0), b2, voffB); PG8_STAGE(PG8_SB(0, 1), b2 + hB, voffB); PG8_STAGE(PG8_SA(0, 0), a2, voffA);
            PG8_WAIT_V(8); PG8_WAIT_L(0); PG8_BAR; PG8_MMA(1, 0, At, B0); PG8_MMA(1, 1, At, B1); PG8_BAR; PG8_SCHED;
            PG8_LDB(B0, 1, 0); PG8_LDB(B1, 1, 1); PG8_SCHED; PG8_LDA(At, 1, 0); PG8_STAGE(PG8_SA(0, 1), a2 + hA, voffA);
            PG8_WAIT_V(8); PG8_WAIT_L(0); PG8_BAR; PG8_MMA(0, 0, At, B0); PG8_MMA(0, 1, At, B1); PG8_BAR; PG8_SCHED;
            PG8_LDA(At, 1, 1); PG8_STAGE(PG8_SB(1, 0), b3, voffB); PG8_STAGE(PG8_SB(1, 1), b3 + hB, voffB); PG8_STAGE(PG8_SA(1, 0), a3, voffA);
            PG8_WAIT_V(8); PG8_WAIT_L(0); PG8_BAR; PG8_MMA(1, 0, At, B0); PG8_MMA(1, 1, At, B1); PG8_BAR; PG8_SCHED;
        }
        if (wr == 0) PG8_BAR;
        E(acc, cur, ui, wr, wc, fr, fq);
        if (!has_next) break;
#pragma unroll
        for (int a = 0; a < 2; ++a)
#pragma unroll
            for (int b = 0; b < 2; ++b)
#pragma unroll
                for (int m = 0; m < 4; ++m)
#pragma unroll
                    for (int n = 0; n < 2; ++n) acc[a][b][m][n] = (f32x4){0.f, 0.f, 0.f, 0.f};
        cur = nxt; cA = nA; cB = nB; ++ui;
        if (wr == 1) PG8_BAR;
    }
    PG8_WAIT_V(0);
    PG8_BAR;
#undef PG8_SA
#undef PG8_SB
#undef PG8_STAGE
#undef PG8_LDA
#undef PG8_LDB
#undef PG8_MMA
#undef PG8_WAIT_V
#undef PG8_WAIT_L
#undef PG8_BAR
#undef PG8_SCHED
}

#define EPI_ARGS const f32x4 (&acc)[2][2][4][2], const Unit& u, int ui, int wr, int wc, int fr, int fq
#define EPI_ROWS for (int ai = 0; ai < 2; ++ai) _Pragma("unroll") for (int m = 0; m < 4; ++m)
struct EpiSplit {
    bf16_t* O; int ldc; int split_cols; size_t split_stride;
    __device__ __forceinline__ void operator()(EPI_ARGS) const {
        int colt = u.pn * BM; const int t = colt / split_cols; bf16_t* base = O + (size_t)t * split_stride; colt -= t * split_cols;
        const int col0 = colt + wc * 32 + 8 * fq;
#pragma unroll
        EPI_ROWS { bf16_t* rowp = base + (size_t)(u.pm * BM + ai * HALF + wr * 64 + m * 16 + fr) * ldc + col0;
#pragma unroll
            for (int bj = 0; bj < 2; ++bj) *(u32x4*)(rowp + bj * HALF) = pack8(acc[ai][bj][m][0], acc[ai][bj][m][1]); }
    }
};
struct EpiLora1 {
    bf16_t* A2; bf16_t* SG;
    __device__ __forceinline__ void operator()(EPI_ARGS) const {
        bf16_t* base = u.pn == 0 ? A2 : SG; const int col0 = wc * 32 + 8 * fq;
#pragma unroll
        EPI_ROWS { bf16_t* rowp = base + (size_t)(u.pm * BM + ai * HALF + wr * 64 + m * 16 + fr) * 256 + col0;
            f32x4 v0 = acc[ai][0][m][0], v1 = acc[ai][0][m][1];
            if (u.pn == 0) { for (int e = 0; e < 4; ++e) { v0[e] = tanhf_(v0[e]); v1[e] = tanhf_(v1[e]); } }
            else { for (int e = 0; e < 4; ++e) { v0[e] = sigmoidf_(v0[e]); v1[e] = sigmoidf_(v1[e]); } }
            *(u32x4*)(rowp) = pack8(v0, v1);
            f32x4 w0 = acc[ai][1][m][0], w1 = acc[ai][1][m][1];
            if (u.pn != 0) { w0 = (f32x4){0.f, 0.f, 0.f, 0.f}; w1 = w0; }
            *(u32x4*)(rowp + HALF) = pack8(w0, w1); }
    }
};
struct EpiLora2 {
    bf16_t* EW; bf16_t* AA; const float* w0; const float* a0;
    __device__ __forceinline__ void operator()(EPI_ARGS) const {
        const int grp = u.pn >> 2, c0 = (u.pn & 3) * BM + wc * 32 + 8 * fq;
        const float* bias = (grp < 2 ? w0 + grp * D : a0 + (grp - 2) * D) + c0;
        bf16_t* base = (grp < 2 ? EW + (size_t)grp * M * D : AA + (size_t)(grp - 2) * M * D) + c0;
        const float sc = grp < 2 ? 0.60653065971f : 1.0f;
#pragma unroll
        EPI_ROWS { bf16_t* rowp = base + (size_t)(u.pm * BM + ai * HALF + wr * 64 + m * 16 + fr) * D;
#pragma unroll
            for (int bj = 0; bj < 2; ++bj) { f32x4 v0 = acc[ai][bj][m][0] + *(const f32x4*)(bias + bj * HALF), v1 = acc[ai][bj][m][1] + *(const f32x4*)(bias + bj * HALF + 4);
                for (int e = 0; e < 4; ++e) { v0[e] = sigmoidf_(v0[e]) * sc; v1[e] = sigmoidf_(v1[e]) * sc; }
                *(u32x4*)(rowp + bj * HALF) = pack8(v0, v1); } if (m & 1) asm volatile("" ::: "memory"); }
    }
};
struct EpiG {
    bf16_t* Z;
    __device__ __forceinline__ void operator()(EPI_ARGS) const {
        const int col0 = u.pn * BM + wc * 32 + 8 * fq;
#pragma unroll
        EPI_ROWS { bf16_t* rowp = Z + (size_t)(u.pm * BM + ai * HALF + wr * 64 + m * 16 + fr) * D + col0;
#pragma unroll
            for (int bj = 0; bj < 2; ++bj) { const u32x4 zw = *(const u32x4*)(rowp + bj * HALF); float z[8]; unpack8(zw, z);
                f32x4 v0 = acc[ai][bj][m][0], v1 = acc[ai][bj][m][1];
                for (int e = 0; e < 4; ++e) { v0[e] *= z[e]; v1[e] *= z[4 + e]; }
                *(u32x4*)(rowp + bj * HALF) = pack8(v0, v1); } if (m & 1) asm volatile("" ::: "memory"); }
    }
};
template <bool BASE_F32> struct EpiRes {
    const float* basef; bf16_t* xb; float* ss;
    __device__ __forceinline__ void operator()(EPI_ARGS) const {
        const int col0 = u.pn * BM + wc * 32 + 8 * fq;
#pragma unroll
        EPI_ROWS { const int row = u.pm * BM + ai * HALF + wr * 64 + m * 16 + fr; const size_t off = (size_t)row * D + col0; float sq = 0.f;
#pragma unroll
            for (int bj = 0; bj < 2; ++bj) { f32x4 b0, b1;
                if (BASE_F32) { const float* bp = basef + off + bj * HALF; b0 = *(const f32x4*)bp; b1 = *(const f32x4*)(bp + 4); }
                else { const u32x4 w = *(const u32x4*)(xb + off + bj * HALF); float t[8]; unpack8(w, t); b0 = (f32x4){t[0], t[1], t[2], t[3]}; b1 = (f32x4){t[4], t[5], t[6], t[7]}; }
                const f32x4 v0 = acc[ai][bj][m][0] + b0, v1 = acc[ai][bj][m][1] + b1;
                *(u32x4*)(xb + off + bj * HALF) = pack8(v0, v1);
                sq += (v0[0] * v0[0] + v0[1] * v0[1]) + (v0[2] * v0[2] + v0[3] * v0[3]) + (v1[0] * v1[0] + v1[1] * v1[1]) + (v1[2] * v1[2] + v1[3] * v1[3]); }
            sq += __shfl_xor(sq, 16); sq += __shfl_xor(sq, 32);
            if (fq == 0) ss[(size_t)row * 16 + u.pn * 4 + wc] = sq; if (m & 1) asm volatile("" ::: "memory"); }
    }
};
struct EpiSq {
    bf16_t* H; const LAS float* RS;
    __device__ __forceinline__ void operator()(EPI_ARGS) const {
        const int col0 = u.pn * BM + wc * 32 + 8 * fq;
#pragma unroll
        EPI_ROWS { const int rl = ai * HALF + wr * 64 + m * 16 + fr; const float rs = RS[ui * 256 + rl]; bf16_t* rowp = H + (size_t)(u.pm * BM + rl) * FF + col0;
#pragma unroll
            for (int bj = 0; bj < 2; ++bj) { f32x4 v0 = acc[ai][bj][m][0] * rs, v1 = acc[ai][bj][m][1] * rs;
                for (int e = 0; e < 4; ++e) { const float a = fmaxf(v0[e], 0.f), b = fmaxf(v1[e], 0.f); v0[e] = a * a; v1[e] = b * b; }
                *(u32x4*)(rowp + bj * HALF) = pack8(v0, v1); } }
    }
};
struct EpiGelu {
    bf16_t* H; const LAS float* RS; f32x2* LNP;
    __device__ __forceinline__ void operator()(EPI_ARGS) const {
        const int col0 = u.pn * BM + wc * 32 + 8 * fq;
#pragma unroll
        EPI_ROWS { const int rl = ai * HALF + wr * 64 + m * 16 + fr; const float rs = RS[ui * 256 + rl]; const int row = u.pm * BM + rl; bf16_t* rowp = H + (size_t)row * FF + col0; float s = 0.f, q = 0.f;
#pragma unroll
            for (int bj = 0; bj < 2; ++bj) { f32x4 v0 = acc[ai][bj][m][0] * rs, v1 = acc[ai][bj][m][1] * rs;
                const f32x2 g0 = gelu_pk((f32x2){v0[0], v0[1]}), g1 = gelu_pk((f32x2){v0[2], v0[3]}), g2 = gelu_pk((f32x2){v1[0], v1[1]}), g3 = gelu_pk((f32x2){v1[2], v1[3]});
                v0 = (f32x4){g0.x, g0.y, g1.x, g1.y}; v1 = (f32x4){g2.x, g2.y, g3.x, g3.y};
                s += (v0[0] + v0[1]) + (v0[2] + v0[3]) + (v1[0] + v1[1]) + (v1[2] + v1[3]);
                q += (v0[0] * v0[0] + v0[1] * v0[1]) + (v0[2] * v0[2] + v0[3] * v0[3]) + (v1[0] * v1[0] + v1[1] * v1[1]) + (v1[2] * v1[2] + v1[3] * v1[3]);
                *(u32x4*)(rowp + bj * HALF) = pack8(v0, v1); }
            if (u.pn >= 8) { s += __shfl_xor(s, 16); s += __shfl_xor(s, 32); q += __shfl_xor(q, 16); q += __shfl_xor(q, 32);
                if (fq == 0) LNP[(size_t)row * 32 + (u.pn - 8) * 4 + wc] = (f32x2){s, q}; } }
    }
};
}

struct Args { const float* in[30]; float* out; unsigned char* ws; int ph_lo, ph_hi; };
struct Frame {
    LAS unsigned char* lds;
    int tid, lane, wave, G;
    float* out; unsigned char* ws;
};
#define LDS_WAIT() asm volatile("s_waitcnt lgkmcnt(0)" ::: "memory")

__device__ __forceinline__ void tr_item(const float* W, int ldw, bf16_t* WT, int ldt, int drow0, int dcol0, const float* ks, LAS float* scr, int k0, int n0, int lane) {
    { const int kr = lane >> 3, n4 = 4 * (lane & 7); f32x4 v[8];
#pragma unroll
      for (int i = 0; i < 8; ++i) v[i] = *(const f32x4*)(W + (size_t)(k0 + kr + 8 * i) * ldw + n0 + n4);
#pragma unroll
      for (int i = 0; i < 8; ++i) { const int kk = kr + 8 * i; f32x4 x = v[i]; if (ks) x = x * ks[k0 + kk]; LAS float* d = scr + kk * 33 + n4; d[0] = x[0]; d[1] = x[1]; d[2] = x[2]; d[3] = x[3]; } }
    LDS_WAIT(); asm volatile("" ::: "memory");
    const int c = lane & 7;
#pragma unroll
    for (int j = 0; j < 4; ++j) { const int n = (lane >> 3) + 8 * j; const LAS float* s = scr + (8 * c) * 33 + n;
        u32x4 o; o.x = cvt_pk_bf16(s[0 * 33], s[1 * 33]); o.y = cvt_pk_bf16(s[2 * 33], s[3 * 33]); o.z = cvt_pk_bf16(s[4 * 33], s[5 * 33]); o.w = cvt_pk_bf16(s[6 * 33], s[7 * 33]);
        *(u32x4*)(WT + (size_t)(drow0 + n0 + n) * ldt + dcol0 + k0 + 8 * c) = o; }
    LDS_WAIT(); asm volatile("" ::: "memory");
}
__device__ __forceinline__ void zero_item(bf16_t* WT, int ldt, int row0, int col0, int lane) {
#pragma unroll
    for (int j = 0; j < 4; ++j) { const int q = lane + 64 * j, r = q >> 3, c = q & 7; *(u32x4*)(WT + (size_t)(row0 + r) * ldt + col0 + 8 * c) = (u32x4){0u, 0u, 0u, 0u}; }
}
#define TR_MAT(W, KK, NN, WT, LDT, DR, DC, KS) { const int _n = ((KK) / 64) * ((NN) / 32); if (r < _n) { const int _nb = (NN) / 32; tr_item(W, NN, WT, LDT, DR, DC, KS, scr, 64 * (r / _nb), 32 * (r % _nb), F.lane); continue; } r -= _n; }

__device__ __forceinline__ void p0_phase(Frame& F, const Args& A) {
    LAS float* scr = (LAS float*)(F.lds + F.wave * 16384);
    const int gw = blockIdx.x * NWAVES + F.wave, NGW = F.G * NWAVES;
    bf16_t* WRKV = (bf16_t*)(F.ws + WS_WRKV); bf16_t* WO = (bf16_t*)(F.ws + WS_WO); bf16_t* L1 = (bf16_t*)(F.ws + WS_L1); bf16_t* L2 = (bf16_t*)(F.ws + WS_L2); bf16_t* G2 = (bf16_t*)(F.ws + WS_G2);
    const float* mu = A.in[4];
    constexpr int NZ1 = 128, NZ2 = 128;
    constexpr int NTOT = 4 * 512 + 2 * (4 * 32 + 64) + 4 * 32 + 64 + NZ1 + NZ2;
    for (int it = gw; it < NTOT; it += NGW) {
        int r = it;
        TR_MAT(A.in[5], 1024, 1024, WRKV, 1024, 0, 0, nullptr)
        TR_MAT(A.in[6], 1024, 1024, WRKV, 1024, 1024, 0, nullptr)
        TR_MAT(A.in[7], 1024, 1024, WRKV, 1024, 2048, 0, nullptr)
        TR_MAT(A.in[8], 1024, 1024, WO, 1024, 0, 0, nullptr)
        TR_MAT(A.in[10], 1024, 64, L1, 2048, 0, 0, nullptr)
        TR_MAT(A.in[10] + 1024 * 64, 1024, 64, L1, 2048, 64, 0, nullptr)
        TR_MAT(A.in[13], 1024, 64, L1, 2048, 128, 0, nullptr)
        TR_MAT(A.in[13] + 1024 * 64, 1024, 64, L1, 2048, 192, 0, nullptr)
        TR_MAT(A.in[15], 1024, 128, L1, 2048, 256, 0, nullptr)
        TR_MAT(A.in[10], 1024, 64, L1, 2048, 0, 1024, mu + 1 * D)
        TR_MAT(A.in[10] + 1024 * 64, 1024, 64, L1, 2048, 64, 1024, mu + 1 * D)
        TR_MAT(A.in[13], 1024, 64, L1, 2048, 128, 1024, mu + 4 * D)
        TR_MAT(A.in[13] + 1024 * 64, 1024, 64, L1, 2048, 192, 1024, mu + 4 * D)
        TR_MAT(A.in[15], 1024, 128, L1, 2048, 256, 1024, mu + 5 * D)
        TR_MAT(A.in[11], 64, 1024, L2, 128, 0, 0, nullptr)
        TR_MAT(A.in[11] + 64 * 1024, 64, 1024, L2, 128, 1024, 64, nullptr)
        TR_MAT(A.in[14], 64, 1024, L2, 128, 2048, 0, nullptr)
        TR_MAT(A.in[14] + 64 * 1024, 64, 1024, L2, 128, 3072, 64, nullptr)
        TR_MAT(A.in[16], 128, 1024, G2, 128, 0, 0, nullptr)
        if (r < NZ1) { zero_item(L1, 2048, 384 + 32 * (r / 32), 64 * (r % 32), F.lane); continue; } r -= NZ1;
        { const int grp = r / 32; zero_item(L2, 128, 32 * r, 64 * (1 - (grp & 1)), F.lane); }
    }
    const float* x = A.in[0]; const float* gn = A.in[1];
    bf16_t* XNXX = (bf16_t*)F.out; bf16_t* XR = (bf16_t*)(F.ws + WS_XR);
    f32x4 gv[4], m0[4], m2[4], m3[4];
#pragma unroll
    for (int j = 0; j < 4; ++j) { gv[j] = ((const f32x4*)gn)[64 * j + F.lane]; m0[j] = ((const f32x4*)mu)[64 * j + F.lane]; m2[j] = ((const f32x4*)(mu + 2 * D))[64 * j + F.lane]; m3[j] = ((const f32x4*)(mu + 3 * D))[64 * j + F.lane]; }
    for (int m = gw; m < M; m += NGW) {
        const int t = m & (T - 1); const bool hp = t > 0, hn = t < T - 1;
        const f32x4* xc = (const f32x4*)(x + (size_t)m * D) + F.lane; const f32x4* xp = xc - D / 4; const f32x4* xq = xc + D / 4;
        f32x4 vc[4], vp[4], vn[4]; float sc = 0.f, sp = 0.f, sn = 0.f; const f32x4 z4 = {0.f, 0.f, 0.f, 0.f};
#pragma unroll
        for (int j = 0; j < 4; ++j) { vc[j] = xc[64 * j]; vp[j] = hp ? xp[64 * j] : z4; vn[j] = hn ? xq[64 * j] : z4;
            sc += (vc[j].x * vc[j].x + vc[j].y * vc[j].y) + (vc[j].z * vc[j].z + vc[j].w * vc[j].w);
            sp += (vp[j].x * vp[j].x + vp[j].y * vp[j].y) + (vp[j].z * vp[j].z + vp[j].w * vp[j].w);
            sn += (vn[j].x * vn[j].x + vn[j].y * vn[j].y) + (vn[j].z * vn[j].z + vn[j].w * vn[j].w); }
        const float rc = 1.0f / sqrtf(wave_sum(sc) * (1.f / D) + NORM_EPS), rp = 1.0f / sqrtf(wave_sum(sp) * (1.f / D) + NORM_EPS), rn = 1.0f / sqrtf(wave_sum(sn) * (1.f / D) + NORM_EPS);
#pragma unroll
        for (int j = 0; j < 4; ++j) { const int col = 4 * (64 * j + F.lane);
            const f32x4 a = vc[j] * rc * gv[j], xx = (vp[j] * rp + vn[j] * rn) * gv[j] * 0.5f - a;
            const f32x4 vr = a + xx * m0[j], vk = a + xx * m2[j], vv = a + xx * m3[j];
            *(u32x2*)(XNXX + (size_t)m * 2048 + col) = (u32x2){cvt_pk_bf16(a[0], a[1]), cvt_pk_bf16(a[2], a[3])};
            *(u32x2*)(XNXX + (size_t)m * 2048 + 1024 + col) = (u32x2){cvt_pk_bf16(xx[0], xx[1]), cvt_pk_bf16(xx[2], xx[3])};
            *(u32x2*)(XR + (size_t)m * D + col) = (u32x2){cvt_pk_bf16(vr[0], vr[1]), cvt_pk_bf16(vr[2], vr[3])};
            *(u32x2*)(XR + (size_t)M * D + (size_t)m * D + col) = (u32x2){cvt_pk_bf16(vk[0], vk[1]), cvt_pk_bf16(vk[2], vk[3])};
            *(u32x2*)(XR + 2 * (size_t)M * D + (size_t)m * D + col) = (u32x2){cvt_pk_bf16(vv[0], vv[1]), cvt_pk_bf16(vv[2], vv[3])}; }
    }
}

__device__ __forceinline__ void convB_phase(Frame& F, const Args& A) {
    LAS float* scr = (LAS float*)(F.lds + F.wave * 16384);
    const int gw = blockIdx.x * NWAVES + F.wave, NGW = F.G * NWAVES;
    bf16_t* W1_0 = (bf16_t*)(F.ws + WS_W1_0); bf16_t* W2_0 = (bf16_t*)(F.ws + WS_W2_0); bf16_t* WIN = (bf16_t*)(F.ws + WS_WIN); bf16_t* WOUT = (bf16_t*)(F.ws + WS_WOUT);
    bf16_t* WSB = (bf16_t*)(F.ws + WS_WSB); bf16_t* W1_1 = (bf16_t*)(F.ws + WS_W1_1); bf16_t* W2_1 = (bf16_t*)(F.ws + WS_W2_1);
    constexpr int NTOT = 5 * 2048 + 1024 + 512;
    for (int it = gw; it < NTOT; it += NGW) {
        int r = it;
        TR_MAT(A.in[28], 1024, 4096, W1_0, 1024, 0, 0, A.in[2])
        TR_MAT(A.in[29], 4096, 1024, W2_0, 4096, 0, 0, nullptr)
        TR_MAT(A.in[22], 1024, 4096, WIN, 1024, 0, 0, A.in[1] + D)
        TR_MAT(A.in[28] + (size_t)D * FF, 1024, 4096, W1_1, 1024, 0, 0, A.in[2] + D)
        TR_MAT(A.in[29] + (size_t)D * FF, 4096, 1024, W2_1, 4096, 0, 0, nullptr)
        TR_MAT(A.in[27], 2048, 1024, WOUT, 2048, 0, 0, nullptr)
        { const float* s = A.in[25] + (size_t)r * 512 + F.lane * 8; const f32x4 a = *(const f32x4*)s, b = *(const f32x4*)(s + 4); *(u32x4*)(WSB + (size_t)r * 512 + F.lane * 8) = pack8(a, b); }
    }
}

constexpr int TC = 16, NCH = T / TC, SREC = 336;
template <int VAR>
__device__ __forceinline__ void scan_phase(Frame& F, const Args& A) {
    LAS float* BUF = (LAS float*)(F.lds);
    LAS float* OP = (LAS float*)(F.lds + 4 * TC * SREC * 4);
    LAS unsigned* FL = (LAS unsigned*)(F.lds + 4 * TC * SREC * 4 + 2 * TC * 256 * 4);
    const int tid = F.tid, lane = F.lane, wave = F.wave;
    const bool prod = wave >= 4; const int ptid = tid - 256;
    const bf16_t* Rg = (const bf16_t*)(F.ws + WS_R); const bf16_t* Kg = (const bf16_t*)(F.ws + WS_K); const bf16_t* Vg = (const bf16_t*)(F.ws + WS_V);
    const bf16_t* EWg = (const bf16_t*)F.out; const bf16_t* AAg = (const bf16_t*)(F.ws + WS_AA); bf16_t* ODg = (bf16_t*)(F.ws + WS_OD);
    for (int it0 = blockIdx.x; it0 < 256; it0 += F.G) {
        const int item = (F.G == 256) ? ((it0 & 7) * 32 + (it0 >> 3)) : it0;
        const int chain = item >> 2, quarter = item & 3, dir = chain & 1, bh = chain >> 1, b = bh >> 4, h = bh & 15, row0 = quarter * 16;
        const size_t boff = (size_t)b * T * D + h * 64;
        const bf16_t* Rp = Rg + boff; const bf16_t* Kp = Kg + boff; const bf16_t* Vp = Vg + boff;
        const bf16_t* Ep = EWg + (size_t)dir * M * D + boff; const bf16_t* Ap = AAg + (size_t)dir * M * D + boff; bf16_t* Op = ODg + (size_t)dir * M * D + boff + row0;
        const int pw = wave - 4, tq = lane >> 4, c4 = (lane & 15) * 4;
        u32x2 raw[4][5];
#pragma unroll
        for (int j = 0; j < 4; ++j) for (int q = 0; q < 5; ++q) raw[j][q] = (u32x2){0u, 0u};
        f32x4 kk4 = {0, 0, 0, 0}, ka4 = {0, 0, 0, 0}, rk4 = {0, 0, 0, 0};
        if (prod) { kk4 = *(const f32x4*)(A.in[17] + h * 64 + c4); ka4 = *(const f32x4*)(A.in[18] + h * 64 + c4); rk4 = *(const f32x4*)(A.in[19] + h * 64 + c4); }
        asm volatile("s_waitcnt vmcnt(0)" : "+v"(kk4), "+v"(ka4), "+v"(rk4) :: "memory");
        bf16_t* Dp = (bf16_t*)(F.ws + WS_DOT) + ((size_t)dir * M + (size_t)b * T) * 16 + h;
#define SC_LOAD(c) do { _Pragma("unroll") for (int j = 0; j < 4; ++j) { const int step = (c) * TC + tq + 4 * j; const int tt = dir ? (T - 1 - step) : step; const size_t o = (size_t)tt * D + c4; \
        raw[j][0] = *(const u32x2*)(Rp + o); raw[j][1] = *(const u32x2*)(Kp + o); raw[j][2] = *(const u32x2*)(Vp + o); raw[j][3] = *(const u32x2*)(Ep + o); raw[j][4] = *(const u32x2*)(Ap + o); } } while (0)
#define SC_PROC(c) do { _Pragma("unroll") for (int j = 0; j < 4; ++j) { const int tl = tq + 4 * j; const u32x2 rr = raw[j][0], rk = raw[j][1], rv = raw[j][2], re = raw[j][3], ra = raw[j][4]; \
        const f32x4 r4 = {bf_lo(rr.x), bf_hi(rr.x), bf_lo(rr.y), bf_hi(rr.y)}, k4 = {bf_lo(rk.x), bf_hi(rk.x), bf_lo(rk.y), bf_hi(rk.y)}, v4 = {bf_lo(rv.x), bf_hi(rv.x), bf_lo(rv.y), bf_hi(rv.y)}; \
        const f32x4 e4 = {bf_lo(re.x), bf_hi(re.x), bf_lo(re.y), bf_hi(re.y)}, a4 = {bf_lo(ra.x), bf_hi(ra.x), bf_lo(ra.y), bf_hi(ra.y)}; \
        f32x4 kk = k4 * kk4; float ss = (kk[0] * kk[0] + kk[1] * kk[1]) + (kk[2] * kk[2] + kk[3] * kk[3]); ss = row16_allsum(ss); \
        const float inv = __builtin_amdgcn_rsqf(fmaxf(ss, 1e-24f)); kk = kk * inv; \
        f32x4 dec; dec[0] = __expf(-e4[0]); dec[1] = __expf(-e4[1]); dec[2] = __expf(-e4[2]); dec[3] = __expf(-e4[3]); \
        const f32x4 kd = k4 * (1.0f + (a4 - 1.0f) * ka4); \
        { const f32x4 pr_ = r4 * kd * rk4; float dt = (pr_[0] + pr_[1]) + (pr_[2] + pr_[3]); dt = row16_allsum(dt); \
          if (quarter == 0 && (lane & 15) == 0) { const int step_ = (c) * TC + tl; const int tt_ = dir ? (T - 1 - step_) : step_; Dp[(size_t)tt_ * 16] = (bf16_t)(cvt_pk_bf16(dt, 0.f) & 0xffffu); } } \
        LAS float* dst = BUF + ((c) & 3) * TC * SREC + tl * SREC + c4; \
        *(LAS f32x4*)(dst) = dec; *(LAS f32x4*)(dst + 64) = -kk; *(LAS f32x4*)(dst + 128) = kk * a4; *(LAS f32x4*)(dst + 192) = kd; *(LAS f32x4*)(dst + 256) = r4; \
        if ((c4 >> 4) == quarter) *(LAS f32x4*)(BUF + ((c) & 3) * TC * SREC + tl * SREC + 320 + c4 - row0) = v4; } } while (0)
#define SC_RED(c, ok) do { const int row = lane & 15; const LAS float* src = OP + ((c) & 1) * TC * 256 + tq * 1024 + ((row >> 2) * 64 + (row & 3) * 16) * 4; \
        f32x4 o4 = {0.f, 0.f, 0.f, 0.f}; \
        _Pragma("unroll") for (int j = 0; j < 16; ++j) o4 += *(const LAS f32x4*)(src + (((j + row) & 15) << 2));     \
        _Pragma("unroll") for (int e = 0; e < 4; ++e) { const int step = (c) * TC + 4 * tq + e; const int tt = dir ? (T - 1 - step) : step; \
            if (ok) Op[(size_t)tt * D + row] = (bf16_t)(cvt_pk_bf16(o4[e], 0.f) & 0xffffu); } } while (0)
#define SC_SPIN_GE(p_, v_) do { unsigned n_ = 0; while (*(volatile LAS unsigned*)(p_) < (unsigned)(v_)) { __builtin_amdgcn_s_sleep(1); if (++n_ > (1u << 22)) break; } asm volatile("" ::: "memory"); } while (0)
        if (tid < 16) FL[tid] = 0u;
        __syncthreads();
        if (prod) {
            SC_LOAD(pw);
#pragma nounroll
            for (int m = 0; m < NCH / 4; ++m) {
                const int k = pw + 4 * m;
                SC_PROC(k);
                asm volatile("s_waitcnt lgkmcnt(0)" ::: "memory");
                if (lane == 0) *(volatile LAS unsigned*)(FL + pw) = (unsigned)(m + 1);
                { const int kl = (k + 4 < NCH) ? k + 4 : NCH - 1; SC_LOAD(kl); }
                SC_SPIN_GE(FL + 4 + pw, 4 * (m + 1));
                SC_RED(k, true);
                asm volatile("s_waitcnt lgkmcnt(0)" ::: "memory");
                if (lane == 0) (void)__hip_atomic_fetch_add(FL + 8 + (k & 1), 1u, __ATOMIC_RELAXED, __HIP_MEMORY_SCOPE_WORKGROUP);
            }
        } else {
            f32x2 S01 = {0.f, 0.f}, S23 = {0.f, 0.f};
            const int ks = lane & 15, rl = lane >> 4;
            unsigned fl_rdy = 0u, fl_red = 0u;
#pragma nounroll
            for (int c = 0; c < NCH; ++c) {
                if (fl_rdy < (unsigned)((c >> 2) + 1)) SC_SPIN_GE(FL + (c & 3), (c >> 2) + 1);
                if (c >= 2 && fl_red < (unsigned)(c >> 1)) SC_SPIN_GE(FL + 8 + (c & 1), c >> 1);
                const LAS float* bp = BUF + (c & 3) * TC * SREC + ks * 4; const LAS float* vp = BUF + (c & 3) * TC * SREC + 320 + wave * 4 + rl;
                LAS float* op = OP + (c & 1) * TC * 256 + tid * 4;
                f32x4 oq = {0.f, 0.f, 0.f, 0.f};
                constexpr int PD = 2;
                f32x4 pw_[PD], pa_[PD], pb_[PD], pk_[PD], pr_[PD]; float pv_[PD];
#pragma unroll
                for (int j = 0; j < PD; ++j) { const LAS float* q = bp + j * SREC; pw_[j] = *(const LAS f32x4*)(q); pa_[j] = *(const LAS f32x4*)(q + 64); pb_[j] = *(const LAS f32x4*)(q + 128); pk_[j] = *(const LAS f32x4*)(q + 192); pr_[j] = *(const LAS f32x4*)(q + 256); pv_[j] = vp[j * SREC]; }
#pragma unroll
                for (int i = 0; i < TC; ++i) {
                    const int sl = i % PD;
                    const f32x4 w = pw_[sl], a = pa_[sl], bb = pb_[sl], k = pk_[sl], r = pr_[sl]; const float v = pv_[sl];
                    if (i == 10) { fl_rdy = *(volatile LAS unsigned*)(FL + ((c + 1) & 3)); fl_red = *(volatile LAS unsigned*)(FL + 8 + ((c + 1) & 1)); }
                    if (i + PD < TC) { const LAS float* q = bp + (i + PD) * SREC; pw_[sl] = *(const LAS f32x4*)(q); pa_[sl] = *(const LAS f32x4*)(q + 64); pb_[sl] = *(const LAS f32x4*)(q + 128); pk_[sl] = *(const LAS f32x4*)(q + 192); pr_[sl] = *(const LAS f32x4*)(q + 256); pv_[sl] = vp[(i + PD) * SREC]; }
                    f32x2 p = S01 * (f32x2){a[0], a[1]}; p = S23 * (f32x2){a[2], a[3]} + p;
                    float sa = p.x + p.y; sa = row16_allsum(sa);
                    const f32x2 vk01 = (f32x2){k[0], k[1]} * v, vk23 = (f32x2){k[2], k[3]} * v;
                    const f32x2 t01 = (f32x2){bb[0], bb[1]} * sa + vk01, t23 = (f32x2){bb[2], bb[3]} * sa + vk23;
                    S01 = S01 * (f32x2){w[0], w[1]} + t01; S23 = S23 * (f32x2){w[2], w[3]} + t23;
                    f32x2 q2 = S01 * (f32x2){r[0], r[1]}; q2 = S23 * (f32x2){r[2], r[3]} + q2;
                    oq[i & 3] = q2.x + q2.y; if ((i & 3) == 3) *(LAS f32x4*)(op + (i >> 2) * 1024) = oq;
                }
                asm volatile("s_waitcnt lgkmcnt(0)" ::: "memory");
                if (lane == 0) (void)__hip_atomic_fetch_add(FL + 4 + (c & 3), 1u, __ATOMIC_RELAXED, __HIP_MEMORY_SCOPE_WORKGROUP);
            }
        }
        __syncthreads();
#undef SC_SPIN_GE
#undef SC_LOAD
#undef SC_PROC
#undef SC_RED
    }
}

__device__ __forceinline__ void z_phase(Frame& F, const Args& A) {
    const int gw = blockIdx.x * NWAVES + F.wave, NGW = F.G * NWAVES, col = F.lane * 16;
    const bf16_t* Rg = (const bf16_t*)(F.ws + WS_R); const bf16_t* Kg = (const bf16_t*)(F.ws + WS_K); const bf16_t* Vg = (const bf16_t*)(F.ws + WS_V);
    const bf16_t* A0 = (const bf16_t*)(F.ws + WS_AA); const bf16_t* A1 = A0 + (size_t)M * D; bf16_t* OF = (bf16_t*)(F.ws + WS_OD); const bf16_t* OB = OF + (size_t)M * D;
    float lg[16], lb[16];
#pragma unroll
    for (int i = 0; i < 16; ++i) { lg[i] = A.in[20][col + i]; lb[i] = A.in[21][col + i]; }
    for (int m = gw; m < M; m += NGW) {
        const size_t o = (size_t)m * D + col;
        float of[16], ob[16], v[16];
#define LD16(dst, P) { const u32x4 _a = *(const u32x4*)((P) + o), _b = *(const u32x4*)((P) + o + 8); float _t[8]; unpack8(_a, _t); for (int i = 0; i < 8; ++i) dst[i] = _t[i]; unpack8(_b, _t); for (int i = 0; i < 8; ++i) dst[8 + i] = _t[i]; }
        LD16(of, OF) LD16(ob, OB) LD16(v, Vg)
#undef LD16
        const bf16_t* DT = (const bf16_t*)(F.ws + WS_DOT) + (size_t)m * 16 + (F.lane >> 2);
        const float dot = __builtin_bit_cast(float, (unsigned)DT[0] << 16) + __builtin_bit_cast(float, (unsigned)DT[(size_t)M * 16] << 16);
        float s = 0.f;
#pragma unroll
        for (int i = 0; i < 16; ++i) { of[i] += ob[i]; s += of[i]; }
        s += __shfl_xor(s, 1); s += __shfl_xor(s, 2);
        const float mean = s * (1.f / 64.f); float q = 0.f;
#pragma unroll
        for (int i = 0; i < 16; ++i) { of[i] -= mean; q += of[i] * of[i]; }
        q += __shfl_xor(q, 1); q += __shfl_xor(q, 2);
        const float rstd = 1.0f / sqrtf(q * (1.f / 64.f) + GN_EPS);
        float z[16];
#pragma unroll
        for (int i = 0; i < 16; ++i) z[i] = of[i] * rstd * lg[i] + lb[i] + dot * v[i];
        u32x4 w0, w1; w0.x = cvt_pk_bf16(z[0], z[1]); w0.y = cvt_pk_bf16(z[2], z[3]); w0.z = cvt_pk_bf16(z[4], z[5]); w0.w = cvt_pk_bf16(z[6], z[7]);
        w1.x = cvt_pk_bf16(z[8], z[9]); w1.y = cvt_pk_bf16(z[10], z[11]); w1.z = cvt_pk_bf16(z[12], z[13]); w1.w = cvt_pk_bf16(z[14], z[15]);
        *(u32x4*)(OF + o) = w0; *(u32x4*)(OF + o + 8) = w1;
    }
}

__device__ __forceinline__ void rs_table(Frame& F, const pg8::StaticOrder& S) {
    LAS float* RS = (LAS float*)(F.lds + RS_OFF); const float* SS = (const float*)(F.ws + WS_SS);
    pg8::Unit u;
    for (int i = 0; i < 8 && S.next(i, u); ++i) {
        if (F.tid < 256) { const f32x4* p = (const f32x4*)(SS + (size_t)(u.pm * 256 + F.tid) * 16); const f32x4 a = p[0], b = p[1], c = p[2], d = p[3]; const f32x4 t = (a + b) + (c + d);
            RS[i * 256 + F.tid] = 1.0f / sqrtf(((t[0] + t[1]) + (t[2] + t[3])) * (1.f / D) + NORM_EPS); }
    }
    __syncthreads();
}

__device__ __forceinline__ void spatial_phase(Frame& F, const Args& A) {
    constexpr int LDW = 136;
    LAS bf16_t* WL = (LAS bf16_t*)(F.lds); LAS bf16_t* VL = (LAS bf16_t*)(F.lds + 128 * LDW * 2); LAS f32x2* ST = (LAS f32x2*)(F.lds + 2 * 128 * LDW * 2);
    bf16_t* H = (bf16_t*)(F.ws + WS_H); const bf16_t* WSB = (const bf16_t*)(F.ws + WS_WSB); const f32x2* LNP = (const f32x2*)(F.ws + WS_LNP);
    const float* lng = A.in[23]; const float* lnb = A.in[24]; const float* bs = A.in[26];
    const int tid = F.tid, lane = F.lane, wave = F.wave, fr = lane & 15, fq = lane >> 4;
    const int i0 = (wave >> 1) * 32, d0 = (wave & 1) * 64, cc = tid & 15;
    int gcur = -1; float gam[8], bet[8], bsv[2];
#pragma unroll
    for (int e = 0; e < 8; ++e) { gam[e] = 0.f; bet[e] = 0.f; }
    bsv[0] = bsv[1] = 0.f;
    u32x4 vraw[4]; f32x4 lnp[4];
#define SP_PREF(un_) do { const int c_ = (un_) >> 4, g_ = (un_) & 15; \
        _Pragma("unroll") for (int i = 0; i < 4; ++i) { const int j = (tid + 512 * i) >> 4; vraw[i] = *(const u32x4*)(H + (size_t)(c_ * 128 + j) * FF + 2048 + g_ * 128 + cc * 8); } \
        const f32x4* p_ = (const f32x4*)(LNP + (size_t)(c_ * 128 + (tid >> 2)) * 32) + (tid & 3) * 4; \
        _Pragma("unroll") for (int i = 0; i < 4; ++i) lnp[i] = p_[i]; } while (0)
    int un = blockIdx.x;
    if (un < 2048) SP_PREF(un);
    for (; un < 2048; un += F.G) {
        const int c = un >> 4, g = un & 15;
        if (g != gcur) {
            __syncthreads();
#pragma unroll
            for (int i = 0; i < 4; ++i) { const int q = tid + 512 * i, row = q >> 4, c8 = q & 15; *(LAS u32x4*)(WL + row * LDW + c8 * 8) = *(const u32x4*)(WSB + (size_t)g * 16384 + row * 128 + c8 * 8); }
#pragma unroll
            for (int e = 0; e < 8; ++e) { gam[e] = lng[g * 128 + cc * 8 + e]; bet[e] = lnb[g * 128 + cc * 8 + e]; }
            bsv[0] = bs[g * 128 + i0 + fr]; bsv[1] = bs[g * 128 + i0 + 16 + fr];
            gcur = g;
        }
        { float s_ = 0.f, q_ = 0.f;
#pragma unroll
          for (int i = 0; i < 4; ++i) { s_ += lnp[i][0] + lnp[i][2]; q_ += lnp[i][1] + lnp[i][3]; }
          s_ += __shfl_xor(s_, 1); s_ += __shfl_xor(s_, 2); q_ += __shfl_xor(q_, 1); q_ += __shfl_xor(q_, 2);
          const float mean = s_ * (1.f / 2048.f), var = q_ * (1.f / 2048.f) - mean * mean;
          if ((tid & 3) == 0) ST[tid >> 2] = (f32x2){mean, 1.0f / sqrtf(fmaxf(var, 0.f) + NORM_EPS)}; }
        __syncthreads();
#pragma unroll
        for (int i = 0; i < 4; ++i) { const int j = (tid + 512 * i) >> 4; float v[8]; unpack8(vraw[i], v);
            const f32x2 st = ST[j];
            for (int e = 0; e < 8; ++e) v[e] = (v[e] - st.x) * st.y * gam[e] + bet[e];
            u32x4 w; w.x = cvt_pk_bf16(v[0], v[1]); w.y = cvt_pk_bf16(v[2], v[3]); w.z = cvt_pk_bf16(v[4], v[5]); w.w = cvt_pk_bf16(v[6], v[7]);
            *(LAS u32x4*)(VL + j * LDW + cc * 8) = w; }
        __syncthreads();
        u32x2 uw[2][4];
#pragma unroll
        for (int mb = 0; mb < 2; ++mb) { const bf16_t* up = H + (size_t)(c * 128 + i0 + mb * 16 + fr) * FF + g * 128 + d0 + 4 * fq;
#pragma unroll
            for (int nb = 0; nb < 4; ++nb) uw[mb][nb] = *(const u32x2*)(up + nb * 16); }
        if (un + F.G < 2048) SP_PREF(un + F.G);
        f32x4 acc[2][4];
#pragma unroll
        for (int mb = 0; mb < 2; ++mb)
#pragma unroll
            for (int nb = 0; nb < 4; ++nb) acc[mb][nb] = (f32x4){0.f, 0.f, 0.f, 0.f};
#pragma unroll
        for (int kk = 0; kk < 4; ++kk) {
            bf16x8 wf[2], vf[4];
#pragma unroll
            for (int mb = 0; mb < 2; ++mb) wf[mb] = *(const LAS bf16x8*)(WL + (i0 + mb * 16 + fr) * LDW + kk * 32 + fq * 8);
#pragma unroll
            for (int nb = 0; nb < 4; ++nb) { const LAS bf16_t* p = VL + (kk * 32 + fq * 8) * LDW + d0 + nb * 16 + fr;
#pragma unroll
                for (int e = 0; e < 8; ++e) vf[nb][e] = (short)p[e * LDW]; }
#pragma unroll
            for (int mb = 0; mb < 2; ++mb)
#pragma unroll
                for (int nb = 0; nb < 4; ++nb) acc[mb][nb] = __builtin_amdgcn_mfma_f32_16x16x32_bf16(vf[nb], wf[mb], acc[mb][nb], 0, 0, 0);
        }
#pragma unroll
        for (int mb = 0; mb < 2; ++mb) { bf16_t* up = H + (size_t)(c * 128 + i0 + mb * 16 + fr) * FF + g * 128 + d0 + 4 * fq;
#pragma unroll
            for (int nb = 0; nb < 4; ++nb) { const f32x4 a = acc[mb][nb]; const u32x2 w = uw[mb][nb];
                const float o0 = (a[0] + bsv[mb]) * bf_lo(w.x), o1 = (a[1] + bsv[mb]) * bf_hi(w.x), o2 = (a[2] + bsv[mb]) * bf_lo(w.y), o3 = (a[3] + bsv[mb]) * bf_hi(w.y);
                *(u32x2*)(up + nb * 16) = (u32x2){cvt_pk_bf16(o0, o1), cvt_pk_bf16(o2, o3)}; } }
    }
#undef SP_PREF
    __syncthreads();
}

__device__ __forceinline__ void final_phase(Frame& F, const Args& A) {
    const int gw = blockIdx.x * NWAVES + F.wave, NGW = F.G * NWAVES, col = F.lane * 16;
    const bf16_t* XBp = (const bf16_t*)(F.ws + WS_XB);
    float gv[16];
#pragma unroll
    for (int i = 0; i < 16; ++i) gv[i] = A.in[3][col + i];
    for (int m = gw; m < M; m += NGW) {
        const u32x4 a = *(const u32x4*)(XBp + (size_t)m * D + col), b = *(const u32x4*)(XBp + (size_t)m * D + col + 8);
        float v[16]; { float t[8]; unpack8(a, t); for (int i = 0; i < 8; ++i) v[i] = t[i]; unpack8(b, t); for (int i = 0; i < 8; ++i) v[8 + i] = t[i]; }
        float s = 0.f;
#pragma unroll
        for (int i = 0; i < 16; ++i) s += v[i] * v[i];
        const float rs = 1.0f / sqrtf(wave_sum(s) * (1.f / D) + NORM_EPS);
        float* op = F.out + (size_t)m * D + col;
#pragma unroll
        for (int i = 0; i < 16; i += 4) *(f32x4*)(op + i) = (f32x4){v[i] * rs * gv[i], v[i + 1] * rs * gv[i + 1], v[i + 2] * rs * gv[i + 2], v[i + 3] * rs * gv[i + 3]};
    }
}

#define XB_TMO      128
#define XB_XCNT(j)  (256  + 64 * (j))
#define XB_XSUB(j)  (1280 + 64 * (j))
#define XB_XGEN(j)  (2304 + 64 * (j))
#define XB_TOP      3328
#define XB_TOPGEN   3392
#define XCD_BAR_WORDS 3456
#define XB_SPIN_CAP (1u << 18)
__device__ __forceinline__ unsigned xb_ld(unsigned* p)              { return __hip_atomic_load(p, __ATOMIC_RELAXED, __HIP_MEMORY_SCOPE_AGENT); }
__device__ __forceinline__ unsigned xb_add(unsigned* p, unsigned v) { return __hip_atomic_fetch_add(p, v, __ATOMIC_RELAXED, __HIP_MEMORY_SCOPE_AGENT); }
__device__ __forceinline__ unsigned xb_xcc_id() { return (unsigned)__builtin_amdgcn_s_getreg((3 << 11) | 20) & 0xFu; }
#define XB_SPIN(cond, bar) do { unsigned _sp = 0; while (cond) { __builtin_amdgcn_s_sleep(1); \
    if ((++_sp & 255u) == 0u) { if (xb_ld(&(bar)[XB_TMO])) break; if (_sp > XB_SPIN_CAP) { atomicAdd(&(bar)[XB_TMO], 1u); break; } } } } while (0)
struct XcdBarrier { unsigned* bar; unsigned x; volatile LAS unsigned* st; };
__device__ __forceinline__ XcdBarrier xcd_barrier_post(unsigned* bar, volatile LAS unsigned* st) {
    XcdBarrier b; b.bar = bar; b.x = xb_xcc_id(); b.st = st;
    if (threadIdx.x == 0) (void)xb_add(&bar[XB_XCNT(b.x)], 1u);
    return b;
}
__device__ __forceinline__ void xcd_barrier_complete(unsigned* bar, unsigned x, unsigned& nloc, unsigned& nx) {
    const unsigned G = gridDim.x * gridDim.y * gridDim.z;
    unsigned sum, cnt, mine, sp = 0u;
    for (;;) {
        sum = 0u; cnt = 0u; mine = 0u;
#pragma unroll
        for (unsigned j = 0; j < 16; ++j) { const unsigned c = xb_ld(&bar[XB_XCNT(j)]); sum += c; cnt += (c > 0u) ? 1u : 0u; mine = (j == x) ? c : mine; }
        if (sum == G) break;
        __builtin_amdgcn_s_sleep(1);
        if ((++sp & 255u) == 0u) { if (xb_ld(&bar[XB_TMO])) break; if (sp > XB_SPIN_CAP) { atomicAdd(&bar[XB_TMO], 1u); break; } }
    }
    nloc = mine > 0u ? mine : 1u; nx = cnt > 0u ? cnt : 1u;
}
__device__ __forceinline__ void xcd_barrier(const XcdBarrier& b) {
    asm volatile("s_waitcnt vmcnt(0)" ::: "memory");
    __syncthreads();
    if (threadIdx.x == 0) {
        unsigned* bar = b.bar;
        __builtin_amdgcn_s_waitcnt(0);
        unsigned nloc = b.st[0], nx = b.st[1];
        if (nloc == 0u) { xcd_barrier_complete(bar, b.x, nloc, nx); b.st[0] = nloc; b.st[1] = nx; }
        const unsigned old = xb_add(&bar[XB_XSUB(b.x)], 1u);
        const unsigned gen = old / nloc;
        if (old + 1u == (gen + 1u) * nloc) {
            __builtin_amdgcn_fence(__ATOMIC_RELEASE, "agent");
            asm volatile("s_waitcnt vmcnt(0)" ::: "memory");
            const unsigned og = xb_add(&bar[XB_TOP], 1u);
            const unsigned tg = og / nx;
            if (og + 1u == (tg + 1u) * nx) xb_add(&bar[XB_TOPGEN], 1u);
            else XB_SPIN(xb_ld(&bar[XB_TOPGEN]) == tg, bar);
            __builtin_amdgcn_fence(__ATOMIC_ACQUIRE, "agent");
            xb_add(&bar[XB_XGEN(b.x)], 1u);
            asm volatile("s_waitcnt vmcnt(0)" ::: "memory");
        } else {
            XB_SPIN(xb_ld(&bar[XB_XGEN(b.x)]) == gen, bar);
            __builtin_amdgcn_fence(__ATOMIC_ACQUIRE, "agent");
            asm volatile("s_waitcnt vmcnt(0)" ::: "memory");
        }
    }
    __syncthreads();
}

struct EpiFinal {
    const bf16_t* base; float* out; const float* g; float* ss; XcdBarrier xb;
    __device__ __forceinline__ void operator()(f32x4 (&acc)[2][2][4][2], const pg8::Unit& u, int ui, int wr, int wc, int fr, int fq) const {
        using namespace pg8;
        const int col0 = u.pn * BM + wc * 32 + 8 * fq;
#pragma unroll
        for (int ai = 0; ai < 2; ++ai)
#pragma unroll
            for (int m = 0; m < 4; ++m) { const int row = u.pm * BM + ai * HALF + wr * 64 + m * 16 + fr; const size_t off = (size_t)row * D + col0; float sq = 0.f;
#pragma unroll
                for (int bj = 0; bj < 2; ++bj) { const u32x4 w = *(const u32x4*)(base + off + bj * HALF); float t[8]; unpack8(w, t); const f32x4 b0 = {t[0], t[1], t[2], t[3]}, b1 = {t[4], t[5], t[6], t[7]};
                    const f32x4 v0 = acc[ai][bj][m][0] + b0, v1 = acc[ai][bj][m][1] + b1; acc[ai][bj][m][0] = v0; acc[ai][bj][m][1] = v1;
                    sq += (v0[0] * v0[0] + v0[1] * v0[1]) + (v0[2] * v0[2] + v0[3] * v0[3]) + (v1[0] * v1[0] + v1[1] * v1[1]) + (v1[2] * v1[2] + v1[3] * v1[3]); }
                sq += __shfl_xor(sq, 16); sq += __shfl_xor(sq, 32);
                if (fq == 0) ss[(size_t)row * 16 + u.pn * 4 + wc] = sq; if (m & 1) asm volatile("" ::: "memory"); }
        xcd_barrier(xb);
        f32x4 gv[2][2];
#pragma unroll
        for (int bj = 0; bj < 2; ++bj) { gv[bj][0] = *(const f32x4*)(g + col0 + bj * HALF); gv[bj][1] = *(const f32x4*)(g + col0 + bj * HALF + 4); }
#pragma unroll
        for (int ai = 0; ai < 2; ++ai)
#pragma unroll
            for (int m = 0; m < 4; ++m) { const int row = u.pm * BM + ai * HALF + wr * 64 + m * 16 + fr; const size_t off = (size_t)row * D + col0;
                const f32x4* p = (const f32x4*)(ss + (size_t)row * 16); const f32x4 t = (p[0] + p[1]) + (p[2] + p[3]);
                const float rs = 1.0f / sqrtf(((t[0] + t[1]) + (t[2] + t[3])) * (1.f / D) + NORM_EPS);
#pragma unroll
                for (int bj = 0; bj < 2; ++bj) { float* op = out + off + bj * HALF; *(f32x4*)op = acc[ai][bj][m][0] * rs * gv[bj][0]; *(f32x4*)(op + 4) = acc[ai][bj][m][1] * rs * gv[bj][1]; }
                if (m & 1) asm volatile("" ::: "memory"); }
    }
};

constexpr int NPHASE = 15;
__global__ void __launch_bounds__(NTHR, 2) fwd_kernel(Args args) {
    extern __shared__ __attribute__((aligned(16))) unsigned char lds_raw[];
    Frame F;
    F.lds = (LAS unsigned char*)lds_raw; F.tid = threadIdx.x; F.lane = F.tid & 63; F.wave = __builtin_amdgcn_readfirstlane(F.tid >> 6); F.G = gridDim.x;
    F.out = args.out; F.ws = args.ws;
    const int lo = args.ph_lo, hi = args.ph_hi;
    cg::grid_group grid = cg::this_grid();
    volatile LAS unsigned* MISC = (volatile LAS unsigned*)(F.lds + RING_BYTES + 512);
    if (F.tid < 2) MISC[F.tid] = 0u;
    __syncthreads();
    XcdBarrier xbar = xcd_barrier_post((unsigned*)(args.ws + WS_BAR), MISC);
#ifndef PHMASK
#define PHMASK 0x7fff
#endif
#define IN(k) (((PHMASK >> (k)) & 1) && lo <= (k) && (k) < hi)
#define SEAM(k) do { if (IN(k) && IN((k) + 1)) { if (hi > 1000) grid.sync(); else xcd_barrier(xbar); } } while (0)
    unsigned char* ws = args.ws;
    bf16_t* XB = (bf16_t*)(ws + WS_XB); bf16_t* HB = (bf16_t*)(ws + WS_H); float* SS = (float*)(ws + WS_SS);
    const LAS float* RS = (const LAS float*)(F.lds + RS_OFF);
    const int bx = blockIdx.x;

    if (IN(0)) { p0_phase(F, args); }
    SEAM(0);
    if (IN(1)) {
        __syncthreads();
        const bool bal = (F.G == 256);
        { pg8::Gemm g{(const bf16_t*)F.out, (const bf16_t*)(ws + WS_L1), M, 512, 2048, 2048, 1 << 20, 0}; pg8::StaticOrder S;
          if (bal) S.init_sub(M, 512, 128, bx >= 128 ? bx - 128 : -1, 0, 1); else S.init(M, 512, F.G, bx);
          pg8::EpiLora1 E{(bf16_t*)(ws + WS_A2), (bf16_t*)(ws + WS_SG)}; pg8::gemm_phase(F.lds, g, S, E); }
        { pg8::Gemm g{(const bf16_t*)(ws + WS_XR), (const bf16_t*)(ws + WS_WRKV), M, 3072, 1024, 1024, 4, (size_t)M * D * 2}; pg8::StaticOrder S;
          if (bal) { if (bx < 128) S.init_sub(M, 3072, 128, bx, 0, 4); else S.init_sub(M, 3072, 128, bx - 128, 512, 2); } else S.init(M, 3072, F.G, bx);
          pg8::EpiSplit E{(bf16_t*)(ws + WS_R), D, D, (size_t)M * D}; pg8::gemm_phase(F.lds, g, S, E); }
    }
    SEAM(1);
    if (IN(2)) {
        pg8::Gemm g{(const bf16_t*)(ws + WS_A2), (const bf16_t*)(ws + WS_L2), M, 4096, 128, 256, 8, 256}; pg8::StaticOrder S; S.init(M, 4096, F.G, bx);
        pg8::EpiLora2 E{(bf16_t*)F.out, (bf16_t*)(ws + WS_AA), args.in[9], args.in[12]}; pg8::gemm_phase(F.lds, g, S, E);
    }
    SEAM(2);
    if (IN(3)) { scan_phase<0>(F, args); }
    SEAM(3);
    if (IN(4)) { z_phase(F, args); }
    SEAM(4);
    if (IN(5)) {
        convB_phase(F, args); __syncthreads();
        pg8::Gemm g{(const bf16_t*)(ws + WS_SG), (const bf16_t*)(ws + WS_G2), M, 1024, 128, 256, 1 << 20, 0}; pg8::StaticOrder S; S.init(M, 1024, F.G, bx);
        pg8::EpiG E{(bf16_t*)(ws + WS_OD)}; pg8::gemm_phase(F.lds, g, S, E);
    }
    SEAM(5);
    if (IN(6)) {
        pg8::Gemm g{(const bf16_t*)(ws + WS_OD), (const bf16_t*)(ws + WS_WO), M, 1024, 1024, 1024, 1 << 20, 0}; pg8::StaticOrder S; S.init(M, 1024, F.G, bx);
        pg8::EpiRes<true> E{args.in[0], XB, SS}; pg8::gemm_phase(F.lds, g, S, E);
    }
    SEAM(6);
    if (IN(7)) {
        pg8::Gemm g{XB, (const bf16_t*)(ws + WS_W1_0), M, FF, 1024, 1024, 1 << 20, 0}; pg8::StaticOrder S; S.init(M, FF, F.G, bx);
        rs_table(F, S);
        pg8::EpiSq E{HB, RS}; pg8::gemm_phase(F.lds, g, S, E);
    }
    SEAM(7);
    if (IN(8)) {
        pg8::Gemm g{HB, (const bf16_t*)(ws + WS_W2_0), M, 1024, FF, FF, 1 << 20, 0}; pg8::StaticOrder S; S.init(M, 1024, F.G, bx);
        pg8::EpiRes<false> E{nullptr, XB, SS}; pg8::gemm_phase(F.lds, g, S, E);
    }
    SEAM(8);
    if (IN(9)) {
        pg8::Gemm g{XB, (const bf16_t*)(ws + WS_WIN), M, FF, 1024, 1024, 1 << 20, 0}; pg8::StaticOrder S; S.init(M, FF, F.G, bx);
        rs_table(F, S);
        pg8::EpiGelu E{HB, RS, (f32x2*)(ws + WS_LNP)}; pg8::gemm_phase(F.lds, g, S, E);
    }
    SEAM(9);
    if (IN(10)) { __syncthreads(); spatial_phase(F, args); }
    SEAM(10);
    if (IN(11)) {
        __syncthreads();
        pg8::Gemm g{HB, (const bf16_t*)(ws + WS_WOUT), M, 1024, 2048, FF, 1 << 20, 0}; pg8::StaticOrder S; S.init(M, 1024, F.G, bx);
        pg8::EpiRes<false> E{nullptr, XB, SS}; pg8::gemm_phase(F.lds, g, S, E);
    }
    SEAM(11);
    if (IN(12)) {
        pg8::Gemm g{XB, (const bf16_t*)(ws + WS_W1_1), M, FF, 1024, 1024, 1 << 20, 0}; pg8::StaticOrder S; S.init(M, FF, F.G, bx);
        rs_table(F, S);
        pg8::EpiSq E{HB, RS}; pg8::gemm_phase(F.lds, g, S, E);
    }
    SEAM(12);
    const bool fuse_final = IN(13) && IN(14) && F.G == 256;
    if (IN(13)) {
        pg8::Gemm g{HB, (const bf16_t*)(ws + WS_W2_1), M, 1024, FF, FF, 1 << 20, 0}; pg8::StaticOrder S; S.init(M, 1024, F.G, bx);
        if (fuse_final) { EpiFinal E{XB, F.out, args.in[3], SS, xbar}; pg8::gemm_phase(F.lds, g, S, E); }
        else { pg8::EpiRes<false> E{nullptr, XB, SS}; pg8::gemm_phase(F.lds, g, S, E); }
    }
    if (!fuse_final) { SEAM(13); }
    if (IN(14) && !fuse_final) { final_phase(F, args); }
}

extern "C" void kernel_launch(void* const* d_in, const int* in_sizes, int n_in, void* d_out, int out_size, void* d_ws, size_t ws_size, hipStream_t stream) {
    static int grid = 0;
    if (grid == 0) {
        if (n_in != 30 || out_size != M * D || ws_size < WS_END) { fprintf(stderr, "kernel_launch: unexpected shapes (n_in %d out %d ws %zu)\n", n_in, out_size, ws_size); grid = -1; return; }
        int dev = 0, cus = 0, per_cu = 0;
        (void)hipGetDevice(&dev); (void)hipDeviceGetAttribute(&cus, hipDeviceAttributeMultiprocessorCount, dev);
        (void)hipFuncSetAttribute((const void*)fwd_kernel, hipFuncAttributeMaxDynamicSharedMemorySize, LDS_BYTES);
        (void)hipOccupancyMaxActiveBlocksPerMultiprocessor(&per_cu, (const void*)fwd_kernel, NTHR, LDS_BYTES);
        if (per_cu < 1) { fprintf(stderr, "kernel_launch: occupancy query says %d blocks per CU\n", per_cu); per_cu = 1; }
        (void)hipGetLastError();
        grid = cus;
        if (grid > 256) grid = 256;
    }
    if (grid < 0) return;
    if (hipMemsetAsync((char*)d_ws + WS_BAR, 0, 16384, stream) != hipSuccess) { fprintf(stderr, "memset failed\n"); return; }
    Args a{};
    for (int i = 0; i < 30; ++i) a.in[i] = (const float*)d_in[i];
    a.out = (float*)d_out; a.ws = (unsigned char*)d_ws;
#if MK_SINGLE
    a.ph_lo = 0; a.ph_hi = NPHASE;
    void* kargs[] = {&a};
    hipError_t e = hipLaunchCooperativeKernel((const void*)fwd_kernel, dim3(grid), dim3(NTHR), kargs, LDS_BYTES, stream);
    if (e != hipSuccess) fprintf(stderr, "cooperative launch failed: %s (grid %d)\n", hipGetErrorString(e), grid);
#else
    for (int p = 0; p < NPHASE; ++p) { a.ph_lo = p; a.ph_hi = p + 1; hipLaunchKernelGGL(fwd_kernel, dim3(grid), dim3(NTHR), LDS_BYTES, stream, a); }
#endif
}
```

```cpp
#include <hip/hip_runtime.h>
#include <hip/hip_cooperative_groups.h>
#include <cstdio>
#include <cstdint>
namespace cg = cooperative_groups;

#ifndef MK_SINGLE
#define MK_SINGLE 1
#endif

#define LAS __attribute__((address_space(3)))
typedef unsigned short bf16_t;
typedef short bf16x8 __attribute__((ext_vector_type(8)));
typedef float f32x4 __attribute__((ext_vector_type(4)));
typedef float f32x2 __attribute__((ext_vector_type(2)));
typedef unsigned u32x4 __attribute__((ext_vector_type(4)));
typedef unsigned u32x2 __attribute__((ext_vector_type(2)));

constexpr int BATCH = 2, T = 8192, D = 1024, FF = 4096, M = BATCH * T;
constexpr int NWAVES = 8, NTHR = 512;
constexpr float NORM_EPS = 1e-5f, GN_EPS = 64e-5f;

constexpr size_t MiB = 1u << 20;
constexpr size_t WS_SS = 0;
constexpr size_t WS_BAR = 1 * MiB + 65536;
constexpr size_t WS_WRKV = 2 * MiB;
constexpr size_t WS_WO = 8 * MiB;
constexpr size_t WS_L1 = 10 * MiB;
constexpr size_t WS_L2 = 12 * MiB;
constexpr size_t WS_G2 = 14 * MiB;
constexpr size_t WS_R = 15 * MiB, WS_K = 47 * MiB, WS_V = 79 * MiB;
constexpr size_t WS_XR = 111 * MiB;
constexpr size_t WS_AA = 111 * MiB;
constexpr size_t WS_OD = 175 * MiB;
constexpr size_t WS_A2 = 239 * MiB;
constexpr size_t WS_SG = 247 * MiB;
constexpr size_t WS_DOT = 255 * MiB;
constexpr size_t WS_W1_0 = 15 * MiB, WS_W2_0 = 23 * MiB, WS_WIN = 31 * MiB, WS_WOUT = 39 * MiB, WS_WSB = 43 * MiB, WS_W1_1 = 44 * MiB, WS_W2_1 = 52 * MiB;
constexpr size_t WS_XB = 60 * MiB;
constexpr size_t WS_H = 92 * MiB;
constexpr size_t WS_LNP = 220 * MiB;
constexpr size_t WS_END = 256 * MiB;

constexpr int RING_BYTES = 131072, RS_OFF = RING_BYTES + 1024, LDS_BYTES = 147456;

__device__ __forceinline__ unsigned cvt_pk_bf16(float lo, float hi) { unsigned r; asm volatile("v_cvt_pk_bf16_f32 %0, %1, %2" : "=v"(r) : "v"(lo), "v"(hi)); return r; }
__device__ __forceinline__ float bf_lo(unsigned w) { return __builtin_bit_cast(float, w << 16); }
__device__ __forceinline__ float bf_hi(unsigned w) { return __builtin_bit_cast(float, w & 0xffff0000u); }
__device__ __forceinline__ float wave_sum(float v) {
#pragma unroll
    for (int o = 1; o < 64; o <<= 1) v += __shfl_xor(v, o);
    return v;
}
template <int CTRL> __device__ __forceinline__ float dpp_f(float x) { return __builtin_bit_cast(float, __builtin_amdgcn_update_dpp(0, __builtin_bit_cast(int, x), CTRL, 0xF, 0xF, true)); }
__device__ __forceinline__ float row16_allsum(float x) { x += dpp_f<0x128>(x); x += dpp_f<0x124>(x); x += dpp_f<0x122>(x); x += dpp_f<0x121>(x); return x; }
__device__ __forceinline__ float sigmoidf_(float x) { return __builtin_amdgcn_rcpf(1.0f + __expf(-x)); }
__device__ __forceinline__ float tanhf_(float x) { return 1.0f - 2.0f * __builtin_amdgcn_rcpf(__expf(2.0f * x) + 1.0f); }
__device__ __forceinline__ f32x2 gelu_pk(f32x2 v) {
    const f32x2 av = __builtin_elementwise_abs(v), d = av * 0.2316418882f + 1.0f;
    f32x2 t; t.x = __builtin_amdgcn_rcpf(d.x); t.y = __builtin_amdgcn_rcpf(d.y);
    f32x2 q = t * 0.5307027145f + (-0.7265760135f); q = q * t + 0.7107068705f; q = q * t + (-0.142248368f); q = q * t + 0.127414796f; q = q * t;
    const f32x2 s = (v * v) * (-0.72134752044f);
    f32x2 e; e.x = __builtin_amdgcn_exp2f(s.x); e.y = __builtin_amdgcn_exp2f(s.y);
    const f32x2 m = v * (q * e), r = v - m;
    f32x2 o; o.x = v.x < 0.f ? m.x : r.x; o.y = v.y < 0.f ? m.y : r.y; return o;
}
__device__ __forceinline__ u32x4 pack8(const f32x4 a, const f32x4 b) { u32x4 w; w.x = cvt_pk_bf16(a[0], a[1]); w.y = cvt_pk_bf16(a[2], a[3]); w.z = cvt_pk_bf16(b[0], b[1]); w.w = cvt_pk_bf16(b[2], b[3]); return w; }
__device__ __forceinline__ void unpack8(const u32x4 w, float (&f)[8]) { f[0] = bf_lo(w.x); f[1] = bf_hi(w.x); f[2] = bf_lo(w.y); f[3] = bf_hi(w.y); f[4] = bf_lo(w.z); f[5] = bf_hi(w.z); f[6] = bf_lo(w.w); f[7] = bf_hi(w.w); }

namespace pg8 {
constexpr int BM = 256, BK = 64, HALF = 128, HTB = HALF * BK * 2, NXCD = 8, WGM = 4;
__host__ __device__ __forceinline__ int lds_byte(int r, int c) { const int st = (r >> 4) * 2 + (c >> 5), rr = r & 15, cc = c & 31, ob = rr * 64 + cc * 2; return st * 1024 + (ob ^ (((ob >> 9) & 1) << 5)); }
__host__ __device__ __forceinline__ void stage_rc(int b, int& R, int& C) { const int st = b / 1024, sb = b % 1024, swz = sb ^ (((sb >> 9) & 1) << 5); R = (st >> 1) * 16 + swz / 64; C = (st & 1) * 32 + (swz % 64) / 2; }
__host__ __device__ __forceinline__ int perm32(int rho) { const int n = rho >> 4, i = rho & 15; return 8 * (i >> 2) + 4 * n + (i & 3); }

struct Unit { int pm, pn; };
struct Gemm { const bf16_t* A; const bf16_t* Bt; int M, N, K, lda; int agrp; size_t astride; };

struct StaticOrder {
    int nM, nN, nwg, G, c, L0, cnt;
    __host__ __device__ void init(int M_, int N_, int G_, int c_) { nM = M_ / BM; nN = N_ / BM; nwg = nM * nN; G = G_; c = c_; L0 = 0; cnt = 1 << 20; }
    __host__ __device__ void init_sub(int M_, int N_, int G_, int c_, int L0_, int cnt_) { init(M_, N_, G_, c_); L0 = L0_; cnt = cnt_; }
    __host__ __device__ bool next(int i, Unit& u) const {
        if (i >= cnt || c < 0) return false;
        const long L = (long)L0 + (long)i * G + c; if (L >= nwg) return false;
        int wgid = (int)L; { const int q = nwg / NXCD, r = nwg % NXCD, xcd = wgid % NXCD, off = wgid / NXCD; wgid = (xcd < r ? xcd * (q + 1) : r * (q + 1) + (xcd - r) * q) + off; }
        const int nig = WGM * nN, gid = wgid / nig, fm = gid * WGM, gsz = (nM - fm) < WGM ? (nM - fm) : WGM;
        u.pm = fm + ((wgid % nig) % gsz); u.pn = (wgid % nig) / gsz; return true;
    }
};

template <class Epi>
__device__ __forceinline__ void gemm_phase(LAS unsigned char* lds, const Gemm g, const StaticOrder& S, const Epi& E) {
    const int tid = threadIdx.x, wid = __builtin_amdgcn_readfirstlane(tid >> 6), lane = tid & 63, wr = wid >> 2, wc = wid & 3, fr = lane & 15, fq = lane >> 4;
    const int K = g.K, nt = K / BK;
    unsigned voffA[2], voffB[2];
#pragma unroll
    for (int i = 0; i < 2; ++i) { int R, C; stage_rc(tid * 16 + i * 8192, R, C); const int Rb = (R & ~31) + perm32(R & 31);
        voffA[i] = (unsigned)(R * g.lda + C) * 2u; voffB[i] = (unsigned)(Rb * K + C) * 2u; }
    const size_t kstep = (size_t)(BK * 2);
    const size_t hA = (size_t)HALF * g.lda * 2, tA = 2 * hA, hB = (size_t)HALF * K * 2, tB = 2 * hB;
    const unsigned ldsw = (unsigned)wid * 1024u;
    const int aoff = lds_byte(wr * 64 + fr, fq * 8), boff = lds_byte(wc * 32 + fr, fq * 8);
#define PG8_SA(b, h) (((b) * 2 + (h)) * HTB)
#define PG8_SB(b, h) ((4 + (b) * 2 + (h)) * HTB)
#define PG8_STAGE(bufoff, gbase, voff) do { _Pragma("unroll") for (int _i = 0; _i < 2; ++_i) \
        __builtin_amdgcn_global_load_lds((const unsigned*)((const char*)(gbase) + (voff)[_i]), (LAS unsigned*)(lds + (bufoff) + ldsw + _i * 8192), 16, 0, 0); } while (0)
#define PG8_LDA(dst, b, h) do { _Pragma("unroll") for (int m = 0; m < 4; ++m) _Pragma("unroll") for (int k = 0; k < 2; ++k) dst[m][k] = *(const LAS bf16x8*)(lds + PG8_SA(b, h) + aoff + m * 2048 + k * 1024); } while (0)
#define PG8_LDB(dst, b, h) do { _Pragma("unroll") for (int n = 0; n < 2; ++n) _Pragma("unroll") for (int k = 0; k < 2; ++k) dst[n][k] = *(const LAS bf16x8*)(lds + PG8_SB(b, h) + boff + n * 2048 + k * 1024); } while (0)
#define PG8_MMA(ai, bj, At, Bt) do { __builtin_amdgcn_s_setprio(1); _Pragma("unroll") for (int m = 0; m < 4; ++m) _Pragma("unroll") for (int n = 0; n < 2; ++n) _Pragma("unroll") for (int k = 0; k < 2; ++k) \
        acc[ai][bj][m][n] = __builtin_amdgcn_mfma_f32_16x16x32_bf16(Bt[n][k], At[m][k], acc[ai][bj][m][n], 0, 0, 0); __builtin_amdgcn_s_setprio(0); } while (0)
#define PG8_WAIT_V(n) asm volatile("s_waitcnt vmcnt(" #n ")" ::: "memory")
#define PG8_WAIT_L(n) asm volatile("s_waitcnt lgkmcnt(" #n ")" ::: "memory")
#define PG8_BAR __builtin_amdgcn_s_barrier()
#define PG8_SCHED __builtin_amdgcn_sched_barrier(0)
    Unit cur, nxt; int ui = 0;
    if (!S.next(0, cur)) return;
    f32x4 acc[2][2][4][2];
#pragma unroll
    for (int a = 0; a < 2; ++a)
#pragma unroll
        for (int b = 0; b < 2; ++b)
#pragma unroll
            for (int m = 0; m < 4; ++m)
#pragma unroll
                for (int n = 0; n < 2; ++n) acc[a][b][m][n] = (f32x4){0.f, 0.f, 0.f, 0.f};
    bf16x8 At[4][2], B0[2][2], B1[2][2];
    const char* cA = (const char*)g.A + (size_t)cur.pm * tA + (size_t)(cur.pn / g.agrp) * g.astride; const char* cB = (const char*)g.Bt + (size_t)cur.pn * tB;
    PG8_STAGE(PG8_SB(0, 0), cB, voffB); PG8_STAGE(PG8_SB(0, 1), cB + hB, voffB); PG8_STAGE(PG8_SA(0, 0), cA, voffA); PG8_STAGE(PG8_SA(0, 1), cA + hA, voffA);
    if (wr == 1) PG8_BAR;
    PG8_WAIT_V(2); PG8_BAR;
    PG8_STAGE(PG8_SB(1, 0), cB + kstep, voffB); PG8_STAGE(PG8_SA(1, 0), cA + kstep, voffA); PG8_STAGE(PG8_SB(1, 1), cB + hB + kstep, voffB);
    PG8_WAIT_V(6); PG8_BAR;
    for (;;) {
        const bool has_next = S.next(ui + 1, nxt);
        const char* nA = has_next ? (const char*)g.A + (size_t)nxt.pm * tA + (size_t)(nxt.pn / g.agrp) * g.astride : cA; const char* nB = has_next ? (const char*)g.Bt + (size_t)nxt.pn * tB : cB;
#pragma nounroll
        for (int t = 0; t < nt; t += 2) {
            const bool last = (t == nt - 2);
            const char* a1 = cA + (size_t)(t + 1) * kstep;
            const char* a2 = last ? nA : cA + (size_t)(t + 2) * kstep; const char* b2 = last ? nB : cB + (size_t)(t + 2) * kstep;
            const char* a3 = a2 + kstep; const char* b3 = b2 + kstep;
            PG8_LDB(B0, 0, 0); PG8_LDB(B1, 0, 1); PG8_SCHED; PG8_LDA(At, 0, 0); PG8_STAGE(PG8_SA(1, 1), a1 + hA, voffA);
            PG8_WAIT_V(8); PG8_WAIT_L(0); PG8_BAR; PG8_MMA(0, 0, At, B0); PG8_MMA(0, 1, At, B1); PG8_BAR; PG8_SCHED;
            PG8_LDA(At, 0, 1); PG8_STAGE(PG8_SB(0, 0), b2, voffB); PG8_STAGE(PG8_SB(0, 1), b2 + hB, voffB); PG8_STAGE(PG8_SA(0, 0), a2, voffA);
            PG8_WAIT_V(8); PG8_WAIT_L(0); PG8_BAR; PG8_MMA(1, 0, At, B0); PG8_MMA(1, 1, At, B1); PG8_BAR; PG8_SCHED;
            PG8_LDB(B0, 1, 0); PG8_LDB(B1, 1, 1); PG8_SCHED; PG8_LDA(At, 1, 0); PG8_STAGE(PG8_SA(0, 1), a2 + hA, voffA);
            PG8_WAIT_V(8); PG8_WAIT_L(0); PG8_BAR; PG8_MMA(0, 0, At, B0); PG8_MMA(0, 1, At, B1); PG8_BAR; PG8_SCHED;
            PG8_LDA(At, 1, 1); PG8_STAGE(PG8_SB(1, 0), b3, voffB); PG8_STAGE(PG8_SB(1, 1), b3 + hB, voffB); PG8_STAGE(PG8_SA(1, 0), a3, voffA);
            PG8_WAIT_V(8); PG8_WAIT_L(0); PG8_BAR; PG8_MMA(1, 0, At, B0); PG8_MMA(1, 1, At, B1); PG8_BAR; PG8_SCHED;
        }
        if (wr == 0) PG8_BAR;
        E(acc, cur, ui, wr, wc, fr, fq);
        if (!has_next) break;
#pragma unroll
        for (int a = 0; a < 2; ++a)
#pragma unroll
            for (int b = 0; b < 2; ++b)
#pragma unroll
                for (int m = 0; m < 4; ++m)
#pragma unroll
                    for (int n = 0; n < 2; ++n) acc[a][b][m][n] = (f32x4){0.f, 0.f, 0.f, 0.f};
        cur = nxt; cA = nA; cB = nB; ++ui;
        if (wr == 1) PG8_BAR;
    }
    PG8_WAIT_V(0);
    PG8_BAR;
#undef PG8_SA
#undef PG8_SB
#undef PG8_STAGE
#undef PG8_LDA
#undef PG8_LDB
#undef PG8_MMA
#undef PG8_WAIT_V
#undef PG8_WAIT_L
#undef PG8_BAR
#undef PG8_SCHED
}

#define EPI_ARGS const f32x4 (&acc)[2][2][4][2], const Unit& u, int ui, int wr, int wc, int fr, int fq
#define EPI_ROWS for (int ai = 0; ai < 2; ++ai) _Pragma("unroll") for (int m = 0; m < 4; ++m)
struct EpiSplit {
    bf16_t* O; int ldc; int split_cols; size_t split_stride;
    __device__ __forceinline__ void operator()(EPI_ARGS) const {
        int colt = u.pn * BM; const int t = colt / split_cols; bf16_t* base = O + (size_t)t * split_stride; colt -= t * split_cols;
        const int col0 = colt + wc * 32 + 8 * fq;
#pragma unroll
        EPI_ROWS { bf16_t* rowp = base + (size_t)(u.pm * BM + ai * HALF + wr * 64 + m * 16 + fr) * ldc + col0;
#pragma unroll
            for (int bj = 0; bj < 2; ++bj) *(u32x4*)(rowp + bj * HALF) = pack8(acc[ai][bj][m][0], acc[ai][bj][m][1]); }
    }
};
struct EpiLora1 {
    bf16_t* A2; bf16_t* SG;
    __device__ __forceinline__ void operator()(EPI_ARGS) const {
        bf16_t* base = u.pn == 0 ? A2 : SG; const int col0 = wc * 32 + 8 * fq;
#pragma unroll
        EPI_ROWS { bf16_t* rowp = base + (size_t)(u.pm * BM + ai * HALF + wr * 64 + m * 16 + fr) * 256 + col0;
            f32x4 v0 = acc[ai][0][m][0], v1 = acc[ai][0][m][1];
            if (u.pn == 0) { for (int e = 0; e < 4; ++e) { v0[e] = tanhf_(v0[e]); v1[e] = tanhf_(v1[e]); } }
            else { for (int e = 0; e < 4; ++e) { v0[e] = sigmoidf_(v0[e]); v1[e] = sigmoidf_(v1[e]); } }
            *(u32x4*)(rowp) = pack8(v0, v1);
            f32x4 w0 = acc[ai][1][m][0], w1 = acc[ai][1][m][1];
            if (u.pn != 0) { w0 = (f32x4){0.f, 0.f, 0.f, 0.f}; w1 = w0; }
            *(u32x4*)(rowp + HALF) = pack8(w0, w1); }
    }
};
struct EpiLora2 {
    bf16_t* EW; bf16_t* AA; const float* w0; const float* a0;
    __device__ __forceinline__ void operator()(EPI_ARGS) const {
        const int grp = u.pn >> 2, c0 = (u.pn & 3) * BM + wc * 32 + 8 * fq;
        const float* bias = (grp < 2 ? w0 + grp * D : a0 + (grp - 2) * D) + c0;
        bf16_t* base = (grp < 2 ? EW + (size_t)grp * M * D : AA + (size_t)(grp - 2) * M * D) + c0;
        const float sc = grp < 2 ? 0.60653065971f : 1.0f;
#pragma unroll
        EPI_ROWS { bf16_t* rowp = base + (size_t)(u.pm * BM + ai * HALF + wr * 64 + m * 16 + fr) * D;
#pragma unroll
            for (int bj = 0; bj < 2; ++bj) { f32x4 v0 = acc[ai][bj][m][0] + *(const f32x4*)(bias + bj * HALF), v1 = acc[ai][bj][m][1] + *(const f32x4*)(bias + bj * HALF + 4);
                for (int e = 0; e < 4; ++e) { v0[e] = sigmoidf_(v0[e]) * sc; v1[e] = sigmoidf_(v1[e]) * sc; }
                *(u32x4*)(rowp + bj * HALF) = pack8(v0, v1); } if (m & 1) asm volatile("" ::: "memory"); }
    }
};
struct EpiG {
    bf16_t* Z;
    __device__ __forceinline__ void operator()(EPI_ARGS) const {
        const int col0 = u.pn * BM + wc * 32 + 8 * fq;
#pragma unroll
        EPI_ROWS { bf16_t* rowp = Z + (size_t)(u.pm * BM + ai * HALF + wr * 64 + m * 16 + fr) * D + col0;
#pragma unroll
            for (int bj = 0; bj < 2; ++bj) { const u32x4 zw = *(const u32x4*)(rowp + bj * HALF); float z[8]; unpack8(zw, z);
                f32x4 v0 = acc[ai][bj][m][0], v1 = acc[ai][bj][m][1];
                for (int e = 0; e < 4; ++e) { v0[e] *= z[e]; v1[e] *= z[4 + e]; }
                *(u32x4*)(rowp + bj * HALF) = pack8(v0, v1); } if (m & 1) asm volatile("" ::: "memory"); }
    }
};
template <bool BASE_F32> struct EpiRes {
    const float* basef; bf16_t* xb; float* ss;
    __device__ __forceinline__ void operator()(EPI_ARGS) const {
        const int col0 = u.pn * BM + wc * 32 + 8 * fq;
#pragma unroll
        EPI_ROWS { const int row = u.pm * BM + ai * HALF + wr * 64 + m * 16 + fr; const size_t off = (size_t)row * D + col0; float sq = 0.f;
#pragma unroll
            for (int bj = 0; bj < 2; ++bj) { f32x4 b0, b1;
                if (BASE_F32) { const float* bp = basef + off + bj * HALF; b0 = *(const f32x4*)bp; b1 = *(const f32x4*)(bp + 4); }
                else { const u32x4 w = *(const u32x4*)(xb + off + bj * HALF); float t[8]; unpack8(w, t); b0 = (f32x4){t[0], t[1], t[2], t[3]}; b1 = (f32x4){t[4], t[5], t[6], t[7]}; }
                const f32x4 v0 = acc[ai][bj][m][0] + b0, v1 = acc[ai][bj][m][1] + b1;
                *(u32x4*)(xb + off + bj * HALF) = pack8(v0, v1);
                sq += (v0[0] * v0[0] + v0[1] * v0[1]) + (v0[2] * v0[2] + v0[3] * v0[3]) + (v1[0] * v1[0] + v1[1] * v1[1]) + (v1[2] * v1[2] + v1[3] * v1[3]); }
            sq += __shfl_xor(sq, 16); sq += __shfl_xor(sq, 32);
            if (fq == 0) ss[(size_t)row * 16 + u.pn * 4 + wc] = sq; if (m & 1) asm volatile("" ::: "memory"); }
    }
};
struct EpiSq {
    bf16_t* H; const LAS float* RS;
    __device__ __forceinline__ void operator()(EPI_ARGS) const {
        const int col0 = u.pn * BM + wc * 32 + 8 * fq;
#pragma unroll
        EPI_ROWS { const int rl = ai * HALF + wr * 64 + m * 16 + fr; const float rs = RS[ui * 256 + rl]; bf16_t* rowp = H + (size_t)(u.pm * BM + rl) * FF + col0;
#pragma unroll
            for (int bj = 0; bj < 2; ++bj) { f32x4 v0 = acc[ai][bj][m][0] * rs, v1 = acc[ai][bj][m][1] * rs;
                for (int e = 0; e < 4; ++e) { const float a = fmaxf(v0[e], 0.f), b = fmaxf(v1[e], 0.f); v0[e] = a * a; v1[e] = b * b; }
                *(u32x4*)(rowp + bj * HALF) = pack8(v0, v1); } }
    }
};
struct EpiGelu {
    bf16_t* H; const LAS float* RS; f32x2* LNP;
    __device__ __forceinline__ void operator()(EPI_ARGS) const {
        const int col0 = u.pn * BM + wc * 32 + 8 * fq;
#pragma unroll
        EPI_ROWS { const int rl = ai * HALF + wr * 64 + m * 16 + fr; const float rs = RS[ui * 256 + rl]; const int row = u.pm * BM + rl; bf16_t* rowp = H + (size_t)row * FF + col0; float s = 0.f, q = 0.f;
#pragma unroll
            for (int bj = 0; bj < 2; ++bj) { f32x4 v0 = acc[ai][bj][m][0] * rs, v1 = acc[ai][bj][m][1] * rs;
                const f32x2 g0 = gelu_pk((f32x2){v0[0], v0[1]}), g1 = gelu_pk((f32x2){v0[2], v0[3]}), g2 = gelu_pk((f32x2){v1[0], v1[1]}), g3 = gelu_pk((f32x2){v1[2], v1[3]});
                v0 = (f32x4){g0.x, g0.y, g1.x, g1.y}; v1 = (f32x4){g2.x, g2.y, g3.x, g3.y};
                s += (v0[0] + v0[1]) + (v0[2] + v0[3]) + (v1[0] + v1[1]) + (v1[2] + v1[3]);
                q += (v0[0] * v0[0] + v0[1] * v0[1]) + (v0[2] * v0[2] + v0[3] * v0[3]) + (v1[0] * v1[0] + v1[1] * v1[1]) + (v1[2] * v1[2] + v1[3] * v1[3]);
                *(u32x4*)(rowp + bj * HALF) = pack8(v0, v1); }
            if (u.pn >= 8) { s += __shfl_xor(s, 16); s += __shfl_xor(s, 32); q += __shfl_xor(q, 16); q += __shfl_xor(q, 32);
                if (fq == 0) LNP[(size_t)row * 32 + (u.pn - 8) * 4 + wc] = (f32x2){s, q}; } }
    }
};
}

struct Args { const float* in[30]; float* out; unsigned char* ws; int ph_lo, ph_hi; };
struct Frame {
    LAS unsigned char* lds;
    int tid, lane, wave, G;
    float* out; unsigned char* ws;
};
#define LDS_WAIT() asm volatile("s_waitcnt lgkmcnt(0)" ::: "memory")

__device__ __forceinline__ void tr_item(const float* W, int ldw, bf16_t* WT, int ldt, int drow0, int dcol0, const float* ks, LAS float* scr, int k0, int n0, int lane) {
    { const int kr = lane >> 3, n4 = 4 * (lane & 7); f32x4 v[8];
#pragma unroll
      for (int i = 0; i < 8; ++i) v[i] = *(const f32x4*)(W + (size_t)(k0 + kr + 8 * i) * ldw + n0 + n4);
#pragma unroll
      for (int i = 0; i < 8; ++i) { const int kk = kr + 8 * i; f32x4 x = v[i]; if (ks) x = x * ks[k0 + kk]; LAS float* d = scr + kk * 33 + n4; d[0] = x[0]; d[1] = x[1]; d[2] = x[2]; d[3] = x[3]; } }
    LDS_WAIT(); asm volatile("" ::: "memory");
    const int c = lane & 7;
#pragma unroll
    for (int j = 0; j < 4; ++j) { const int n = (lane >> 3) + 8 * j; const LAS float* s = scr + (8 * c) * 33 + n;
        u32x4 o; o.x = cvt_pk_bf16(s[0 * 33], s[1 * 33]); o.y = cvt_pk_bf16(s[2 * 33], s[3 * 33]); o.z = cvt_pk_bf16(s[4 * 33], s[5 * 33]); o.w = cvt_pk_bf16(s[6 * 33], s[7 * 33]);
        *(u32x4*)(WT + (size_t)(drow0 + n0 + n) * ldt + dcol0 + k0 + 8 * c) = o; }
    LDS_WAIT(); asm volatile("" ::: "memory");
}
__device__ __forceinline__ void zero_item(bf16_t* WT, int ldt, int row0, int col0, int lane) {
#pragma unroll
    for (int j = 0; j < 4; ++j) { const int q = lane + 64 * j, r = q >> 3, c = q & 7; *(u32x4*)(WT + (size_t)(row0 + r) * ldt + col0 + 8 * c) = (u32x4){0u, 0u, 0u, 0u}; }
}
#define TR_MAT(W, KK, NN, WT, LDT, DR, DC, KS) { const int _n = ((KK) / 64) * ((NN) / 32); if (r < _n) { const int _nb = (NN) / 32; tr_item(W, NN, WT, LDT, DR, DC, KS, scr, 64 * (r / _nb), 32 * (r % _nb), F.lane); continue; } r -= _n; }

__device__ __forceinline__ void p0_phase(Frame& F, const Args& A) {
    LAS float* scr = (LAS float*)(F.lds + F.wave * 16384);
    const int gw = blockIdx.x * NWAVES + F.wave, NGW = F.G * NWAVES;
    bf16_t* WRKV = (bf16_t*)(F.ws + WS_WRKV); bf16_t* WO = (bf16_t*)(F.ws + WS_WO); bf16_t* L1 = (bf16_t*)(F.ws + WS_L1); bf16_t* L2 = (bf16_t*)(F.ws + WS_L2); bf16_t* G2 = (bf16_t*)(F.ws + WS_G2);
    const float* mu = A.in[4];
    constexpr int NZ1 = 128, NZ2 = 128;
    constexpr int NTOT = 4 * 512 + 2 * (4 * 32 + 64) + 4 * 32 + 64 + NZ1 + NZ2;
    for (int it = gw; it < NTOT; it += NGW) {
        int r = it;
        TR_MAT(A.in[5], 1024, 1024, WRKV, 1024, 0, 0, nullptr)
        TR_MAT(A.in[6], 1024, 1024, WRKV, 1024, 1024, 0, nullptr)
        TR_MAT(A.in[7], 1024, 1024, WRKV, 1024, 2048, 0, nullptr)
        TR_MAT(A.in[8], 1024, 1024, WO, 1024, 0, 0, nullptr)
        TR_MAT(A.in[10], 1024, 64, L1, 2048, 0, 0, nullptr)
        TR_MAT(A.in[10] + 1024 * 64, 1024, 64, L1, 2048, 64, 0, nullptr)
        TR_MAT(A.in[13], 1024, 64, L1, 2048, 128, 0, nullptr)
        TR_MAT(A.in[13] + 1024 * 64, 1024, 64, L1, 2048, 192, 0, nullptr)
        TR_MAT(A.in[15], 1024, 128, L1, 2048, 256, 0, nullptr)
        TR_MAT(A.in[10], 1024, 64, L1, 2048, 0, 1024, mu + 1 * D)
        TR_MAT(A.in[10] + 1024 * 64, 1024, 64, L1, 2048, 64, 1024, mu + 1 * D)
        TR_MAT(A.in[13], 1024, 64, L1, 2048, 128, 1024, mu + 4 * D)
        TR_MAT(A.in[13] + 1024 * 64, 1024, 64, L1, 2048, 192, 1024, mu + 4 * D)
        TR_MAT(A.in[15], 1024, 128, L1, 2048, 256, 1024, mu + 5 * D)
        TR_MAT(A.in[11], 64, 1024, L2, 128, 0, 0, nullptr)
        TR_MAT(A.in[11] + 64 * 1024, 64, 1024, L2, 128, 1024, 64, nullptr)
        TR_MAT(A.in[14], 64, 1024, L2, 128, 2048, 0, nullptr)
        TR_MAT(A.in[14] + 64 * 1024, 64, 1024, L2, 128, 3072, 64, nullptr)
        TR_MAT(A.in[16], 128, 1024, G2, 128, 0, 0, nullptr)
        if (r < NZ1) { zero_item(L1, 2048, 384 + 32 * (r / 32), 64 * (r % 32), F.lane); continue; } r -= NZ1;
        { const int grp = r / 32; zero_item(L2, 128, 32 * r, 64 * (1 - (grp & 1)), F.lane); }
    }
    const float* x = A.in[0]; const float* gn = A.in[1];
    bf16_t* XNXX = (bf16_t*)F.out; bf16_t* XR = (bf16_t*)(F.ws + WS_XR);
    f32x4 gv[4], m0[4], m2[4], m3[4];
#pragma unroll
    for (int j = 0; j < 4; ++j) { gv[j] = ((const f32x4*)gn)[64 * j + F.lane]; m0[j] = ((const f32x4*)mu)[64 * j + F.lane]; m2[j] = ((const f32x4*)(mu + 2 * D))[64 * j + F.lane]; m3[j] = ((const f32x4*)(mu + 3 * D))[64 * j + F.lane]; }
    for (int m = gw; m < M; m += NGW) {
        const int t = m & (T - 1); const bool hp = t > 0, hn = t < T - 1;
        const f32x4* xc = (const f32x4*)(x + (size_t)m * D) + F.lane; const f32x4* xp = xc - D / 4; const f32x4* xq = xc + D / 4;
        f32x4 vc[4], vp[4], vn[4]; float sc = 0.f, sp = 0.f, sn = 0.f; const f32x4 z4 = {0.f, 0.f, 0.f, 0.f};
#pragma unroll
        for (int j = 0; j < 4; ++j) { vc[j] = xc[64 * j]; vp[j] = hp ? xp[64 * j] : z4; vn[j] = hn ? xq[64 * j] : z4;
            sc += (vc[j].x * vc[j].x + vc[j].y * vc[j].y) + (vc[j].z * vc[j].z + vc[j].w * vc[j].w);
            sp += (vp[j].x * vp[j].x + vp[j].y * vp[j].y) + (vp[j].z * vp[j].z + vp[j].w * vp[j].w);
            sn += (vn[j].x * vn[j].x + vn[j].y * vn[j].y) + (vn[j].z * vn[j].z + vn[j].w * vn[j].w); }
        const float rc = 1.0f / sqrtf(wave_sum(sc) * (1.f / D) + NORM_EPS), rp = 1.0f / sqrtf(wave_sum(sp) * (1.f / D) + NORM_EPS), rn = 1.0f / sqrtf(wave_sum(sn) * (1.f / D) + NORM_EPS);
#pragma unroll
        for (int j = 0; j < 4; ++j) { const int col = 4 * (64 * j + F.lane);
            const f32x4 a = vc[j] * rc * gv[j], xx = (vp[j] * rp + vn[j] * rn) * gv[j] * 0.5f - a;
            const f32x4 vr = a + xx * m0[j], vk = a + xx * m2[j], vv = a + xx * m3[j];
            *(u32x2*)(XNXX + (size_t)m * 2048 + col) = (u32x2){cvt_pk_bf16(a[0], a[1]), cvt_pk_bf16(a[2], a[3])};
            *(u32x2*)(XNXX + (size_t)m * 2048 + 1024 + col) = (u32x2){cvt_pk_bf16(xx[0], xx[1]), cvt_pk_bf16(xx[2], xx[3])};
            *(u32x2*)(XR + (size_t)m * D + col) = (u32x2){cvt_pk_bf16(vr[0], vr[1]), cvt_pk_bf16(vr[2], vr[3])};
            *(u32x2*)(XR + (size_t)M * D + (size_t)m * D + col) = (u32x2){cvt_pk_bf16(vk[0], vk[1]), cvt_pk_bf16(vk[2], vk[3])};
            *(u32x2*)(XR + 2 * (size_t)M * D + (size_t)m * D + col) = (u32x2){cvt_pk_bf16(vv[0], vv[1]), cvt_pk_bf16(vv[2], vv[3])}; }
    }
}

__device__ __forceinline__ void convB_phase(Frame& F, const Args& A) {
    LAS float* scr = (LAS float*)(F.lds + F.wave * 16384);
    const int gw = blockIdx.x * NWAVES + F.wave, NGW = F.G * NWAVES;
    bf16_t* W1_0 = (bf16_t*)(F.ws + WS_W1_0); bf16_t* W2_0 = (bf16_t*)(F.ws + WS_W2_0); bf16_t* WIN = (bf16_t*)(F.ws + WS_WIN); bf16_t* WOUT = (bf16_t*)(F.ws + WS_WOUT);
    bf16_t* WSB = (bf16_t*)(F.ws + WS_WSB); bf16_t* W1_1 = (bf16_t*)(F.ws + WS_W1_1); bf16_t* W2_1 = (bf16_t*)(F.ws + WS_W2_1);
    constexpr int NTOT = 5 * 2048 + 1024 + 512;
    for (int it = gw; it < NTOT; it += NGW) {
        int r = it;
        TR_MAT(A.in[28], 1024, 4096, W1_0, 1024, 0, 0, A.in[2])
        TR_MAT(A.in[29], 4096, 1024, W2_0, 4096, 0, 0, nullptr)
        TR_MAT(A.in[22], 1024, 4096, WIN, 1024, 0, 0, A.in[1] + D)
        TR_MAT(A.in[28] + (size_t)D * FF, 1024, 4096, W1_1, 1024, 0, 0, A.in[2] + D)
        TR_MAT(A.in[29] + (size_t)D * FF, 4096, 1024, W2_1, 4096, 0, 0, nullptr)
        TR_MAT(A.in[27], 2048, 1024, WOUT, 2048, 0, 0, nullptr)
        { const float* s = A.in[25] + (size_t)r * 512 + F.lane * 8; const f32x4 a = *(const f32x4*)s, b = *(const f32x4*)(s + 4); *(u32x4*)(WSB + (size_t)r * 512 + F.lane * 8) = pack8(a, b); }
    }
}

constexpr int TC = 16, NCH = T / TC, SREC = 336;
template <int VAR>
__device__ __forceinline__ void scan_phase(Frame& F, const Args& A) {
    LAS float* BUF = (LAS float*)(F.lds);
    LAS float* OP = (LAS float*)(F.lds + 4 * TC * SREC * 4);
    LAS unsigned* FL = (LAS unsigned*)(F.lds + 4 * TC * SREC * 4 + 2 * TC * 256 * 4);
    const int tid = F.tid, lane = F.lane, wave = F.wave;
    const bool prod = wave >= 4; const int ptid = tid - 256;
    const bf16_t* Rg = (const bf16_t*)(F.ws + WS_R); const bf16_t* Kg = (const bf16_t*)(F.ws + WS_K); const bf16_t* Vg = (const bf16_t*)(F.ws + WS_V);
    const bf16_t* EWg = (const bf16_t*)F.out; const bf16_t* AAg = (const bf16_t*)(F.ws + WS_AA); bf16_t* ODg = (bf16_t*)(F.ws + WS_OD);
    for (int it0 = blockIdx.x; it0 < 256; it0 += F.G) {
        const int item = (F.G == 256) ? ((it0 & 7) * 32 + (it0 >> 3)) : it0;
        const int chain = item >> 2, quarter = item & 3, dir = chain & 1, bh = chain >> 1, b = bh >> 4, h = bh & 15, row0 = quarter * 16;
        const size_t boff = (size_t)b * T * D + h * 64;
        const bf16_t* Rp = Rg + boff; const bf16_t* Kp = Kg + boff; const bf16_t* Vp = Vg + boff;
        const bf16_t* Ep = EWg + (size_t)dir * M * D + boff; const bf16_t* Ap = AAg + (size_t)dir * M * D + boff; bf16_t* Op = ODg + (size_t)dir * M * D + boff + row0;
        const int pw = wave - 4, tq = lane >> 4, c4 = (lane & 15) * 4;
        u32x2 raw[4][5];
#pragma unroll
        for (int j = 0; j < 4; ++j) for (int q = 0; q < 5; ++q) raw[j][q] = (u32x2){0u, 0u};
        f32x4 kk4 = {0, 0, 0, 0}, ka4 = {0, 0, 0, 0}, rk4 = {0, 0, 0, 0};
        if (prod) { kk4 = *(const f32x4*)(A.in[17] + h * 64 + c4); ka4 = *(const f32x4*)(A.in[18] + h * 64 + c4); rk4 = *(const f32x4*)(A.in[19] + h * 64 + c4); }
        asm volatile("s_waitcnt vmcnt(0)" : "+v"(kk4), "+v"(ka4), "+v"(rk4) :: "memory");
        bf16_t* Dp = (bf16_t*)(F.ws + WS_DOT) + ((size_t)dir * M + (size_t)b * T) * 16 + h;
#define SC_LOAD(c) do { _Pragma("unroll") for (int j = 0; j < 4; ++j) { const int step = (c) * TC + tq + 4 * j; const int tt = dir ? (T - 1 - step) : step; const size_t o = (size_t)tt * D + c4; \
        raw[j][0] = *(const u32x2*)(Rp + o); raw[j][1] = *(const u32x2*)(Kp + o); raw[j][2] = *(const u32x2*)(Vp + o); raw[j][3] = *(const u32x2*)(Ep + o); raw[j][4] = *(const u32x2*)(Ap + o); } } while (0)
#define SC_PROC(c) do { _Pragma("unroll") for (int j = 0; j < 4; ++j) { const int tl = tq + 4 * j; const u32x2 rr = raw[j][0], rk = raw[j][1], rv = raw[j][2], re = raw[j][3], ra = raw[j][4]; \
        const f32x4 r4 = {bf_lo(rr.x), bf_hi(rr.x), bf_lo(rr.y), bf_hi(rr.y)}, k4 = {bf_lo(rk.x), bf_hi(rk.x), bf_lo(rk.y), bf_hi(rk.y)}, v4 = {bf_lo(rv.x), bf_hi(rv.x), bf_lo(rv.y), bf_hi(rv.y)}; \
        const f32x4 e4 = {bf_lo(re.x), bf_hi(re.x), bf_lo(re.y), bf_hi(re.y)}, a4 = {bf_lo(ra.x), bf_hi(ra.x), bf_lo(ra.y), bf_hi(ra.y)}; \
        f32x4 kk = k4 * kk4; float ss = (kk[0] * kk[0] + kk[1] * kk[1]) + (kk[2] * kk[2] + kk[3] * kk[3]); ss = row16_allsum(ss); \
        const float inv = __builtin_amdgcn_rsqf(fmaxf(ss, 1e-24f)); kk = kk * inv; \
        f32x4 dec; dec[0] = __expf(-e4[0]); dec[1] = __expf(-e4[1]); dec[2] = __expf(-e4[2]); dec[3] = __expf(-e4[3]); \
        const f32x4 kd = k4 * (1.0f + (a4 - 1.0f) * ka4); \
        { const f32x4 pr_ = r4 * kd * rk4; float dt = (pr_[0] + pr_[1]) + (pr_[2] + pr_[3]); dt = row16_allsum(dt); \
          if (quarter == 0 && (lane & 15) == 0) { const int step_ = (c) * TC + tl; const int tt_ = dir ? (T - 1 - step_) : step_; Dp[(size_t)tt_ * 16] = (bf16_t)(cvt_pk_bf16(dt, 0.f) & 0xffffu); } } \
        LAS float* dst = BUF + ((c) & 3) * TC * SREC + tl * SREC + c4; \
        *(LAS f32x4*)(dst) = dec; *(LAS f32x4*)(dst + 64) = -kk; *(LAS f32x4*)(dst + 128) = kk * a4; *(LAS f32x4*)(dst + 192) = kd; *(LAS f32x4*)(dst + 256) = r4; \
        if ((c4 >> 4) == quarter) *(LAS f32x4*)(BUF + ((c) & 3) * TC * SREC + tl * SREC + 320 + c4 - row0) = v4; } } while (0)
#define SC_RED(c, ok) do { const int row = lane & 15; const LAS float* src = OP + ((c) & 1) * TC * 256 + tq * 1024 + ((row >> 2) * 64 + (row & 3) * 16) * 4; \
        f32x4 o4 = {0.f, 0.f, 0.f, 0.f}; \
        _Pragma("unroll") for (int j = 0; j < 16; ++j) o4 += *(const LAS f32x4*)(src + (((j + row) & 15) << 2));     \
        _Pragma("unroll") for (int e = 0; e < 4; ++e) { const int step = (c) * TC + 4 * tq + e; const int tt = dir ? (T - 1 - step) : step; \
            if (ok) Op[(size_t)tt * D + row] = (bf16_t)(cvt_pk_bf16(o4[e], 0.f) & 0xffffu); } } while (0)
#define SC_SPIN_GE(p_, v_) do { unsigned n_ = 0; while (*(volatile LAS unsigned*)(p_) < (unsigned)(v_)) { __builtin_amdgcn_s_sleep(1); if (++n_ > (1u << 22)) break; } asm volatile("" ::: "memory"); } while (0)
        if (tid < 16) FL[tid] = 0u;
        __syncthreads();
        if (prod) {
            SC_LOAD(pw);
#pragma nounroll
            for (int m = 0; m < NCH / 4; ++m) {
                const int k = pw + 4 * m;
                SC_PROC(k);
                asm volatile("s_waitcnt lgkmcnt(0)" ::: "memory");
                if (lane == 0) *(volatile LAS unsigned*)(FL + pw) = (unsigned)(m + 1);
                { const int kl = (k + 4 < NCH) ? k + 4 : NCH - 1; SC_LOAD(kl); }
                SC_SPIN_GE(FL + 4 + pw, 4 * (m + 1));
                SC_RED(k, true);
                asm volatile("s_waitcnt lgkmcnt(0)" ::: "memory");
                if (lane == 0) (void)__hip_atomic_fetch_add(FL + 8 + (k & 1), 1u, __ATOMIC_RELAXED, __HIP_MEMORY_SCOPE_WORKGROUP);
            }
        } else {
            f32x2 S01 = {0.f, 0.f}, S23 = {0.f, 0.f};
            const int ks = lane & 15, rl = lane >> 4;
            unsigned fl_rdy = 0u, fl_red = 0u;
#pragma nounroll
            for (int c = 0; c < NCH; ++c) {
                if (fl_rdy < (unsigned)((c >> 2) + 1)) SC_SPIN_GE(FL + (c & 3), (c >> 2) + 1);
                if (c >= 2 && fl_red < (unsigned)(c >> 1)) SC_SPIN_GE(FL + 8 + (c & 1), c >> 1);
                const LAS float* bp = BUF + (c & 3) * TC * SREC + ks * 4; const LAS float* vp = BUF + (c & 3) * TC * SREC + 320 + wave * 4 + rl;
                LAS float* op = OP + (c & 1) * TC * 256 + tid * 4;
                f32x4 oq = {0.f, 0.f, 0.f, 0.f};
                constexpr int PD = 2;
                f32x4 pw_[PD], pa_[PD], pb_[PD], pk_[PD], pr_[PD]; float pv_[PD];
#pragma unroll
                for (int j = 0; j < PD; ++j) { const LAS float* q = bp + j * SREC; pw_[j] = *(const LAS f32x4*)(q); pa_[j] = *(const LAS f32x4*)(q + 64); pb_[j] = *(const LAS f32x4*)(q + 128); pk_[j] = *(const LAS f32x4*)(q + 192); pr_[j] = *(const LAS f32x4*)(q + 256); pv_[j] = vp[j * SREC]; }
#pragma unroll
                for (int i = 0; i < TC; ++i) {
                    const int sl = i % PD;
                    const f32x4 w = pw_[sl], a = pa_[sl], bb = pb_[sl], k = pk_[sl], r = pr_[sl]; const float v = pv_[sl];
                    if (i == 10) { fl_rdy = *(volatile LAS unsigned*)(FL + ((c + 1) & 3)); fl_red = *(volatile LAS unsigned*)(FL + 8 + ((c + 1) & 1)); }
                    if (i + PD < TC) { const LAS float* q = bp + (i + PD) * SREC; pw_[sl] = *(const LAS f32x4*)(q); pa_[sl] = *(const LAS f32x4*)(q + 64); pb_[sl] = *(const LAS f32x4*)(q + 128); pk_[sl] = *(const LAS f32x4*)(q + 192); pr_[sl] = *(const LAS f32x4*)(q + 256); pv_[sl] = vp[(i + PD) * SREC]; }
                    f32x2 p = S01 * (f32x2){a[0], a[1]}; p = S23 * (f32x2){a[2], a[3]} + p;
                    float sa = p.x + p.y; sa = row16_allsum(sa);
                    const f32x2 vk01 = (f32x2){k[0], k[1]} * v, vk23 = (f32x2){k[2], k[3]} * v;
                    const f32x2 t01 = (f32x2){bb[0], bb[1]} * sa + vk01, t23 = (f32x2){bb[2], bb[3]} * sa + vk23;
                    S01 = S01 * (f32x2){w[0], w[1]} + t01; S23 = S23 * (f32x2){w[2], w[3]} + t23;
                    f32x2 q2 = S01 * (f32x2){r[0], r[1]}; q2 = S23 * (f32x2){r[2], r[3]} + q2;
                    oq[i & 3] = q2.x + q2.y; if ((i & 3) == 3) *(LAS f32x4*)(op + (i >> 2) * 1024) = oq;
                }
                asm volatile("s_waitcnt lgkmcnt(0)" ::: "memory");
                if (lane == 0) (void)__hip_atomic_fetch_add(FL + 4 + (c & 3), 1u, __ATOMIC_RELAXED, __HIP_MEMORY_SCOPE_WORKGROUP);
            }
        }
        __syncthreads();
#undef SC_SPIN_GE
#undef SC_LOAD
#undef SC_PROC
#undef SC_RED
    }
}

__device__ __forceinline__ void z_phase(Frame& F, const Args& A) {
    const int gw = blockIdx.x * NWAVES + F.wave, NGW = F.G * NWAVES, col = F.lane * 16;
    const bf16_t* Rg = (const bf16_t*)(F.ws + WS_R); const bf16_t* Kg = (const bf16_t*)(F.ws + WS_K); const bf16_t* Vg = (const bf16_t*)(F.ws + WS_V);
    const bf16_t* A0 = (const bf16_t*)(F.ws + WS_AA); const bf16_t* A1 = A0 + (size_t)M * D; bf16_t* OF = (bf16_t*)(F.ws + WS_OD); const bf16_t* OB = OF + (size_t)M * D;
    float lg[16], lb[16];
#pragma unroll
    for (int i = 0; i < 16; ++i) { lg[i] = A.in[20][col + i]; lb[i] = A.in[21][col + i]; }
    for (int m = gw; m < M; m += NGW) {
        const size_t o = (size_t)m * D + col;
        float of[16], ob[16], v[16];
#define LD16(dst, P) { const u32x4 _a = *(const u32x4*)((P) + o), _b = *(const u32x4*)((P) + o + 8); float _t[8]; unpack8(_a, _t); for (int i = 0; i < 8; ++i) dst[i] = _t[i]; unpack8(_b, _t); for (int i = 0; i < 8; ++i) dst[8 + i] = _t[i]; }
        LD16(of, OF) LD16(ob, OB) LD16(v, Vg)
#undef LD16
        const bf16_t* DT = (const bf16_t*)(F.ws + WS_DOT) + (size_t)m * 16 + (F.lane >> 2);
        const float dot = __builtin_bit_cast(float, (unsigned)DT[0] << 16) + __builtin_bit_cast(float, (unsigned)DT[(size_t)M * 16] << 16);
        float s = 0.f;
#pragma unroll
        for (int i = 0; i < 16; ++i) { of[i] += ob[i]; s += of[i]; }
        s += __shfl_xor(s, 1); s += __shfl_xor(s, 2);
        const float mean = s * (1.f / 64.f); float q = 0.f;
#pragma unroll
        for (int i = 0; i < 16; ++i) { of[i] -= mean; q += of[i] * of[i]; }
        q += __shfl_xor(q, 1); q += __shfl_xor(q, 2);
        const float rstd = 1.0f / sqrtf(q * (1.f / 64.f) + GN_EPS);
        float z[16];
#pragma unroll
        for (int i = 0; i < 16; ++i) z[i] = of[i] * rstd * lg[i] + lb[i] + dot * v[i];
        u32x4 w0, w1; w0.x = cvt_pk_bf16(z[0], z[1]); w0.y = cvt_pk_bf16(z[2], z[3]); w0.z = cvt_pk_bf16(z[4], z[5]); w0.w = cvt_pk_bf16(z[6], z[7]);
        w1.x = cvt_pk_bf16(z[8], z[9]); w1.y = cvt_pk_bf16(z[10], z[11]); w1.z = cvt_pk_bf16(z[12], z[13]); w1.w = cvt_pk_bf16(z[14], z[15]);
        *(u32x4*)(OF + o) = w0; *(u32x4*)(OF + o + 8) = w1;
    }
}

__device__ __forceinline__ void rs_table(Frame& F, const pg8::StaticOrder& S) {
    LAS float* RS = (LAS float*)(F.lds + RS_OFF); const float* SS = (const float*)(F.ws + WS_SS);
    pg8::Unit u;
    for (int i = 0; i < 8 && S.next(i, u); ++i) {
        if (F.tid < 256) { const f32x4* p = (const f32x4*)(SS + (size_t)(u.pm * 256 + F.tid) * 16); const f32x4 a = p[0], b = p[1], c = p[2], d = p[3]; const f32x4 t = (a + b) + (c + d);
            RS[i * 256 + F.tid] = 1.0f / sqrtf(((t[0] + t[1]) + (t[2] + t[3])) * (1.f / D) + NORM_EPS); }
    }
    __syncthreads();
}

__device__ __forceinline__ void spatial_phase(Frame& F, const Args& A) {
    constexpr int LDW = 136;
    LAS bf16_t* WL = (LAS bf16_t*)(F.lds); LAS bf16_t* VL = (LAS bf16_t*)(F.lds + 128 * LDW * 2); LAS f32x2* ST = (LAS f32x2*)(F.lds + 2 * 128 * LDW * 2);
    bf16_t* H = (bf16_t*)(F.ws + WS_H); const bf16_t* WSB = (const bf16_t*)(F.ws + WS_WSB); const f32x2* LNP = (const f32x2*)(F.ws + WS_LNP);
    const float* lng = A.in[23]; const float* lnb = A.in[24]; const float* bs = A.in[26];
    const int tid = F.tid, lane = F.lane, wave = F.wave, fr = lane & 15, fq = lane >> 4;
    const int i0 = (wave >> 1) * 32, d0 = (wave & 1) * 64, cc = tid & 15;
    int gcur = -1; float gam[8], bet[8], bsv[2];
#pragma unroll
    for (int e = 0; e < 8; ++e) { gam[e] = 0.f; bet[e] = 0.f; }
    bsv[0] = bsv[1] = 0.f;
    u32x4 vraw[4]; f32x4 lnp[4];
#define SP_PREF(un_) do { const int c_ = (un_) >> 4, g_ = (un_) & 15; \
        _Pragma("unroll") for (int i = 0; i < 4; ++i) { const int j = (tid + 512 * i) >> 4; vraw[i] = *(const u32x4*)(H + (size_t)(c_ * 128 + j) * FF + 2048 + g_ * 128 + cc * 8); } \
        const f32x4* p_ = (const f32x4*)(LNP + (size_t)(c_ * 128 + (tid >> 2)) * 32) + (tid & 3) * 4; \
        _Pragma("unroll") for (int i = 0; i < 4; ++i) lnp[i] = p_[i]; } while (0)
    int un = blockIdx.x;
    if (un < 2048) SP_PREF(un);
    for (; un < 2048; un += F.G) {
        const int c = un >> 4, g = un & 15;
        if (g != gcur) {
            __syncthreads();
#pragma unroll
            for (int i = 0; i < 4; ++i) { const int q = tid + 512 * i, row = q >> 4, c8 = q & 15; *(LAS u32x4*)(WL + row * LDW + c8 * 8) = *(const u32x4*)(WSB + (size_t)g * 16384 + row * 128 + c8 * 8); }
#pragma unroll
            for (int e = 0; e < 8; ++e) { gam[e] = lng[g * 128 + cc * 8 + e]; bet[e] = lnb[g * 128 + cc * 8 + e]; }
            bsv[0] = bs[g * 128 + i0 + fr]; bsv[1] = bs[g * 128 + i0 + 16 + fr];
            gcur = g;
        }
        { float s_ = 0.f, q_ = 0.f;
#pragma unroll
          for (int i = 0; i < 4; ++i) { s_ += lnp[i][0] + lnp[i][2]; q_ += lnp[i][1] + lnp[i][3]; }
          s_ += __shfl_xor(s_, 1); s_ += __shfl_xor(s_, 2); q_ += __shfl_xor(q_, 1); q_ += __shfl_xor(q_, 2);
          const float mean = s_ * (1.f / 2048.f), var = q_ * (1.f / 2048.f) - mean * mean;
          if ((tid & 3) == 0) ST[tid >> 2] = (f32x2){mean, 1.0f / sqrtf(fmaxf(var, 0.f) + NORM_EPS)}; }
        __syncthreads();
#pragma unroll
        for (int i = 0; i < 4; ++i) { const int j = (tid + 512 * i) >> 4; float v[8]; unpack8(vraw[i], v);
            const f32x2 st = ST[j];
            for (int e = 0; e < 8; ++e) v[e] = (v[e] - st.x) * st.y * gam[e] + bet[e];
            u32x4 w; w.x = cvt_pk_bf16(v[0], v[1]); w.y = cvt_pk_bf16(v[2], v[3]); w.z = cvt_pk_bf16(v[4], v[5]); w.w = cvt_pk_bf16(v[6], v[7]);
            *(LAS u32x4*)(VL + j * LDW + cc * 8) = w; }
        __syncthreads();
        u32x2 uw[2][4];
#pragma unroll
        for (int mb = 0; mb < 2; ++mb) { const bf16_t* up = H + (size_t)(c * 128 + i0 + mb * 16 + fr) * FF + g * 128 + d0 + 4 * fq;
#pragma unroll
            for (int nb = 0; nb < 4; ++nb) uw[mb][nb] = *(const u32x2*)(up + nb * 16); }
        if (un + F.G < 2048) SP_PREF(un + F.G);
        f32x4 acc[2][4];
#pragma unroll
        for (int mb = 0; mb < 2; ++mb)
#pragma unroll
            for (int nb = 0; nb < 4; ++nb) acc[mb][nb] = (f32x4){0.f, 0.f, 0.f, 0.f};
#pragma unroll
        for (int kk = 0; kk < 4; ++kk) {
            bf16x8 wf[2], vf[4];
#pragma unroll
            for (int mb = 0; mb < 2; ++mb) wf[mb] = *(const LAS bf16x8*)(WL + (i0 + mb * 16 + fr) * LDW + kk * 32 + fq * 8);
#pragma unroll
            for (int nb = 0; nb < 4; ++nb) { const LAS bf16_t* p = VL + (kk * 32 + fq * 8) * LDW + d0 + nb * 16 + fr;
#pragma unroll
                for (int e = 0; e < 8; ++e) vf[nb][e] = (short)p[e * LDW]; }
#pragma unroll
            for (int mb = 0; mb < 2; ++mb)
#pragma unroll
                for (int nb = 0; nb < 4; ++nb) acc[mb][nb] = __builtin_amdgcn_mfma_f32_16x16x32_bf16(vf[nb], wf[mb], acc[mb][nb], 0, 0, 0);
        }
#pragma unroll
        for (int mb = 0; mb < 2; ++mb) { bf16_t* up = H + (size_t)(c * 128 + i0 + mb * 16 + fr) * FF + g * 128 + d0 + 4 * fq;
#pragma unroll
            for (int nb = 0; nb < 4; ++nb) { const f32x4 a = acc[mb][nb]; const u32x2 w = uw[mb][nb];
                const float o0 = (a[0] + bsv[mb]) * bf_lo(w.x), o1 = (a[1] + bsv[mb]) * bf_hi(w.x), o2 = (a[2] + bsv[mb]) * bf_lo(w.y), o3 = (a[3] + bsv[mb]) * bf_hi(w.y);
                *(u32x2*)(up + nb * 16) = (u32x2){cvt_pk_bf16(o0, o1), cvt_pk_bf16(o2, o3)}; } }
    }
#undef SP_PREF
    __syncthreads();
}

__device__ __forceinline__ void final_phase(Frame& F, const Args& A) {
    const int gw = blockIdx.x * NWAVES + F.wave, NGW = F.G * NWAVES, col = F.lane * 16;
    const bf16_t* XBp = (const bf16_t*)(F.ws + WS_XB);
    float gv[16];
#pragma unroll
    for (int i = 0; i < 16; ++i) gv[i] = A.in[3][col + i];
    for (int m = gw; m < M; m += NGW) {
        const u32x4 a = *(const u32x4*)(XBp + (size_t)m * D + col), b = *(const u32x4*)(XBp + (size_t)m * D + col + 8);
        float v[16]; { float t[8]; unpack8(a, t); for (int i = 0; i < 8; ++i) v[i] = t[i]; unpack8(b, t); for (int i = 0; i < 8; ++i) v[8 + i] = t[i]; }
        float s = 0.f;
#pragma unroll
        for (int i = 0; i < 16; ++i) s += v[i] * v[i];
        const float rs = 1.0f / sqrtf(wave_sum(s) * (1.f / D) + NORM_EPS);
        float* op = F.out + (size_t)m * D + col;
#pragma unroll
        for (int i = 0; i < 16; i += 4) *(f32x4*)(op + i) = (f32x4){v[i] * rs * gv[i], v[i + 1] * rs * gv[i + 1], v[i + 2] * rs * gv[i + 2], v[i + 3] * rs * gv[i + 3]};
    }
}

#define XB_TMO      128
#define XB_XCNT(j)  (256  + 64 * (j))
#define XB_XSUB(j)  (1280 + 64 * (j))
#define XB_XGEN(j)  (2304 + 64 * (j))
#define XB_TOP      3328
#define XB_TOPGEN   3392
#define XCD_BAR_WORDS 3456
#define XB_SPIN_CAP (1u << 18)
__device__ __forceinline__ unsigned xb_ld(unsigned* p)              { return __hip_atomic_load(p, __ATOMIC_RELAXED, __HIP_MEMORY_SCOPE_AGENT); }
__device__ __forceinline__ unsigned xb_add(unsigned* p, unsigned v) { return __hip_atomic_fetch_add(p, v, __ATOMIC_RELAXED, __HIP_MEMORY_SCOPE_AGENT); }
__device__ __forceinline__ unsigned xb_xcc_id() { return (unsigned)__builtin_amdgcn_s_getreg((3 << 11) | 20) & 0xFu; }
#define XB_SPIN(cond, bar) do { unsigned _sp = 0; while (cond) { __builtin_amdgcn_s_sleep(1); \
    if ((++_sp & 255u) == 0u) { if (xb_ld(&(bar)[XB_TMO])) break; if (_sp > XB_SPIN_CAP) { atomicAdd(&(bar)[XB_TMO], 1u); break; } } } } while (0)
struct XcdBarrier { unsigned* bar; unsigned x; volatile LAS unsigned* st; };
__device__ __forceinline__ XcdBarrier xcd_barrier_post(unsigned* bar, volatile LAS unsigned* st) {
    XcdBarrier b; b.bar = bar; b.x = xb_xcc_id(); b.st = st;
    if (threadIdx.x == 0) (void)xb_add(&bar[XB_XCNT(b.x)], 1u);
    return b;
}
__device__ __forceinline__ void xcd_barrier_complete(unsigned* bar, unsigned x, unsigned& nloc, unsigned& nx) {
    const unsigned G = gridDim.x * gridDim.y * gridDim.z;
    unsigned sum, cnt, mine, sp = 0u;
    for (;;) {
        sum = 0u; cnt = 0u; mine = 0u;
#pragma unroll
        for (unsigned j = 0; j < 16; ++j) { const unsigned c = xb_ld(&bar[XB_XCNT(j)]); sum += c; cnt += (c > 0u) ? 1u : 0u; mine = (j == x) ? c : mine; }
        if (sum == G) break;
        __builtin_amdgcn_s_sleep(1);
        if ((++sp & 255u) == 0u) { if (xb_ld(&bar[XB_TMO])) break; if (sp > XB_SPIN_CAP) { atomicAdd(&bar[XB_TMO], 1u); break; } }
    }
    nloc = mine > 0u ? mine : 1u; nx = cnt > 0u ? cnt : 1u;
}
__device__ __forceinline__ void xcd_barrier(const XcdBarrier& b) {
    asm volatile("s_waitcnt vmcnt(0)" ::: "memory");
    __syncthreads();
    if (threadIdx.x == 0) {
        unsigned* bar = b.bar;
        __builtin_amdgcn_s_waitcnt(0);
        unsigned nloc = b.st[0], nx = b.st[1];
        if (nloc == 0u) { xcd_barrier_complete(bar, b.x, nloc, nx); b.st[0] = nloc; b.st[1] = nx; }
        const unsigned old = xb_add(&bar[XB_XSUB(b.x)], 1u);
        const unsigned gen = old / nloc;
        if (old + 1u == (gen + 1u) * nloc) {
            __builtin_amdgcn_fence(__ATOMIC_RELEASE, "agent");
            asm volatile("s_waitcnt vmcnt(0)" ::: "memory");
            const unsigned og = xb_add(&bar[XB_TOP], 1u);
            const unsigned tg = og / nx;
            if (og + 1u == (tg + 1u) * nx) xb_add(&bar[XB_TOPGEN], 1u);
            else XB_SPIN(xb_ld(&bar[XB_TOPGEN]) == tg, bar);
            __builtin_amdgcn_fence(__ATOMIC_ACQUIRE, "agent");
            xb_add(&bar[XB_XGEN(b.x)], 1u);
            asm volatile("s_waitcnt vmcnt(0)" ::: "memory");
        } else {
            XB_SPIN(xb_ld(&bar[XB_XGEN(b.x)]) == gen, bar);
            __builtin_amdgcn_fence(__ATOMIC_ACQUIRE, "agent");
            asm volatile("s_waitcnt vmcnt(0)" ::: "memory");
        }
    }
    __syncthreads();
}

struct EpiFinal {
    const bf16_t* base; float* out; const float* g; float* ss; XcdBarrier xb;
    __device__ __forceinline__ void operator()(f32x4 (&acc)[2][2][4][2], const pg8::Unit& u, int ui, int wr, int wc, int fr, int fq) const {
        using namespace pg8;
        const int col0 = u.pn * BM + wc * 32 + 8 * fq;
#pragma unroll
        for (int ai = 0; ai < 2; ++ai)
#pragma unroll
            for (int m = 0; m < 4; ++m) { const int row = u.pm * BM + ai * HALF + wr * 64 + m * 16 + fr; const size_t off = (size_t)row * D + col0; float sq = 0.f;
#pragma unroll
                for (int bj = 0; bj < 2; ++bj) { const u32x4 w = *(const u32x4*)(base + off + bj * HALF); float t[8]; unpack8(w, t); const f32x4 b0 = {t[0], t[1], t[2], t[3]}, b1 = {t[4], t[5], t[6], t[7]};
                    const f32x4 v0 = acc[ai][bj][m][0] + b0, v1 = acc[ai][bj][m][1] + b1; acc[ai][bj][m][0] = v0; acc[ai][bj][m][1] = v1;
                    sq += (v0[0] * v0[0] + v0[1] * v0[1]) + (v0[2] * v0[2] + v0[3] * v0[3]) + (v1[0] * v1[0] + v1[1] * v1[1]) + (v1[2] * v1[2] + v1[3] * v1[3]); }
                sq += __shfl_xor(sq, 16); sq += __shfl_xor(sq, 32);
                if (fq == 0) ss[(size_t)row * 16 + u.pn * 4 + wc] = sq; if (m & 1) asm volatile("" ::: "memory"); }
        xcd_barrier(xb);
        f32x4 gv[2][2];
#pragma unroll
        for (int bj = 0; bj < 2; ++bj) { gv[bj][0] = *(const f32x4*)(g + col0 + bj * HALF); gv[bj][1] = *(const f32x4*)(g + col0 + bj * HALF + 4); }
#pragma unroll
        for (int ai = 0; ai < 2; ++ai)
#pragma unroll
            for (int m = 0; m < 4; ++m) { const int row = u.pm * BM + ai * HALF + wr * 64 + m * 16 + fr; const size_t off = (size_t)row * D + col0;
                const f32x4* p = (const f32x4*)(ss + (size_t)row * 16); const f32x4 t = (p[0] + p[1]) + (p[2] + p[3]);
                const float rs = 1.0f / sqrtf(((t[0] + t[1]) + (t[2] + t[3])) * (1.f / D) + NORM_EPS);
#pragma unroll
                for (int bj = 0; bj < 2; ++bj) { float* op = out + off + bj * HALF; *(f32x4*)op = acc[ai][bj][m][0] * rs * gv[bj][0]; *(f32x4*)(op + 4) = acc[ai][bj][m][1] * rs * gv[bj][1]; }
                if (m & 1) asm volatile("" ::: "memory"); }
    }
};

constexpr int NPHASE = 15;
__global__ void __launch_bounds__(NTHR, 2) fwd_kernel(Args args) {
    extern __shared__ __attribute__((aligned(16))) unsigned char lds_raw[];
    Frame F;
    F.lds = (LAS unsigned char*)lds_raw; F.tid = threadIdx.x; F.lane = F.tid & 63; F.wave = __builtin_amdgcn_readfirstlane(F.tid >> 6); F.G = gridDim.x;
    F.out = args.out; F.ws = args.ws;
    const int lo = args.ph_lo, hi = args.ph_hi;
    cg::grid_group grid = cg::this_grid();
    volatile LAS unsigned* MISC = (volatile LAS unsigned*)(F.lds + RING_BYTES + 512);
    if (F.tid < 2) MISC[F.tid] = 0u;
    __syncthreads();
    XcdBarrier xbar = xcd_barrier_post((unsigned*)(args.ws + WS_BAR), MISC);
#ifndef PHMASK
#define PHMASK 0x7fff
#endif
#define IN(k) (((PHMASK >> (k)) & 1) && lo <= (k) && (k) < hi)
#define SEAM(k) do { if (IN(k) && IN((k) + 1)) { if (hi > 1000) grid.sync(); else xcd_barrier(xbar); } } while (0)
    unsigned char* ws = args.ws;
    bf16_t* XB = (bf16_t*)(ws + WS_XB); bf16_t* HB = (bf16_t*)(ws + WS_H); float* SS = (float*)(ws + WS_SS);
    const LAS float* RS = (const LAS float*)(F.lds + RS_OFF);
    const int bx = blockIdx.x;

    if (IN(0)) { p0_phase(F, args); }
    SEAM(0);
    if (IN(1)) {
        __syncthreads();
        const bool bal = (F.G == 256);
        { pg8::Gemm g{(const bf16_t*)F.out, (const bf16_t*)(ws + WS_L1), M, 512, 2048, 2048, 1 << 20, 0}; pg8::StaticOrder S;
          if (bal) S.init_sub(M, 512, 128, bx >= 128 ? bx - 128 : -1, 0, 1); else S.init(M, 512, F.G, bx);
          pg8::EpiLora1 E{(bf16_t*)(ws + WS_A2), (bf16_t*)(ws + WS_SG)}; pg8::gemm_phase(F.lds, g, S, E); }
        { pg8::Gemm g{(const bf16_t*)(ws + WS_XR), (const bf16_t*)(ws + WS_WRKV), M, 3072, 1024, 1024, 4, (size_t)M * D * 2}; pg8::StaticOrder S;
          if (bal) { if (bx < 128) S.init_sub(M, 3072, 128, bx, 0, 4); else S.init_sub(M, 3072, 128, bx - 128, 512, 2); } else S.init(M, 3072, F.G, bx);
          pg8::EpiSplit E{(bf16_t*)(ws + WS_R), D, D, (size_t)M * D}; pg8::gemm_phase(F.lds, g, S, E); }
    }
    SEAM(1);
    if (IN(2)) {
        pg8::Gemm g{(const bf16_t*)(ws + WS_A2), (const bf16_t*)(ws + WS_L2), M, 4096, 128, 256, 8, 256}; pg8::StaticOrder S; S.init(M, 4096, F.G, bx);
        pg8::EpiLora2 E{(bf16_t*)F.out, (bf16_t*)(ws + WS_AA), args.in[9], args.in[12]}; pg8::gemm_phase(F.lds, g, S, E);
    }
    SEAM(2);
    if (IN(3)) { scan_phase<0>(F, args); }
    SEAM(3);
    if (IN(4)) { z_phase(F, args); }
    SEAM(4);
    if (IN(5)) {
        { pg8::Gemm g{(const bf16_t*)(ws + WS_SG), (const bf16_t*)(ws + WS_G2), M, 1024, 128, 256, 1 << 20, 0}; pg8::StaticOrder S; S.init(M, 1024, F.G, bx);
          pg8::EpiG E{(bf16_t*)(ws + WS_OD)}; pg8::gemm_phase(F.lds, g, S, E); }
        __syncthreads(); convB_phase(F, args); __syncthreads();
    }
    SEAM(5);
    if (IN(6)) {
        pg8::Gemm g{(const bf16_t*)(ws + WS_OD), (const bf16_t*)(ws + WS_WO), M, 1024, 1024, 1024, 1 << 20, 0}; pg8::StaticOrder S; S.init(M, 1024, F.G, bx);
        pg8::EpiRes<true> E{args.in[0], XB, SS}; pg8::gemm_phase(F.lds, g, S, E);
    }
    SEAM(6);
    if (IN(7)) {
        pg8::Gemm g{XB, (const bf16_t*)(ws + WS_W1_0), M, FF, 1024, 1024, 1 << 20, 0}; pg8::StaticOrder S; S.init(M, FF, F.G, bx);
        rs_table(F, S);
        pg8::EpiSq E{HB, RS}; pg8::gemm_phase(F.lds, g, S, E);
    }
    SEAM(7);
    if (IN(8)) {
        pg8::Gemm g{HB, (const bf16_t*)(ws + WS_W2_0), M, 1024, FF, FF, 1 << 20, 0}; pg8::StaticOrder S; S.init(M, 1024, F.G, bx);
        pg8::EpiRes<false> E{nullptr, XB, SS}; pg8::gemm_phase(F.lds, g, S, E);
    }
    SEAM(8);
    if (IN(9)) {
        pg8::Gemm g{XB, (const bf16_t*)(ws + WS_WIN), M, FF, 1024, 1024, 1 << 20, 0}; pg8::StaticOrder S; S.init(M, FF, F.G, bx);
        rs_table(F, S);
        pg8::EpiGelu E{HB, RS, (f32x2*)(ws + WS_LNP)}; pg8::gemm_phase(F.lds, g, S, E);
    }
    SEAM(9);
    if (IN(10)) { __syncthreads(); spatial_phase(F, args); }
    SEAM(10);
    if (IN(11)) {
        __syncthreads();
        pg8::Gemm g{HB, (const bf16_t*)(ws + WS_WOUT), M, 1024, 2048, FF, 1 << 20, 0}; pg8::StaticOrder S; S.init(M, 1024, F.G, bx);
        pg8::EpiRes<false> E{nullptr, XB, SS}; pg8::gemm_phase(F.lds, g, S, E);
    }
    SEAM(11);
    if (IN(12)) {
        pg8::Gemm g{XB, (const bf16_t*)(ws + WS_W1_1), M, FF, 1024, 1024, 1 << 20, 0}; pg8::StaticOrder S; S.init(M, FF, F.G, bx);
        rs_table(F, S);
        pg8::EpiSq E{HB, RS}; pg8::gemm_phase(F.lds, g, S, E);
    }
    SEAM(12);
    const bool fuse_final = IN(13) && IN(14) && F.G == 256;
    if (IN(13)) {
        pg8::Gemm g{HB, (const bf16_t*)(ws + WS_W2_1), M, 1024, FF, FF, 1 << 20, 0}; pg8::StaticOrder S; S.init(M, 1024, F.G, bx);
        if (fuse_final) { EpiFinal E{XB, F.out, args.in[3], SS, xbar}; pg8::gemm_phase(F.lds, g, S, E); }
        else { pg8::EpiRes<false> E{nullptr, XB, SS}; pg8::gemm_phase(F.lds, g, S, E); }
    }
    if (!fuse_final) { SEAM(13); }
    if (IN(14) && !fuse_final) { final_phase(F, args); }
}

extern "C" void kernel_launch(void* const* d_in, const int* in_sizes, int n_in, void* d_out, int out_size, void* d_ws, size_t ws_size, hipStream_t stream) {
    static int grid = 0;
    if (grid == 0) {
        if (n_in != 30 || out_size != M * D || ws_size < WS_END) { fprintf(stderr, "kernel_launch: unexpected shapes (n_in %d out %d ws %zu)\n", n_in, out_size, ws_size); grid = -1; return; }
        int dev = 0, cus = 0, per_cu = 0;
        (void)hipGetDevice(&dev); (void)hipDeviceGetAttribute(&cus, hipDeviceAttributeMultiprocessorCount, dev);
        (void)hipFuncSetAttribute((const void*)fwd_kernel, hipFuncAttributeMaxDynamicSharedMemorySize, LDS_BYTES);
        (void)hipOccupancyMaxActiveBlocksPerMultiprocessor(&per_cu, (const void*)fwd_kernel, NTHR, LDS_BYTES);
        if (per_cu < 1) { fprintf(stderr, "kernel_launch: occupancy query says %d blocks per CU\n", per_cu); per_cu = 1; }
        (void)hipGetLastError();
        grid = cus;
        if (grid > 256) grid = 256;
    }
    if (grid < 0) return;
    if (hipMemsetAsync((char*)d_ws + WS_BAR, 0, 16384, stream) != hipSuccess) { fprintf(stderr, "memset failed\n"); return; }
    Args a{};
    for (int i = 0; i < 30; ++i) a.in[i] = (const float*)d_in[i];
    a.out = (float*)d_out; a.ws = (unsigned char*)d_ws;
#if MK_SINGLE
    a.ph_lo = 0; a.ph_hi = NPHASE;
    void* kargs[] = {&a};
    hipError_t e = hipLaunchCooperativeKernel((const void*)fwd_kernel, dim3(grid), dim3(NTHR), kargs, LDS_BYTES, stream);
    if (e != hipSuccess) fprintf(stderr, "cooperative launch failed: %s (grid %d)\n", hipGetErrorString(e), grid);
#else
    for (int p = 0; p < NPHASE; ++p) { a.ph_lo = p; a.ph_hi = p + 1; hipLaunchKernelGGL(fwd_kernel, dim3(grid), dim3(NTHR), LDS_BYTES, stream, a); }
#endif
}
```
